# Optimizing an MI355X kernel written in HIP

```python
import jax, jax.numpy as jnp
from jax import lax
import numpy as np

D_MODEL = 1024
BATCH = 8
SEQ = 4096
DEPTH = 2

GRID_W = 64
CTX_LEN = 256
ROPE_THETA = 10000.0
Q_BLOCK = 128

A_HEADS = 4
A_KV_HEADS = 2
A_DIM = 128
B_HEADS = 4
B_QK_DIM = 128
B_V_DIM = 128
RET_CHUNK = 128
MLA_HEADS = 8
MLA_Q_LORA = 384
MLA_KV_LORA = 256
MLA_NOPE = 128
MLA_ROPE = 64
MLA_V = 128
N_EXPERTS = 32
TOP_K = 4
D_FF = D_MODEL
SWIGLU_LIMIT = 7.0
SWIGLU_ALPHA = 1.702
MOE_BLOCK = 128
DN_ALPHA = (2 * DEPTH) ** 0.25
DN_BETA = (8 * DEPTH) ** -0.25
N_EVEN = (DEPTH + 1) // 2
N_ODD = DEPTH // 2
A_Q_W = A_HEADS * A_DIM
A_KV_W = A_KV_HEADS * A_DIM
B_QK_W = B_HEADS * B_QK_DIM
B_V_W = B_HEADS * B_V_DIM
AB_IN = A_Q_W + 2 * A_KV_W + 2 * B_QK_W + 2 * B_V_W
MIX_WIDTH = A_Q_W + B_V_W
MLA_IN = MLA_Q_LORA + MLA_KV_LORA + MLA_ROPE

kernel_name = 'hybrid_dit_gqa_retention_mla_moe'

F32 = jnp.float32


def rms_norm(x, g, eps=1e-6):
    xf = x.astype(F32)
    return (xf * lax.rsqrt(jnp.mean(xf * xf, axis=-1, keepdims=True) + eps)).astype(x.dtype) * g


def layer_norm(x, g, b, eps=1e-5):
    xf = x.astype(F32)
    mu = jnp.mean(xf, axis=-1, keepdims=True)
    var = jnp.mean(jnp.square(xf - mu), axis=-1, keepdims=True)
    return ((xf - mu) * lax.rsqrt(var + eps)).astype(x.dtype) * g + b


def modulate(x, shift, scale):
    return x * (1.0 + scale) + shift


def to_heads(t, n, d):
    b, s, _ = t.shape
    return t.reshape(b, s, n, d).transpose(0, 2, 1, 3)


def from_heads(t):
    b, n, s, d = t.shape
    return t.transpose(0, 2, 1, 3).reshape(b, s, n * d)


def rope_1d(x, pos):
    half = x.shape[-1] // 2
    inv = ROPE_THETA ** (-jnp.arange(half, dtype=F32) / half)
    ang = pos.astype(F32)[:, None] * inv[None, :]
    cos, sin = jnp.cos(ang), jnp.sin(ang)
    x1, x2 = x[..., :half], x[..., half:]
    return jnp.concatenate([x1 * cos - x2 * sin, x1 * sin + x2 * cos], axis=-1).astype(x.dtype)


def axial_rope(x, n_tok):
    n_rows = n_tok // GRID_W
    rows = jnp.repeat(jnp.arange(n_rows), GRID_W)
    cols = jnp.tile(jnp.arange(GRID_W), n_rows)
    d = x.shape[-1] // 2
    return jnp.concatenate([rope_1d(x[..., :d], rows), rope_1d(x[..., d:], cols)], axis=-1)


def attend(q, k, v):
    s = jnp.einsum('bkgqd,bksd->bkgqs', q, k, preferred_element_type=F32)
    p = jax.nn.softmax(s, axis=-1).astype(v.dtype)
    return jnp.einsum('bkgqs,bkse->bkgqe', p, v)


def blocked_attend(q, k, v):
    b, kh, g, t, d = q.shape
    nb = t // Q_BLOCK
    qb = jnp.moveaxis(q.reshape(b, kh, g, nb, Q_BLOCK, d), 3, 0)
    ob = lax.map(lambda qi: attend(qi, k, v), qb)
    return jnp.moveaxis(ob, 0, 3).reshape(b, kh, g, t, v.shape[-1])


def retention_scan(q, k, v, log_gamma, s0, include_diag):
    b, h, t, dk = k.shape
    dv = v.shape[-1]
    nc = t // RET_CHUNK
    pos = jnp.arange(RET_CHUNK, dtype=F32)
    lg = log_gamma[:, None]
    kc = k.reshape(b, h, nc, RET_CHUNK, dk).astype(F32)
    vc = v.reshape(b, h, nc, RET_CHUNK, dv).astype(F32)
    zeta = jnp.exp(lg * (RET_CHUNK - 1 - pos))
    kv = jnp.einsum('bhncd,bhnce->bhnde', kc * zeta[None, :, None, :, None], vc)
    chunk_decay = jnp.exp(log_gamma * RET_CHUNK)[None, :, None, None]

    def step(s, kv_n):
        return chunk_decay * s + kv_n, s

    s_last, s_prev = lax.scan(step, s0, jnp.moveaxis(kv, 2, 0))
    if q is None:
        return None, s_last
    s_prev = jnp.moveaxis(s_prev, 0, 2)
    qc = q.reshape(b, h, nc, RET_CHUNK, dk).astype(F32)
    diff = pos[:, None] - pos[None, :]
    mask = (diff >= 0) if include_diag else (diff > 0)
    d_intra = jnp.where(mask[None], jnp.exp(lg[:, :, None] * jnp.maximum(diff, 0.0)[None]), 0.0)
    xi = jnp.exp(lg * (pos + 1.0))
    sc = jnp.einsum('bhncd,bhnsd->bhncs', qc, kc) * d_intra[None, :, None]
    out = (jnp.einsum('bhncs,bhnse->bhnce', sc, vc)
           + jnp.einsum('bhncd,bhnde->bhnce', qc * xi[None, :, None, :, None], s_prev))
    return out.reshape(b, h, t, dv), s_last


def bidir_retention(q_c, k_c, v_c, q_l, k_l, v_l, log_decay):
    b, h, _, dk = k_c.shape
    dv = v_c.shape[-1]
    log_gamma = jnp.log1p(-jnp.exp(log_decay.astype(F32)))
    s0 = jnp.zeros((b, h, dk, dv), F32)
    flip = lambda t: t[:, :, ::-1]
    oc_f, s_f = retention_scan(q_c, k_c, v_c, log_gamma[0], s0, True)
    oc_b, s_b = retention_scan(None if q_c is None else flip(q_c), flip(k_c), flip(v_c), log_gamma[1], s0, False)
    ol_f, _ = retention_scan(q_l, k_l, v_l, log_gamma[0], s_f, True)
    ol_b, _ = retention_scan(flip(q_l), flip(k_l), flip(v_l), log_gamma[1], s_b, False)
    out_c = None if q_c is None else oc_f + flip(oc_b)
    return out_c, ol_f + flip(ol_b)


def head_group_norm(o, g, eps=1e-5):
    mu = jnp.mean(o, axis=-1, keepdims=True)
    var = jnp.mean(jnp.square(o - mu), axis=-1, keepdims=True)
    return from_heads(((o - mu) * lax.rsqrt(var + eps)).astype(g.dtype)) * g


def mixer_ab(hc, hl, w_in, q_norm, k_norm, log_decay, gn_g, w_out, with_ctx):
    n_ctx, n_lat = hc.shape[1], hl.shape[1]
    cuts = np.cumsum([A_Q_W, A_KV_W, A_KV_W, B_QK_W, B_QK_W, B_V_W])
    aq_c, ak_c, av_c, bq_c, bk_c, bv_c, bg_c = jnp.split(hc @ w_in, cuts, axis=-1)
    aq_l, ak_l, av_l, bq_l, bk_l, bv_l, bg_l = jnp.split(hl @ w_in, cuts, axis=-1)
    a_scale = A_DIM ** -0.5
    grp = A_HEADS // A_KV_HEADS
    ka_c = rms_norm(to_heads(ak_c, A_KV_HEADS, A_DIM), k_norm)
    va_c = to_heads(av_c, A_KV_HEADS, A_DIM)
    qa_l = axial_rope(rms_norm(to_heads(aq_l, A_HEADS, A_DIM), q_norm), n_lat) * a_scale
    ka_l = axial_rope(rms_norm(to_heads(ak_l, A_KV_HEADS, A_DIM), k_norm), n_lat)
    va_l = to_heads(av_l, A_KV_HEADS, A_DIM)
    k_all = jnp.concatenate([ka_c, ka_l], axis=2)
    v_all = jnp.concatenate([va_c, va_l], axis=2)
    b = hl.shape[0]
    oa_l = blocked_attend(qa_l.reshape(b, A_KV_HEADS, grp, n_lat, A_DIM), k_all, v_all)
    oa_l = from_heads(oa_l.reshape(b, A_HEADS, n_lat, A_DIM))
    b_scale = B_QK_DIM ** -0.5
    pos_c = jnp.arange(n_ctx)
    pos_l = n_ctx + jnp.arange(n_lat)
    kb_c = rope_1d(to_heads(bk_c, B_HEADS, B_QK_DIM), pos_c)
    vb_c = to_heads(bv_c, B_HEADS, B_V_DIM)
    qb_l = rope_1d(to_heads(bq_l, B_HEADS, B_QK_DIM), pos_l) * b_scale
    kb_l = rope_1d(to_heads(bk_l, B_HEADS, B_QK_DIM), pos_l)
    vb_l = to_heads(bv_l, B_HEADS, B_V_DIM)
    qb_c = rope_1d(to_heads(bq_c, B_HEADS, B_QK_DIM), pos_c) * b_scale if with_ctx else None
    ob_c, ob_l = bidir_retention(qb_c, kb_c, vb_c, qb_l, kb_l, vb_l, log_decay)
    yb_l = head_group_norm(ob_l, gn_g) * jax.nn.silu(bg_l)
    yl = jnp.concatenate([oa_l, yb_l], axis=-1) @ w_out
    if not with_ctx:
        return None, yl
    qa_c = rms_norm(to_heads(aq_c, A_HEADS, A_DIM), q_norm) * a_scale
    oa_c = attend(qa_c.reshape(b, A_KV_HEADS, grp, n_ctx, A_DIM), ka_c, va_c)
    oa_c = from_heads(oa_c.reshape(b, A_HEADS, n_ctx, A_DIM))
    yb_c = head_group_norm(ob_c, gn_g) * jax.nn.silu(bg_c)
    yc = jnp.concatenate([oa_c, yb_c], axis=-1) @ w_out
    return yc, yl


def mla_kv(p, kv_norm, w_ukv, use_rope):
    ckv = p[..., MLA_Q_LORA:MLA_Q_LORA + MLA_KV_LORA]
    kpe = p[..., MLA_Q_LORA + MLA_KV_LORA:][:, None]
    kv = to_heads(rms_norm(ckv, kv_norm) @ w_ukv, MLA_HEADS, MLA_NOPE + MLA_V)
    k_nope, v = kv[..., :MLA_NOPE], kv[..., MLA_NOPE:]
    if use_rope:
        kpe = axial_rope(kpe, p.shape[1])
    kpe = jnp.broadcast_to(kpe, k_nope.shape[:-1] + (MLA_ROPE,))
    return jnp.concatenate([k_nope, kpe], axis=-1), v


def mla_q(p, q_norm, w_uq, use_rope):
    q = to_heads(rms_norm(p[..., :MLA_Q_LORA], q_norm) @ w_uq, MLA_HEADS, MLA_NOPE + MLA_ROPE)
    if use_rope:
        q = jnp.concatenate([q[..., :MLA_NOPE], axial_rope(q[..., MLA_NOPE:], p.shape[1])], axis=-1)
    return q * (MLA_NOPE + MLA_ROPE) ** -0.5


def mixer_mla(hc, hl, w_in, q_norm, kv_norm, w_uq, w_ukv, w_out, with_ctx):
    pc, pl = hc @ w_in, hl @ w_in
    k_c, v_c = mla_kv(pc, kv_norm, w_ukv, False)
    k_l, v_l = mla_kv(pl, kv_norm, w_ukv, True)
    q_l = mla_q(pl, q_norm, w_uq, True)
    k_all = jnp.concatenate([k_c, k_l], axis=2)
    v_all = jnp.concatenate([v_c, v_l], axis=2)
    yl = from_heads(blocked_attend(q_l[:, :, None], k_all, v_all)[:, :, 0]) @ w_out
    if not with_ctx:
        return None, yl
    q_c = mla_q(pc, q_norm, w_uq, False)
    yc = from_heads(attend(q_c[:, :, None], k_c, v_c)[:, :, 0]) @ w_out
    return yc, yl


def clamped_swiglu(gu):
    glu = jnp.minimum(gu[..., :D_FF], SWIGLU_LIMIT)
    lin = jnp.clip(gu[..., D_FF:], -SWIGLU_LIMIT, SWIGLU_LIMIT)
    return glu * jax.nn.sigmoid(SWIGLU_ALPHA * glu) * (lin + 1.0)


def moe(h, router_w, router_b, w_up, b_up, w_down, b_down):
    t, d = h.shape
    logits = (h @ router_w + router_b).astype(F32)
    top_v, top_i = lax.top_k(logits, TOP_K)
    gates = jax.nn.softmax(top_v, axis=-1)
    n_asg = t * TOP_K
    flat_e = top_i.reshape(-1)
    order = jnp.argsort(flat_e)
    e_sorted = flat_e[order]
    tok_sorted = (order // TOP_K).astype(jnp.int32)
    counts = jnp.bincount(flat_e, length=N_EXPERTS)
    padded = (counts + MOE_BLOCK - 1) // MOE_BLOCK * MOE_BLOCK
    pad_end = jnp.cumsum(padded)
    pad_start = pad_end - padded
    start = jnp.cumsum(counts) - counts
    dest = pad_start[e_sorted] + jnp.arange(n_asg) - start[e_sorted]
    n_blocks = -(-n_asg // MOE_BLOCK) + N_EXPERTS
    n_slots = n_blocks * MOE_BLOCK
    slot_tok = jnp.full((n_slots,), t, jnp.int32).at[dest].set(tok_sorted)
    slot_gate = jnp.zeros((n_slots,), F32).at[dest].set(gates.reshape(-1)[order])
    blk_expert = jnp.minimum(jnp.searchsorted(pad_end, jnp.arange(n_blocks) * MOE_BLOCK, side='right'), N_EXPERTS - 1)
    h_pad = jnp.concatenate([h, jnp.zeros((1, d), h.dtype)], axis=0)

    def expert_block(args):
        tok, g, e = args
        xb = h_pad[tok]
        y = clamped_swiglu(xb @ w_up[e] + b_up[e]) @ w_down[e] + b_down[e]
        return (y * g[:, None]).astype(h.dtype)

    yb = lax.map(expert_block, (slot_tok.reshape(n_blocks, MOE_BLOCK), slot_gate.reshape(n_blocks, MOE_BLOCK), blk_expert))
    out = jnp.zeros((t + 1, d), h.dtype).at[slot_tok].add(yb.reshape(n_slots, d))
    return out[:t]


def setup_inputs(seed: int = 0) -> dict:
    key = jax.random.key(seed)
    ks = jax.random.split(key, 28)
    d = D_MODEL
    nrm = lambda k, shape, s: jax.random.normal(k, shape, F32) * s
    gain = lambda k, shape: 1.0 + 0.02 * jax.random.normal(k, shape, F32)
    log_decay0 = jnp.log(2.0 ** -(5.0 + jnp.arange(B_HEADS, dtype=F32)))
    return {
        'x': nrm(ks[0], (BATCH, SEQ, d), 1.0),
        'c': nrm(ks[1], (BATCH, d), 1.0),
        'ctx': nrm(ks[2], (BATCH, CTX_LEN, d), 1.0),
        'c_ctx': nrm(ks[3], (d,), 1.0),
        'ada_w': nrm(ks[4], (DEPTH, d, 6 * d), 0.5 * d ** -0.5),
        'ada_b': nrm(ks[5], (DEPTH, 6 * d), 0.02),
        'ln1_g': gain(ks[6], (DEPTH, d)),
        'ln1_b': nrm(ks[7], (DEPTH, d), 0.02),
        'ln2_g': gain(ks[8], (DEPTH, d)),
        'ln2_b': nrm(ks[9], (DEPTH, d), 0.02),
        'ab_w_in': nrm(ks[10], (N_EVEN, d, AB_IN), d ** -0.5),
        'ab_q_norm': gain(ks[11], (N_EVEN, A_DIM)),
        'ab_k_norm': gain(ks[12], (N_EVEN, A_DIM)),
        'ab_log_decay': log_decay0 + nrm(ks[13], (N_EVEN, 2, B_HEADS), 0.05),
        'ab_gn_g': gain(ks[14], (N_EVEN, B_V_W)),
        'ab_w_out': nrm(ks[15], (N_EVEN, MIX_WIDTH, d), DN_BETA * MIX_WIDTH ** -0.5),
        'mla_w_in': nrm(ks[16], (N_ODD, d, MLA_IN), d ** -0.5),
        'mla_q_norm': gain(ks[17], (N_ODD, MLA_Q_LORA)),
        'mla_kv_norm': gain(ks[18], (N_ODD, MLA_KV_LORA)),
        'mla_w_uq': nrm(ks[19], (N_ODD, MLA_Q_LORA, MLA_HEADS * (MLA_NOPE + MLA_ROPE)), MLA_Q_LORA ** -0.5),
        'mla_w_ukv': nrm(ks[20], (N_ODD, MLA_KV_LORA, MLA_HEADS * (MLA_NOPE + MLA_V)), MLA_KV_LORA ** -0.5),
        'mla_w_out': nrm(ks[21], (N_ODD, MLA_HEADS * MLA_V, d), DN_BETA * (MLA_HEADS * MLA_V) ** -0.5),
        'moe_router_w': nrm(ks[22], (DEPTH, d, N_EXPERTS), d ** -0.5),
        'moe_router_b': nrm(ks[23], (DEPTH, N_EXPERTS), 0.01),
        'moe_w_up': nrm(ks[24], (DEPTH, N_EXPERTS, d, 2 * D_FF), d ** -0.5),
        'moe_b_up': nrm(ks[25], (DEPTH, N_EXPERTS, 2 * D_FF), 0.02),
        'moe_w_down': nrm(ks[26], (DEPTH, N_EXPERTS, D_FF, d), DN_BETA * D_FF ** -0.5),
        'moe_b_down': nrm(ks[27], (DEPTH, N_EXPERTS, d), 0.02),
    }


def reference(x, c, ctx, c_ctx, ada_w, ada_b, ln1_g, ln1_b, ln2_g, ln2_b,
              ab_w_in, ab_q_norm, ab_k_norm, ab_log_decay, ab_gn_g, ab_w_out,
              mla_w_in, mla_q_norm, mla_kv_norm, mla_w_uq, mla_w_ukv, mla_w_out,
              moe_router_w, moe_router_b, moe_w_up, moe_b_up, moe_w_down, moe_b_down):
    b, n_lat, d = x.shape
    n_ctx = ctx.shape[1]
    sc = jax.nn.silu(c)
    scc = jax.nn.silu(c_ctx)
    xl, xc = x, ctx
    for i in range(DEPTH):
        last = i == DEPTH - 1
        j = i // 2
        mod_l = jnp.split((sc @ ada_w[i] + ada_b[i])[:, None, :], 6, axis=-1)
        mod_c = jnp.split(scc @ ada_w[i] + ada_b[i], 6, axis=-1)
        hl = modulate(xl, mod_l[0], mod_l[1])
        hc = modulate(xc, mod_c[0], mod_c[1])
        if i % 2 == 0:
            yc, yl = mixer_ab(hc, hl, ab_w_in[j], ab_q_norm[j], ab_k_norm[j], ab_log_decay[j],
                              ab_gn_g[j], ab_w_out[j], not last)
        else:
            yc, yl = mixer_mla(hc, hl, mla_w_in[j], mla_q_norm[j], mla_kv_norm[j], mla_w_uq[j],
                               mla_w_ukv[j], mla_w_out[j], not last)
        xl = layer_norm(DN_ALPHA * xl + mod_l[2] * yl, ln1_g[i], ln1_b[i])
        hl = modulate(xl, mod_l[3], mod_l[4])
        moe_args = (moe_router_w[i], moe_router_b[i], moe_w_up[i], moe_b_up[i], moe_w_down[i], moe_b_down[i])
        if last:
            fl = moe(hl.reshape(b * n_lat, d), *moe_args).reshape(b, n_lat, d)
        else:
            xc = layer_norm(DN_ALPHA * xc + mod_c[2] * yc, ln1_g[i], ln1_b[i])
            hc = modulate(xc, mod_c[3], mod_c[4])
            f = moe(jnp.concatenate([hc.reshape(b * n_ctx, d), hl.reshape(b * n_lat, d)], axis=0), *moe_args)
            fc = f[:b * n_ctx].reshape(b, n_ctx, d)
            fl = f[b * n_ctx:].reshape(b, n_lat, d)
            xc = layer_norm(DN_ALPHA * xc + mod_c[5] * fc, ln2_g[i], ln2_b[i])
        xl = layer_norm(DN_ALPHA * xl + mod_l[5] * fl, ln2_g[i], ln2_b[i])
    return xl
```

```cpp
#include <hip/hip_runtime.h>
#include <cstdio>
#include <cstdint>

#define LAS __attribute__((address_space(3)))
#define GAS __attribute__((address_space(1)))
typedef unsigned short bf16;
typedef short bf16x8 __attribute__((ext_vector_type(8)));
typedef short s16x4 __attribute__((ext_vector_type(4)));
typedef float f32x4 __attribute__((ext_vector_type(4)));
typedef float f32x2 __attribute__((ext_vector_type(2)));
typedef float f32x8 __attribute__((ext_vector_type(8)));
typedef float f32x16 __attribute__((ext_vector_type(16)));
typedef unsigned u32x4 __attribute__((ext_vector_type(4)));
typedef unsigned u32x2 __attribute__((ext_vector_type(2)));
typedef GAS unsigned gu32;

constexpr int D = 1024, NB = 8, SEQ = 4096, NCTX = 256, SP = SEQ + NCTX  , R = NB * SP  ;
constexpr int GRID_W = 64;
constexpr int AB_IN = 3072, MLA_IN = 704, MLA_IN_P = 768, MLA_QL = 384, MLA_KVL = 256, UQ_N = 1536, UKV_N = 2048;
constexpr int NE = 32, TOPK = 4, DFF = 1024;
constexpr int NCHUNK = SP / 128;
constexpr float DN_ALPHA = 1.4142135623730951f;
constexpr int CAP = R * TOPK;
constexpr int NSLOT_MAX = R * TOPK + NE * 256;

__device__ __forceinline__ unsigned cvt_pk_bf16(float lo, float hi) { unsigned r; asm volatile("v_cvt_pk_bf16_f32 %0, %1, %2" : "=v"(r) : "v"(lo), "v"(hi)); return r; }
__device__ __forceinline__ float bflo(unsigned w) { return __uint_as_float(w << 16); }
__device__ __forceinline__ float bfhi(unsigned w) { return __uint_as_float(w & 0xffff0000u); }
__device__ __forceinline__ float bf2f(bf16 b) { return __uint_as_float((unsigned)b << 16); }
__device__ __forceinline__ bf16 f2bf(float f) { return (bf16)(cvt_pk_bf16(f, 0.f) & 0xffffu); }
__device__ __forceinline__ float wave_sum(float v) {
#pragma unroll
    for (int o = 1; o < 64; o <<= 1) v += __shfl_xor(v, o);
    return v;
}
#define LDS_WAIT() asm volatile("s_waitcnt lgkmcnt(0)" ::: "memory")
#define VM_WAIT() asm volatile("s_waitcnt vmcnt(0)" ::: "memory")
namespace pg8 {
typedef unsigned short bf16_t;
constexpr int BM = 256, BK = 64, HALF = 128, HTB = HALF * BK * 2  , STAGE_BYTES = 8 * HTB, NXCD = 8, WGM = 8;

__host__ __device__ __forceinline__ int lds_byte(int r, int c) { const int st = (r >> 4) * 2 + (c >> 5), rr = r & 15, cc = c & 31, ob = rr * 64 + cc * 2; return st * 1024 + (ob ^ (((ob >> 9) & 1) << 5)); }
__host__ __device__ __forceinline__ void stage_rc(int b, int& R_, int& C_) { const int st = b / 1024, sb = b % 1024, swz = sb ^ (((sb >> 9) & 1) << 5); R_ = (st >> 1) * 16 + swz / 64; C_ = (st & 1) * 32 + (swz % 64) / 2; }
__host__ __device__ __forceinline__ int perm32(int rho) { const int n = rho >> 4, i = rho & 15; return 8 * (i >> 2) + 4 * n + (i & 3); }

struct Unit { int pm, pn, pb, e; };
struct Gemm { const bf16_t* A; const bf16_t* Bt; int K; };

struct StaticOrder {
    int nM, nN, nwg, G, c;
    static constexpr bool GATHER = false;
    __device__ void init(int nM_, int nN_, int G_, int c_) { nM = nM_; nN = nN_; nwg = nM * nN; G = G_; c = c_; }
    __device__ bool next(int i, Unit& u) const {
        const long L = (long)i * G + c; if (L >= nwg) return false;
        int wgid = (int)L; { const int q = nwg / NXCD, r = nwg % NXCD, xcd = wgid % NXCD, off = wgid / NXCD; wgid = (xcd < r ? xcd * (q + 1) : r * (q + 1) + (xcd - r) * q) + off; }
        const int nig = WGM * nN, gid = wgid / nig, fm = gid * WGM, gsz = (nM - fm) < WGM ? (nM - fm) : WGM;
        u.pm = fm + ((wgid % nig) % gsz); u.pn = (wgid % nig) / gsz; u.pb = u.pn; u.e = 0; return true;
    }
    __device__ __forceinline__ unsigned arow(const Unit&, int) const { return 0u; }
};

template <class Epi, class Sched>
__device__ __forceinline__ void gemm_phase(LAS unsigned char* lds, const Gemm g, const Sched& S, const Epi& E) {
    constexpr bool GATHER = Sched::GATHER;
    const int tid = threadIdx.x, wid = __builtin_amdgcn_readfirstlane(tid >> 6), lane = tid & 63, wr = wid >> 2, wc = wid & 3, fr = lane & 15, fq = lane >> 4;
    const int K = g.K, nt = K / BK;
    unsigned voffB[2]; int RA[2], CA[2];
#pragma unroll
    for (int i = 0; i < 2; ++i) { int R_, C_; stage_rc(tid * 16 + i * 8192, R_, C_); const int Rb = Epi::PERM ? ((R_ & ~31) + perm32(R_ & 31)) : R_;
        RA[i] = R_; CA[i] = C_; voffB[i] = (unsigned)(Rb * K + C_) * 2u; }
    const size_t kstep = (size_t)(BK * 2);
    const size_t hstep = (size_t)HALF * K * 2;
    const size_t tstep = 2 * hstep;
    const unsigned ldsw = (unsigned)wid * 1024u;
    const int aoff = lds_byte(wr * 64 + fr, fq * 8), boff = lds_byte(wc * 32 + fr, fq * 8);
#define PG8_SA(b, h) (((b) * 2 + (h)) * HTB)
#define PG8_SB(b, h) ((4 + (b) * 2 + (h)) * HTB)
#define PG8_STAGE(bufoff, gbase, voff) do { _Pragma("unroll") for (int _i = 0; _i < 2; ++_i) \
        __builtin_amdgcn_global_load_lds((const unsigned*)((const char*)(gbase) + (voff)[_i]), (LAS unsigned*)(lds + (bufoff) + ldsw + _i * 8192), 16, 0, 0); } while (0)
#define PG8_LDA(dst, b, h) do { _Pragma("unroll") for (int m = 0; m < 4; ++m) _Pragma("unroll") for (int k = 0; k < 2; ++k) dst[m][k] = *(const LAS bf16x8*)(lds + PG8_SA(b, h) + aoff + m * 2048 + k * 1024); } while (0)
#define PG8_LDB(dst, b, h) do { _Pragma("unroll") for (int n = 0; n < 2; ++n) _Pragma("unroll") for (int k = 0; k < 2; ++k) dst[n][k] = *(const LAS bf16x8*)(lds + PG8_SB(b, h) + boff + n * 2048 + k * 1024); } while (0)
#define PG8_MMA(ai, bj, At, Bt) do { __builtin_amdgcn_s_setprio(1); _Pragma("unroll") for (int m = 0; m < 4; ++m) _Pragma("unroll") for (int n = 0; n < 2; ++n) _Pragma("unroll") for (int k = 0; k < 2; ++k) \
        acc[ai][bj][m][n] = __builtin_amdgcn_mfma_f32_16x16x32_bf16(Bt[n][k], At[m][k], acc[ai][bj][m][n], 0, 0, 0); __builtin_amdgcn_s_setprio(0); } while (0)
#define PG8_WAIT_V(n) asm volatile("s_waitcnt vmcnt(" #n ")" ::: "memory")
#define PG8_WAIT_L(n) asm volatile("s_waitcnt lgkmcnt(" #n ")" ::: "memory")
#define PG8_BAR __builtin_amdgcn_s_barrier()
#define PG8_SCHED __builtin_amdgcn_sched_barrier(0)
#define PG8_AOFFS(dst, u) do { _Pragma("unroll") for (int _h = 0; _h < 2; ++_h) _Pragma("unroll") for (int _i = 0; _i < 2; ++_i) { \
        if constexpr (GATHER) dst[_h][_i] = (S.arow(u, _h * HALF + RA[_i]) * (unsigned)K + (unsigned)CA[_i]) * 2u; \
        else dst[_h][_i] = ((unsigned)((_h * HALF + RA[_i]) * K + CA[_i])) * 2u; } } while (0)
    Unit cur, nxt; int ui = 0;
    if (!S.next(0, cur)) return;
    f32x4 acc[2][2][4][2];
#pragma unroll
    for (int a = 0; a < 2; ++a)
#pragma unroll
        for (int b = 0; b < 2; ++b)
#pragma unroll
            for (int m = 0; m < 4; ++m)
#pragma unroll
                for (int n = 0; n < 2; ++n) acc[a][b][m][n] = (f32x4){0.f, 0.f, 0.f, 0.f};
    bf16x8 At[4][2], B0[2][2], B1[2][2];
    unsigned vAc[2][2], vAn[2][2];
    PG8_AOFFS(vAc, cur);
    const char* cA = GATHER ? (const char*)g.A : (const char*)g.A + (size_t)cur.pm * tstep; const char* cB = (const char*)g.Bt + (size_t)cur.pb * tstep;
    PG8_STAGE(PG8_SB(0, 0), cB, voffB); PG8_STAGE(PG8_SB(0, 1), cB + hstep, voffB); PG8_STAGE(PG8_SA(0, 0), cA, vAc[0]); PG8_STAGE(PG8_SA(0, 1), cA, vAc[1]);
    if (wr == 1) PG8_BAR;
    PG8_WAIT_V(2); PG8_BAR;
    PG8_STAGE(PG8_SB(1, 0), cB + kstep, voffB); PG8_STAGE(PG8_SA(1, 0), cA + kstep, vAc[0]); PG8_STAGE(PG8_SB(1, 1), cB + hstep + kstep, voffB);
    PG8_WAIT_V(6); PG8_BAR;
    for (;;) {
        const bool has_next = S.next(ui + 1, nxt);
        if (has_next) { PG8_AOFFS(vAn, nxt); } else {
#pragma unroll
            for (int _h = 0; _h < 2; ++_h)
#pragma unroll
                for (int _i = 0; _i < 2; ++_i) vAn[_h][_i] = vAc[_h][_i]; }
        const char* nA = has_next ? (GATHER ? (const char*)g.A : (const char*)g.A + (size_t)nxt.pm * tstep) : cA; const char* nB = has_next ? (const char*)g.Bt + (size_t)nxt.pb * tstep : cB;
#pragma unroll 1
        for (int t = 0; t < nt; t += 2) {
            const bool last = (t == nt - 2);
            const char* a1 = cA + (size_t)(t + 1) * kstep;
            const char* a2 = last ? nA : cA + (size_t)(t + 2) * kstep; const char* b2 = last ? nB : cB + (size_t)(t + 2) * kstep;
            const char* a3 = a2 + kstep; const char* b3 = b2 + kstep;
            unsigned v2[2][2];
#pragma unroll
            for (int _h = 0; _h < 2; ++_h)
#pragma unroll
                for (int _i = 0; _i < 2; ++_i) v2[_h][_i] = last ? vAn[_h][_i] : vAc[_h][_i];
            PG8_LDB(B0, 0, 0); PG8_LDB(B1, 0, 1); PG8_SCHED; PG8_LDA(At, 0, 0); PG8_STAGE(PG8_SA(1, 1), a1, vAc[1]);
            PG8_WAIT_V(8); PG8_WAIT_L(0); PG8_BAR; PG8_MMA(0, 0, At, B0); PG8_MMA(0, 1, At, B1); PG8_BAR; PG8_SCHED;
            PG8_LDA(At, 0, 1); PG8_STAGE(PG8_SB(0, 0), b2, voffB); PG8_STAGE(PG8_SB(0, 1), b2 + hstep, voffB); PG8_STAGE(PG8_SA(0, 0), a2, v2[0]);
            PG8_WAIT_V(8); PG8_WAIT_L(0); PG8_BAR; PG8_MMA(1, 0, At, B0); PG8_MMA(1, 1, At, B1); PG8_BAR; PG8_SCHED;
            PG8_LDB(B0, 1, 0); PG8_LDB(B1, 1, 1); PG8_SCHED; PG8_LDA(At, 1, 0); PG8_STAGE(PG8_SA(0, 1), a2, v2[1]);
            PG8_WAIT_V(8); PG8_WAIT_L(0); PG8_BAR; PG8_MMA(0, 0, At, B0); PG8_MMA(0, 1, At, B1); PG8_BAR; PG8_SCHED;
            PG8_LDA(At, 1, 1); PG8_STAGE(PG8_SB(1, 0), b3, voffB); PG8_STAGE(PG8_SB(1, 1), b3 + hstep, voffB); PG8_STAGE(PG8_SA(1, 0), a3, v2[0]);
            PG8_WAIT_V(8); PG8_WAIT_L(0); PG8_BAR; PG8_MMA(1, 0, At, B0); PG8_MMA(1, 1, At, B1); PG8_BAR; PG8_SCHED;
        }
        if (wr == 0) PG8_BAR;
        E(acc, cur, wr, wc, fr, fq);
        if (!has_next) break;
#pragma unroll
        for (int a = 0; a < 2; ++a)
#pragma unroll
            for (int b = 0; b < 2; ++b)
#pragma unroll
                for (int m = 0; m < 4; ++m)
#pragma unroll
                    for (int n = 0; n < 2; ++n) acc[a][b][m][n] = (f32x4){0.f, 0.f, 0.f, 0.f};
        cur = nxt; cA = nA; cB = nB; ++ui;
#pragma unroll
        for (int _h = 0; _h < 2; ++_h)
#pragma unroll
            for (int _i = 0; _i < 2; ++_i) vAc[_h][_i] = vAn[_h][_i];
        if (wr == 1) PG8_BAR;
    }
    PG8_WAIT_V(0);
    PG8_BAR;
#undef PG8_SA
#undef PG8_SB
#undef PG8_STAGE
#undef PG8_LDA
#undef PG8_LDB
#undef PG8_MMA
#undef PG8_WAIT_V
#undef PG8_WAIT_L
#undef PG8_BAR
#undef PG8_SCHED
#undef PG8_AOFFS
}
}
namespace att {
constexpr int NW = 8, QBLK = 32, KVBLK = 64, DV = 128;
#define KSWZ(row, colB, RS) ((row) * (RS) + ((colB) ^ (((row) & 7) << 4)))
#define SBAR() __builtin_amdgcn_sched_barrier(0)
__device__ __forceinline__ int crow(int r, int hi) { return (r & 3) + 8 * (r >> 2) + 4 * hi; }
constexpr float THR = 8.f;
constexpr float LOG2E = 1.4426950408889634f;

__device__ __forceinline__ void partialSM(f32x16& p0, f32x16& p1, float& m_reg, float& mn, float& alpha) {
  constexpr float C = LOG2E;
  float pmax = p0[0];
#pragma unroll
  for (int r = 1; r < 16; ++r) pmax = fmaxf(pmax, p0[r]);
#pragma unroll
  for (int r = 0; r < 16; ++r) pmax = fmaxf(pmax, p1[r]);
  { auto rr = __builtin_amdgcn_permlane32_swap(__float_as_uint(pmax), __float_as_uint(pmax), false, false);
    pmax = fmaxf(__uint_as_float(rr[0]), __uint_as_float(rr[1])); }
  if (__builtin_expect(__all(pmax - m_reg <= THR), 1)) { mn = m_reg; alpha = 1.f; }
  else { mn = fmaxf(m_reg, pmax); alpha = __builtin_amdgcn_exp2f((m_reg - mn) * C); m_reg = mn; }
  float mnC = -mn * C;
#pragma unroll
  for (int r = 0; r < 16; ++r) p0[r] = fmaf(p0[r], C, mnC);
#pragma unroll
  for (int r = 0; r < 16; ++r) p1[r] = fmaf(p1[r], C, mnC);
#pragma unroll
  for (int r = 0; r < 16; ++r) p0[r] = __builtin_amdgcn_exp2f(p0[r]);
}
__device__ __forceinline__ void finishSM(f32x16& p0, f32x16& p1, float alpha, float& l_reg, bf16x8& pa0, bf16x8& pa1, bf16x8& pa2, bf16x8& pa3) {
#pragma unroll
  for (int r = 0; r < 16; ++r) p1[r] = __builtin_amdgcn_exp2f(p1[r]);
  float ps = 0;
#pragma unroll
  for (int r = 0; r < 16; ++r) ps += p0[r];
#pragma unroll
  for (int r = 0; r < 16; ++r) ps += p1[r];
  { auto rr = __builtin_amdgcn_permlane32_swap(__float_as_uint(ps), __float_as_uint(ps), false, false);
    ps = __uint_as_float(rr[0]) + __uint_as_float(rr[1]); }
  l_reg = l_reg * alpha + ps;
#define PK4(P, BASE, OUT) do { unsigned a0 = cvt_pk_bf16(P[BASE + 0], P[BASE + 1]), a1 = cvt_pk_bf16(P[BASE + 2], P[BASE + 3]);   \
    unsigned b0 = cvt_pk_bf16(P[BASE + 4], P[BASE + 5]), b1 = cvt_pk_bf16(P[BASE + 6], P[BASE + 7]);                              \
    auto r0 = __builtin_amdgcn_permlane32_swap(a0, b0, false, false); auto r1 = __builtin_amdgcn_permlane32_swap(a1, b1, false, false); \
    u32x4 w = {r0[0], r1[0], r0[1], r1[1]}; OUT = *reinterpret_cast<bf16x8*>(&w); } while (0)
  PK4(p0, 0, pa0); PK4(p0, 8, pa1); PK4(p1, 0, pa2); PK4(p1, 8, pa3);
#undef PK4
}
template <int DQK, int QL>
__device__ __forceinline__ void qkt(f32x16& p0, f32x16& p1, const char* Ks, const bf16x8* qr, const char* qlds, int r32, int hi) {
  p0 = f32x16{}; p1 = f32x16{};
  constexpr int NQ = DQK / 16, NR = NQ - QL;
#pragma unroll
  for (int d0 = 0; d0 < NQ; ++d0) { int cb = (d0 * 16 + hi * 8) * 2;
    bf16x8 b0 = *reinterpret_cast<const bf16x8*>(Ks + KSWZ(r32, cb, DQK * 2));
    bf16x8 b1 = *reinterpret_cast<const bf16x8*>(Ks + KSWZ(32 + r32, cb, DQK * 2));
    bf16x8 q; if (d0 < NR) q = qr[d0 < NR ? d0 : 0]; else q = *reinterpret_cast<const bf16x8*>(qlds + (d0 - NR) * 1024);
    p0 = __builtin_amdgcn_mfma_f32_32x32x16_bf16(b0, q, p0, 0, 0, 0);
    p1 = __builtin_amdgcn_mfma_f32_32x32x16_bf16(b1, q, p1, 0, 0, 0);
    if ((d0 & 1) == 1) asm volatile("" ::: "memory"); }
}
__device__ __forceinline__ int v_st(int k, int c) { const int kk = (k & ~0xC) | ((k & 4) << 1) | ((k & 8) >> 1); return ((kk >> 3) * 4 + (c >> 5)) * 512 + ((kk & 7) * 32 + (c & 31)) * 2; }
__device__ __forceinline__ int v_rd_base(int lane) { return ((lane & 3) << 3) | (((lane >> 2) & 3) << 6) | (((lane >> 4) & 1) << 5) | (((lane >> 5) & 1) << 8); }
constexpr int v_rd_off(int d0, int ks, int half) { return d0 * 512 + ks * 4096 + half * 2048; }
template <int OFF> __device__ __forceinline__ s16x4 tr_read(int vb) {
  s16x4 r; asm volatile("ds_read_b64_tr_b16 %0, %1 offset:%2" : "=&v"(r) : "v"(vb), "i"(OFF) : "memory"); return r;
}
template <int D0> __device__ __forceinline__ void pv_one(f32x16& od, int vb, bf16x8 pa0, bf16x8 pa1, bf16x8 pa2, bf16x8 pa3) {
  const s16x4 l0 = tr_read<v_rd_off(D0, 0, 0)>(vb), h0 = tr_read<v_rd_off(D0, 0, 1)>(vb), l1 = tr_read<v_rd_off(D0, 1, 0)>(vb), h1 = tr_read<v_rd_off(D0, 1, 1)>(vb);
  const s16x4 l2 = tr_read<v_rd_off(D0, 2, 0)>(vb), h2 = tr_read<v_rd_off(D0, 2, 1)>(vb), l3 = tr_read<v_rd_off(D0, 3, 0)>(vb), h3 = tr_read<v_rd_off(D0, 3, 1)>(vb);
  asm volatile("s_waitcnt lgkmcnt(0)" ::: "memory"); SBAR();
#define PK(L, H) (bf16x8){L[0], L[1], L[2], L[3], H[0], H[1], H[2], H[3]}
  od = __builtin_amdgcn_mfma_f32_32x32x16_bf16(pa0, PK(l0, h0), od, 0, 0, 0);
  od = __builtin_amdgcn_mfma_f32_32x32x16_bf16(pa1, PK(l1, h1), od, 0, 0, 0);
  od = __builtin_amdgcn_mfma_f32_32x32x16_bf16(pa2, PK(l2, h2), od, 0, 0, 0);
  od = __builtin_amdgcn_mfma_f32_32x32x16_bf16(pa3, PK(l3, h3), od, 0, 0, 0);
#undef PK
}
__device__ __forceinline__ void pv_d0(f32x16* o, int vb, bf16x8 pa0, bf16x8 pa1, bf16x8 pa2, bf16x8 pa3) {
  pv_one<0>(o[0], vb, pa0, pa1, pa2, pa3); pv_one<1>(o[1], vb, pa0, pa1, pa2, pa3); pv_one<2>(o[2], vb, pa0, pa1, pa2, pa3); pv_one<3>(o[3], vb, pa0, pa1, pa2, pa3);
}
template <int DQK> struct Shm { static constexpr int V = KVBLK * DV * 2, K = KVBLK * DQK * 2, QL = (DQK > 128 ? (DQK - 128) / 16 : 0), TOTAL = 3 * V + 3 * K + NW * 64 * 4 + QL * NW * 1024; };

template <int DQK, int LDQ, int LDK, int LDV, int LDO>
__device__ __forceinline__ void attn_dense_body(const bf16* __restrict__ Qb, const bf16* __restrict__ Kh, const bf16* __restrict__ Vh, bf16* __restrict__ Ob, int seq, char* lds) {
  constexpr int SHM_V = Shm<DQK>::V, SHM_K = Shm<DQK>::K, NQ = DQK / 16, QL = Shm<DQK>::QL, NR = NQ - QL, KP = DQK / 64  , KROWB = DQK * 2;
  const int tid = threadIdx.x, wid = __builtin_amdgcn_readfirstlane(tid >> 6), lane = tid & 63, r32 = lane & 31, hi = lane >> 5;
  char* K_lds = lds; char* V_lds = lds + 3 * SHM_K;
  float* ws = (float*)(lds + 3 * SHM_V + 3 * SHM_K) + wid * 64; float* li_l = ws; float* al_l = ws + 32;
  float m_reg = -1e30f, l_reg = 0; f32x16 o[4] = {}; bf16x8 qr[NR];
  char* qlds = lds + 3 * SHM_V + 3 * SHM_K + NW * 64 * 4 + wid * (QL * 1024) + lane * 16;
  const bf16* Qw = Qb + (long)(wid * QBLK + r32) * LDQ + hi * 8;
#pragma unroll
  for (int d0 = 0; d0 < NQ; ++d0) { const bf16x8 qv = *reinterpret_cast<const bf16x8*>(Qw + d0 * 16); if (d0 < NR) qr[d0 < NR ? d0 : 0] = qv; else *reinterpret_cast<bf16x8*>(qlds + (d0 - NR) * 1024) = qv; }
  unsigned koff[KP], voff[2];
#pragma unroll
  for (int i = 0; i < KP; ++i) { const int ob = 16 * (tid + 512 * i), row = ob / KROWB, cbs = ob % KROWB, cb = cbs ^ ((row & 7) << 4); koff[i] = (unsigned)(row * LDK * 2 + cb); }
#pragma unroll
  for (int i = 0; i < 2; ++i) { const int ob = 16 * (tid + 512 * i), sub = ob >> 9, rem = ob & 511, kk = (sub >> 2) * 8 + (rem >> 6), cc = (sub & 3) * 32 + ((rem & 63) >> 1);
    const int k = (kk & ~0xC) | ((kk & 4) << 1) | ((kk & 8) >> 1); voff[i] = (unsigned)(k * LDV * 2 + cc * 2); }
  const int vb0 = (int)(uintptr_t)V_lds + v_rd_base(lane);
  const int NT = seq / KVBLK;
#define KDMA(t_, slot_) do { const int _tt = (t_) < NT ? (t_) : NT - 1; const char* _b = (const char*)Kh + (size_t)_tt * (KVBLK * LDK * 2); \
    _Pragma("unroll") for (int _q = 0; _q < KP; ++_q) __builtin_amdgcn_global_load_lds((const unsigned*)(_b + koff[_q]), (LAS unsigned*)(K_lds + (slot_) * SHM_K + _q * 8192 + wid * 1024), 16, 0, 0); } while (0)
#define VDMA(t_, slot_) do { const int _tt = (t_) < NT ? (t_) : NT - 1; const char* _b = (const char*)Vh + (size_t)_tt * (KVBLK * LDV * 2); \
    _Pragma("unroll") for (int _q = 0; _q < 2; ++_q) __builtin_amdgcn_global_load_lds((const unsigned*)(_b + voff[_q]), (LAS unsigned*)(V_lds + (slot_) * SHM_V + _q * 8192 + wid * 1024), 16, 0, 0); } while (0)
#define WAITB() do { asm volatile("s_waitcnt vmcnt(%0)" :: "n"(KP + 2) : "memory"); __builtin_amdgcn_s_barrier(); asm volatile("" ::: "memory"); SBAR(); } while (0)
#define RESC(a) do { if (__any((a) < 1.f)) { if (hi == 0) al_l[r32] = (a); asm volatile("s_waitcnt lgkmcnt(0)" ::: "memory"); \
    _Pragma("unroll") for (int d = 0; d < 4; ++d) _Pragma("unroll") for (int r = 0; r < 16; ++r) o[d][r] *= al_l[crow(r, hi)]; } } while (0)
  f32x16 pA0, pA1, pB0, pB1; float mnA, mnB, alA, alB; bf16x8 pa0, pa1, pa2, pa3;
  KDMA(0, 0); KDMA(1, 1); VDMA(0, 0); KDMA(2, 2); VDMA(1, 1);
  asm volatile("s_waitcnt vmcnt(%0)" :: "n"(2 * (KP + 2)) : "memory"); __builtin_amdgcn_s_barrier(); asm volatile("" ::: "memory"); SBAR();
  int s0 = 0, s1 = 1, s2 = 2;
#define STEP(t_, X0, X1, mnX, alX, Y0, Y1, alY, HASPREV) do { \
    if (HASPREV) { finishSM(Y0, Y1, alY, l_reg, pa0, pa1, pa2, pa3); } \
    SBAR(); qkt<DQK, QL>(X0, X1, K_lds + s0 * SHM_K, qr, qlds, r32, hi); SBAR(); \
    if (HASPREV) { pv_d0(o, vb0 + s2 * SHM_V, pa0, pa1, pa2, pa3); } \
    partialSM(X0, X1, m_reg, mnX, alX); \
    WAITB(); \
    KDMA((t_) + 3, s0); VDMA((t_) + 2, s2); \
    RESC(alX); \
    { const int _r = s0; s0 = s1; s1 = s2; s2 = _r; } } while (0)
  for (int t = 0; t < NT; t += 2) {
    STEP(t, pA0, pA1, mnA, alA, pB0, pB1, alB, t > 0);
    STEP(t + 1, pB0, pB1, mnB, alB, pA0, pA1, alA, true);
  }
  finishSM(pB0, pB1, alB, l_reg, pa0, pa1, pa2, pa3); SBAR();
  pv_d0(o, vb0 + s2 * SHM_V, pa0, pa1, pa2, pa3);
  if (hi == 0) li_l[r32] = l_reg; asm volatile("s_waitcnt lgkmcnt(0)" ::: "memory");
  float rli[16];
#pragma unroll
  for (int r = 0; r < 16; ++r) rli[r] = __builtin_amdgcn_rcpf(li_l[crow(r, hi)]);
  bf16* Ow = Ob + (long)(wid * QBLK) * LDO;
#pragma unroll
  for (int r = 0; r < 16; ++r) { int orow = crow(r, hi);
#pragma unroll
    for (int d0 = 0; d0 < 4; ++d0) Ow[(long)orow * LDO + d0 * 32 + r32] = f2bf(o[d0][r] * rli[r]); }
  asm volatile("s_waitcnt vmcnt(0)" ::: "memory"); __builtin_amdgcn_s_barrier(); asm volatile("" ::: "memory");
  (void)mnA; (void)mnB;
#undef KDMA
#undef VDMA
#undef WAITB
#undef RESC
#undef STEP
}
}
constexpr size_t MiB = 1u << 20;
constexpr size_t WS_CTL = 0, CTL_ZERO_BYTES = 1 * MiB;
constexpr size_t WS_MODS = 1 * MiB;
constexpr size_t WS_TAB_RET = 2 * MiB;
constexpr size_t WS_TAB_A128 = 4 * MiB + 512 * 1024;
constexpr size_t WS_TAB_A64 = WS_TAB_A128 + 16384;
constexpr size_t WS_WABIN = 6 * MiB, WS_WABOUT = 12 * MiB, WS_WMLAIN = 14 * MiB, WS_WUQ = 16 * MiB, WS_WUKV = 18 * MiB, WS_WMLAOUT = 19 * MiB;
constexpr size_t WS_WUP = 22 * MiB, WS_WDOWN = 278 * MiB;
constexpr size_t WS_X = 406 * MiB, WS_ACC = 542 * MiB, WS_H = 678 * MiB, WS_P = 746 * MiB, WS_MIX = 950 * MiB;
constexpr size_t WS_KZTF = 1018 * MiB, WS_KZTB = 1052 * MiB, WS_VBT = 1086 * MiB, WS_ST = 1120 * MiB;
constexpr size_t WS_LTOK = 1188 * MiB, WS_LGATE = 1205 * MiB, WS_TOKSLOT = 1222 * MiB, WS_ACT = 1223 * MiB, WS_YK = 1511 * MiB, WS_END = 1799 * MiB;
constexpr size_t WS_PM = WS_P, WS_CQ = WS_P + 51 * MiB, WS_CKV = WS_CQ + 25 * MiB + 512 * 1024, WS_QM = WS_CKV + 17 * MiB;
constexpr size_t WS_KM = WS_KZTF, WS_VM = WS_ST;
static_assert(WS_QM + (size_t)R * UQ_N * 2 <= WS_MIX, "MLA overlay fits in P");
static_assert(WS_KM + (size_t)R * UQ_N * 2 <= WS_ST && WS_VM + (size_t)R * 1024 * 2 <= WS_LTOK, "MLA K/V overlay");
static_assert(WS_ACT + (size_t)NSLOT_MAX * 1024 * 2 <= WS_YK && WS_YK + (size_t)NSLOT_MAX * 1024 * 2 <= WS_END, "MoE buffers");
constexpr int CW_TMO = 0, CW_BAR = 4096, CW_CNT = 16384;

constexpr int RING_BYTES = 131072;
constexpr int ATT_BYTES = 157696;
constexpr int XTRA_OFF = RING_BYTES;
constexpr int MISC_OFF = ATT_BYTES;
constexpr int LDS_BYTES = ATT_BYTES + 1024;
static_assert(att::Shm<192>::TOTAL <= ATT_BYTES && att::Shm<128>::TOTAL <= ATT_BYTES && LDS_BYTES <= 163840, "LDS map");

#define XB_TMO      128
#define XB_XCNT(j)  (256  + 64 * (j))
#define XB_XSUB(j)  (1280 + 64 * (j))
#define XB_XGEN(j)  (2304 + 64 * (j))
#define XB_TOP      3328
#define XB_TOPGEN   3392
#define XCD_BAR_WORDS 3456
#define XB_SPIN_CAP (1u << 22)
__device__ __forceinline__ unsigned xb_ld(unsigned* p)              { return __hip_atomic_load(p, __ATOMIC_RELAXED, __HIP_MEMORY_SCOPE_AGENT); }
__device__ __forceinline__ unsigned xb_add(unsigned* p, unsigned v) { return __hip_atomic_fetch_add(p, v, __ATOMIC_RELAXED, __HIP_MEMORY_SCOPE_AGENT); }
__device__ __forceinline__ unsigned xb_xcc_id() { return (unsigned)__builtin_amdgcn_s_getreg((3 << 11) | 20) & 0xFu; }
#define XB_SPIN(cond, bar) do { unsigned _sp = 0; while (cond) { __builtin_amdgcn_s_sleep(1); \
    if ((++_sp & 255u) == 0u) { if (xb_ld(&(bar)[XB_TMO])) break; if (_sp > XB_SPIN_CAP) { atomicAdd(&(bar)[XB_TMO], 1u); break; } } } } while (0)
struct XcdBarrier { unsigned* bar; unsigned x; volatile LAS unsigned* st; };
__device__ __forceinline__ XcdBarrier xcd_barrier_post(unsigned* bar, volatile LAS unsigned* st) {
    XcdBarrier b; b.bar = bar; b.x = xb_xcc_id(); b.st = st;
    if (threadIdx.x == 0) (void)xb_add(&bar[XB_XCNT(b.x)], 1u);
    return b;
}
__device__ __forceinline__ void xcd_barrier_complete(unsigned* bar, unsigned x, unsigned& nloc, unsigned& nx) {
    const unsigned G = gridDim.x * gridDim.y * gridDim.z;
    unsigned sum, cnt, mine, sp = 0u;
    for (;;) {
        sum = 0u; cnt = 0u; mine = 0u;
#pragma unroll
        for (unsigned j = 0; j < 16; ++j) { const unsigned c = xb_ld(&bar[XB_XCNT(j)]); sum += c; cnt += (c > 0u) ? 1u : 0u; mine = (j == x) ? c : mine; }
        if (sum == G) break;
        __builtin_amdgcn_s_sleep(1);
        if ((++sp & 255u) == 0u) { if (xb_ld(&bar[XB_TMO])) break; if (sp > XB_SPIN_CAP) { atomicAdd(&bar[XB_TMO], 1u); break; } }
    }
    nloc = mine > 0u ? mine : 1u; nx = cnt > 0u ? cnt : 1u;
}
__device__ __forceinline__ void xcd_barrier(const XcdBarrier& b) {
    asm volatile("s_waitcnt vmcnt(0)" ::: "memory");
    __syncthreads();
    if (threadIdx.x == 0) {
        unsigned* bar = b.bar;
        __builtin_amdgcn_s_waitcnt(0);
        unsigned nloc = b.st[0], nx = b.st[1];
        if (nloc == 0u) { xcd_barrier_complete(bar, b.x, nloc, nx); b.st[0] = nloc; b.st[1] = nx; }
        const unsigned old = xb_add(&bar[XB_XSUB(b.x)], 1u);
        const unsigned gen = old / nloc;
        if (old + 1u == (gen + 1u) * nloc) {
            __builtin_amdgcn_fence(__ATOMIC_RELEASE, "agent");
            asm volatile("s_waitcnt vmcnt(0)" ::: "memory");
            const unsigned og = xb_add(&bar[XB_TOP], 1u);
            const unsigned tg = og / nx;
            if (og + 1u == (tg + 1u) * nx) xb_add(&bar[XB_TOPGEN], 1u);
            else XB_SPIN(xb_ld(&bar[XB_TOPGEN]) == tg, bar);
            __builtin_amdgcn_fence(__ATOMIC_ACQUIRE, "agent");
            xb_add(&bar[XB_XGEN(b.x)], 1u);
            asm volatile("s_waitcnt vmcnt(0)" ::: "memory");
        } else {
            XB_SPIN(xb_ld(&bar[XB_XGEN(b.x)]) == gen, bar);
            __builtin_amdgcn_fence(__ATOMIC_ACQUIRE, "agent");
            asm volatile("s_waitcnt vmcnt(0)" ::: "memory");
        }
    }
    __syncthreads();
}

struct Args { const float* in[28]; float* out; unsigned char* ws; int ph_lo, ph_hi; };
struct Ctx { LAS unsigned char* lds; int tid, lane, wave, vcu, G, gw, NGW; };
enum { I_X = 0, I_C, I_CTX, I_CCTX, I_ADAW, I_ADAB, I_LN1G, I_LN1B, I_LN2G, I_LN2B, I_ABWIN, I_ABQN, I_ABKN, I_ABLD, I_ABGN, I_ABWOUT,
       I_MLAWIN, I_MLAQN, I_MLAKVN, I_MLAWUQ, I_MLAWUKV, I_MLAWOUT, I_RW, I_RB, I_WUP, I_BUP, I_WDOWN, I_BDOWN };
template <int MAP> __device__ __forceinline__ int colmap(int r) {
    if constexpr (MAP == 0) return r;
    else if constexpr (MAP == 1) { const int t = r >> 8, cc = r & 255; return cc < 128 ? t * 128 + cc : 1024 + t * 128 + (cc - 128); }
    else if constexpr (MAP == 2) return r < MLA_IN ? r : -1;
    else {
        if (r < 1024) { const int h = r >> 7, i = r & 127; return h * 192 + i; }
        const int rr = r - 1024, t = rr >> 8, cc = rr & 255, bj = cc >> 7, c2 = cc & 127, head = 4 * t + (c2 >> 5), j = c2 & 31;
        return head * 192 + 128 + (j < 16 ? j : 16 + j) + (bj ? 16 : 0);
    }
}
template <int MAP> __device__ __forceinline__ void tr_item(const float* __restrict__ W, int K, int N, bf16* __restrict__ WT, LAS float* scr, int item, int nblk, int lane) {
    const int kb = item / nblk, nb = item % nblk, k0 = 64 * kb, n0 = 32 * nb;
    const int col = colmap<MAP>(n0 + (lane & 31));
    const float* src = W + (size_t)(k0 + (lane >> 5)) * N + (col >= 0 ? col : 0);
#pragma unroll 8
    for (int i = 0; i < 32; ++i) { const int kk = 2 * i + (lane >> 5); const float v = src[(size_t)(2 * i) * N]; scr[kk * 33 + (lane & 31)] = col >= 0 ? v : 0.f; }
    LDS_WAIT(); asm volatile("" ::: "memory");
    const int c8 = lane & 7;
#pragma unroll
    for (int j = 0; j < 4; ++j) { const int n = (lane >> 3) + 8 * j; const LAS float* s = scr + (8 * c8) * 33 + n;
        u32x4 o; o.x = cvt_pk_bf16(s[0 * 33], s[1 * 33]); o.y = cvt_pk_bf16(s[2 * 33], s[3 * 33]); o.z = cvt_pk_bf16(s[4 * 33], s[5 * 33]); o.w = cvt_pk_bf16(s[6 * 33], s[7 * 33]);
        *(u32x4*)(WT + (size_t)(n0 + n) * K + k0 + 8 * c8) = o; }
    LDS_WAIT(); asm volatile("" ::: "memory");
}
__device__ __forceinline__ void ph0_prologue(const Args& a, const Ctx& c) {
    unsigned char* ws = a.ws;
    float* mods = (float*)(ws + WS_MODS);
    {
        LAS float* sc = (LAS float*)c.lds;
        for (int i = c.tid; i < 9 * 1024; i += 512) { const float v = (i < 8192) ? a.in[I_C][i] : a.in[I_CCTX][i - 8192]; sc[i] = v / (1.f + expf(-v)); }
        __syncthreads();
        if (c.gw < 192) {
            const int l = c.gw / 96, j = (c.gw % 96) * 64 + c.lane;
            const float* W = a.in[I_ADAW] + (size_t)l * 1024 * 6144 + j;
            float acc[9];
#pragma unroll
            for (int b = 0; b < 9; ++b) acc[b] = 0.f;
#pragma unroll 8
            for (int d = 0; d < 1024; ++d) { const float w = W[(size_t)d * 6144];
#pragma unroll
                for (int b = 0; b < 9; ++b) acc[b] = fmaf(sc[b * 1024 + d], w, acc[b]); }
            const float bias = a.in[I_ADAB][l * 6144 + j];
#pragma unroll
            for (int b = 0; b < 9; ++b) mods[(size_t)(l * 9 + b) * 6144 + j] = acc[b] + bias;
        }
        __syncthreads();
    }
    {
        float2* ret = (float2*)(ws + WS_TAB_RET); float2* a128 = (float2*)(ws + WS_TAB_A128); float2* a64 = (float2*)(ws + WS_TAB_A64);
        const int gt = c.gw * 64 + c.lane, NT = c.NGW * 64;
        for (int i = gt; i < SP * 64; i += NT) { const int pos = i >> 6, f = i & 63; const double ang = (double)pos * pow(10000.0, -(double)f / 64.0); ret[i] = make_float2((float)cos(ang), (float)sin(ang)); }
        for (int i = gt; i < 64 * 32; i += NT) { const int pos = i >> 5, f = i & 31; const double ang = (double)pos * pow(10000.0, -(double)f / 32.0); a128[i] = make_float2((float)cos(ang), (float)sin(ang)); }
        for (int i = gt; i < 64 * 16; i += NT) { const int pos = i >> 4, f = i & 15; const double ang = (double)pos * pow(10000.0, -(double)f / 16.0); a64[i] = make_float2((float)cos(ang), (float)sin(ang)); }
    }
    {
        LAS float* scr = (LAS float*)(c.lds + c.wave * 16384);
        constexpr int I0 = 16 * 96, I1 = 16 * 32, I2 = 16 * 24, I3 = 6 * 48, I4 = 4 * 64, I5 = 16 * 32, IUP = 16 * 64, IDN = 16 * 32;
        constexpr int NITEMS = I0 + I1 + I2 + I3 + I4 + I5 + 64 * IUP + 64 * IDN;
        for (int it = c.gw; it < NITEMS; it += c.NGW) {
            int r = it;
            if (r < I0) { tr_item<0>(a.in[I_ABWIN], 1024, AB_IN, (bf16*)(ws + WS_WABIN), scr, r, 96, c.lane); continue; } r -= I0;
            if (r < I1) { tr_item<0>(a.in[I_ABWOUT], 1024, 1024, (bf16*)(ws + WS_WABOUT), scr, r, 32, c.lane); continue; } r -= I1;
            if (r < I2) { tr_item<2>(a.in[I_MLAWIN], 1024, MLA_IN, (bf16*)(ws + WS_WMLAIN), scr, r, 24, c.lane); continue; } r -= I2;
            if (r < I3) { tr_item<3>(a.in[I_MLAWUQ], MLA_QL, UQ_N, (bf16*)(ws + WS_WUQ), scr, r, 48, c.lane); continue; } r -= I3;
            if (r < I4) { tr_item<0>(a.in[I_MLAWUKV], MLA_KVL, UKV_N, (bf16*)(ws + WS_WUKV), scr, r, 64, c.lane); continue; } r -= I4;
            if (r < I5) { tr_item<0>(a.in[I_MLAWOUT], 1024, 1024, (bf16*)(ws + WS_WMLAOUT), scr, r, 32, c.lane); continue; } r -= I5;
            if (r < 64 * IUP) { const int m = r / IUP; tr_item<1>(a.in[I_WUP] + (size_t)m * 1024 * 2048, 1024, 2048, (bf16*)(ws + WS_WUP) + (size_t)m * 2048 * 1024, scr, r % IUP, 64, c.lane); continue; } r -= 64 * IUP;
            { const int m = r / IDN; tr_item<0>(a.in[I_WDOWN] + (size_t)m * 1024 * 1024, 1024, 1024, (bf16*)(ws + WS_WDOWN) + (size_t)m * 1024 * 1024, scr, r % IDN, 32, c.lane); }
        }
    }
}

__device__ __forceinline__ void ph1_mod0(const Args& a, const Ctx& c) {
    const float* mods = (const float*)(a.ws + WS_MODS); bf16* H = (bf16*)(a.ws + WS_H);
    for (int row = c.gw; row < R; row += c.NGW) {
        const int b = row / SP, s = row % SP;
        const float* src = s < NCTX ? a.in[I_CTX] + ((size_t)b * NCTX + s) * D : a.in[I_X] + ((size_t)b * SEQ + (s - NCTX)) * D;
        const float* m = mods + (size_t)(s < NCTX ? 8 : b) * 6144;
        bf16* dst = H + (size_t)row * D;
#pragma unroll
        for (int j = 0; j < 4; ++j) { const int col = 4 * c.lane + 256 * j;
            const f32x4 x = *(const f32x4*)(src + col), sh = *(const f32x4*)(m + col), sl = *(const f32x4*)(m + 1024 + col);
            const f32x4 h = x * (sl + 1.0f) + sh;
            u32x2 o; o.x = cvt_pk_bf16(h[0], h[1]); o.y = cvt_pk_bf16(h[2], h[3]); *(u32x2*)(dst + col) = o; }
    }
}

__device__ __forceinline__ void st16(void* base, unsigned off, u32x4 v) { *(u32x4*)((char*)base + off) = v; }
__device__ __forceinline__ void st8(void* base, unsigned off, u32x2 v) { *(u32x2*)((char*)base + off) = v; }
__device__ __forceinline__ u32x4 pack2x4(const f32x4 v0, const f32x4 v1) { u32x4 w; w.x = cvt_pk_bf16(v0[0], v0[1]); w.y = cvt_pk_bf16(v0[2], v0[3]); w.z = cvt_pk_bf16(v1[0], v1[1]); w.w = cvt_pk_bf16(v1[2], v1[3]); return w; }
struct EpiStoreBf16 {
    static constexpr bool PERM = true;
    bf16* O; int ldc;
    __device__ __forceinline__ void operator()(const f32x4 (&acc)[2][2][4][2], const pg8::Unit& u, int wr, int wc, int fr, int fq) const {
        const unsigned rb = ((unsigned)(u.pm * 256 + wr * 64 + fr) * (unsigned)ldc + (unsigned)(u.pn * 256 + wc * 32 + 8 * fq)) * 2u;
#pragma unroll
        for (int ai = 0; ai < 2; ++ai)
#pragma unroll
            for (int m = 0; m < 4; ++m) { const unsigned ro = rb + (unsigned)((ai * 128 + m * 16) * ldc) * 2u;
#pragma unroll
                for (int bj = 0; bj < 2; ++bj) st16(O, ro + bj * 256, pack2x4(acc[ai][bj][m][0], acc[ai][bj][m][1])); }
    }
};
template <int L> struct EpiResid {
    static constexpr bool PERM = false;
    const float* xlat; const float* xctx; const float* X; const float* mods  ; float* ACC;
    __device__ __forceinline__ void operator()(const f32x4 (&acc)[2][2][4][2], const pg8::Unit& u, int wr, int wc, int fr, int fq) const {
        const int b = u.pm / 17, tt = u.pm % 17; const bool isc = (tt == 0);
        const float* src; if constexpr (L == 0) src = isc ? xctx + (size_t)b * NCTX * D : xlat + ((size_t)b * SEQ + (size_t)(tt - 1) * 256) * D; else src = X + (size_t)u.pm * 256 * D;
        const float* m2 = mods + (size_t)(isc ? 8 : b) * 6144 + 2 * 1024;
        float* dst = ACC + (size_t)u.pm * 256 * D;
        const int col0 = u.pn * 256 + wc * 32 + 4 * fq;
        const unsigned rb = ((unsigned)(wr * 64 + fr) * D + (unsigned)col0) * 4u;
        f32x4 mv[2][2];
#pragma unroll
        for (int bj = 0; bj < 2; ++bj)
#pragma unroll
            for (int n = 0; n < 2; ++n) mv[bj][n] = *(const f32x4*)(m2 + col0 + bj * 128 + n * 16);
#pragma unroll
        for (int ai = 0; ai < 2; ++ai)
#pragma unroll
            for (int m = 0; m < 4; ++m) { const unsigned ro = rb + (unsigned)((ai * 128 + m * 16) * D) * 4u;
#pragma unroll
                for (int bj = 0; bj < 2; ++bj)
#pragma unroll
                    for (int n = 0; n < 2; ++n) { const unsigned o = ro + (bj * 128 + n * 16) * 4;
                        const f32x4 xv = *(const f32x4*)((const char*)src + o);
                        *(f32x4*)((char*)dst + o) = xv * DN_ALPHA + mv[bj][n] * acc[ai][bj][m][n]; } }
    }
};
__device__ __forceinline__ void unpack8(const u32x4 w, float* v) { v[0] = bflo(w.x); v[1] = bfhi(w.x); v[2] = bflo(w.y); v[3] = bfhi(w.y); v[4] = bflo(w.z); v[5] = bfhi(w.z); v[6] = bflo(w.w); v[7] = bfhi(w.w); }
__device__ __forceinline__ u32x4 pack8(const float* v) { u32x4 w; w.x = cvt_pk_bf16(v[0], v[1]); w.y = cvt_pk_bf16(v[2], v[3]); w.z = cvt_pk_bf16(v[4], v[5]); w.w = cvt_pk_bf16(v[6], v[7]); return w; }
__device__ __forceinline__ float log_gamma_of(float log_decay) { return (float)log1p(-exp((double)log_decay)); }

__device__ __forceinline__ void ph3_post(const Args& a, const Ctx& c) {
    bf16* P = (bf16*)(a.ws + WS_P);
    const float2* RET = (const float2*)(a.ws + WS_TAB_RET); const float2* A128 = (const float2*)(a.ws + WS_TAB_A128);
    const float* qn = a.in[I_ABQN]; const float* kn = a.in[I_ABKN]; const float* ld = a.in[I_ABLD];
    bf16* KZTF = (bf16*)(a.ws + WS_KZTF); bf16* KZTB = (bf16*)(a.ws + WS_KZTB); bf16* VBT = (bf16*)(a.ws + WS_VBT);
    LAS bf16* T0 = (LAS bf16*)c.lds; LAS bf16* T1 = T0 + 128 * 72;
    const int tok = c.tid >> 3, j = c.tid & 7;
    constexpr float QK_SCALE = 0.08838834764831845f;
    for (int u = c.vcu; u < (R / 64) * 18; u += c.G) {
        const int rb = u / 18, kind = u % 18;
        const int row0 = rb * 64, b0 = row0 / SP, s0 = row0 % SP;
        const int row = row0 + tok, s = s0 + tok; const bool lat = s0 >= NCTX;
        bf16* prow = P + (size_t)row * AB_IN;
        if (kind < 14) {
            int cb, x1c, x2c;
            if (kind < 6) { cb = kind * 128; x1c = j < 4 ? 8 * j : 64 + 8 * (j - 4); x2c = x1c + 32; }
            else { cb = 1024 + (kind - 6) * 128; x1c = 8 * j; x2c = 64 + 8 * j; }
            float v1[8], v2[8], o1[8], o2[8];
            unpack8(*(const u32x4*)(prow + cb + x1c), v1); unpack8(*(const u32x4*)(prow + cb + x2c), v2);
            if (kind < 6) {
                float ss = 0.f;
#pragma unroll
                for (int i = 0; i < 8; ++i) ss += v1[i] * v1[i] + v2[i] * v2[i];
                ss += __shfl_xor(ss, 1); ss += __shfl_xor(ss, 2); ss += __shfl_xor(ss, 4);
                const float rinv = rsqrtf(ss * (1.f / 128.f) + 1e-6f);
                const float* g = kind < 4 ? qn : kn;
#pragma unroll
                for (int i = 0; i < 8; ++i) { v1[i] *= rinv * g[x1c + i]; v2[i] *= rinv * g[x2c + i]; }
                if (lat) { const int t = s - NCTX; const int pos = j < 4 ? t / GRID_W : t % GRID_W; const float2* cs = A128 + pos * 32 + (j & 3) * 8;
#pragma unroll
                    for (int i = 0; i < 8; ++i) { const float2 q = cs[i]; o1[i] = v1[i] * q.x - v2[i] * q.y; o2[i] = v1[i] * q.y + v2[i] * q.x; } }
                else {
#pragma unroll
                    for (int i = 0; i < 8; ++i) { o1[i] = v1[i]; o2[i] = v2[i]; } }
                if (kind < 4) {
#pragma unroll
                    for (int i = 0; i < 8; ++i) { o1[i] *= QK_SCALE; o2[i] *= QK_SCALE; } }
            } else {
                const float2* cs = RET + (size_t)s * 64 + 8 * j;
#pragma unroll
                for (int i = 0; i < 8; ++i) { const float2 q = cs[i]; o1[i] = v1[i] * q.x - v2[i] * q.y; o2[i] = v1[i] * q.y + v2[i] * q.x; }
                if (kind < 10) {
#pragma unroll
                    for (int i = 0; i < 8; ++i) { o1[i] *= QK_SCALE; o2[i] *= QK_SCALE; } }
            }
            *(u32x4*)(prow + cb + x1c) = pack8(o1); *(u32x4*)(prow + cb + x2c) = pack8(o2);
            if (kind >= 10) {
                const int h = kind - 10;
                const float lgf = log_gamma_of(ld[h]), lgb = log_gamma_of(ld[4 + h]);
                const int cpos = s & 127;
                const float zf = expf(lgf * (float)(127 - cpos)), zb = expf(lgb * (float)cpos);
#pragma unroll
                for (int i = 0; i < 8; ++i) { T0[(x1c + i) * 72 + tok] = f2bf(o1[i] * zf); T0[(x2c + i) * 72 + tok] = f2bf(o2[i] * zf);
                                              T1[(x1c + i) * 72 + tok] = f2bf(o1[i] * zb); T1[(x2c + i) * 72 + tok] = f2bf(o2[i] * zb); }
                __syncthreads();
#pragma unroll
                for (int q = 0; q < 2; ++q) { const int p = c.tid + 512 * q, d = p >> 3, seg = p & 7;
                    const size_t go = ((size_t)((b0 * 4 + h) * 128 + d)) * SP + s0 + seg * 8;
                    *(u32x4*)(KZTF + go) = *(const LAS u32x4*)(T0 + d * 72 + seg * 8);
                    *(u32x4*)(KZTB + go) = *(const LAS u32x4*)(T1 + d * 72 + seg * 8); }
                __syncthreads();
            }
        } else {
            const int h = kind - 14, cb = 2048 + h * 128;
            const u32x4 w0 = *(const u32x4*)(prow + cb + 16 * j), w1 = *(const u32x4*)(prow + cb + 16 * j + 8);
            const unsigned ww[8] = {w0.x, w0.y, w0.z, w0.w, w1.x, w1.y, w1.z, w1.w};
#pragma unroll
            for (int i = 0; i < 8; ++i) { T0[(16 * j + 2 * i) * 72 + tok] = (bf16)(ww[i] & 0xffffu); T0[(16 * j + 2 * i + 1) * 72 + tok] = (bf16)(ww[i] >> 16); }
            __syncthreads();
#pragma unroll
            for (int q = 0; q < 2; ++q) { const int p = c.tid + 512 * q, d = p >> 3, seg = p & 7;
                *(u32x4*)(VBT + ((size_t)((b0 * 4 + h) * 128 + d)) * SP + s0 + seg * 8) = *(const LAS u32x4*)(T0 + d * 72 + seg * 8); }
            __syncthreads();
        }
    }
}

#define MFMA16(a_, b_, c_) __builtin_amdgcn_mfma_f32_16x16x32_bf16((a_), (b_), (c_), 0, 0, 0)
__device__ __forceinline__ void ph4_r1(const Args& a, const Ctx& c) {
    const float* ld = a.in[I_ABLD];
    bf16* ST = (bf16*)(a.ws + WS_ST);
    const int fr = c.lane & 15, fq = c.lane >> 4;
    for (int task = blockIdx.x; task < 256; task += c.G) {
        const int eq = task & 3, dir = (task >> 2) & 1, h = (task >> 3) & 3, b = task >> 5;
        const bf16* KZ = (const bf16*)(a.ws + (dir ? WS_KZTB : WS_KZTF)) + (size_t)(b * 4 + h) * 128 * SP;
        const bf16* VT = (const bf16*)(a.ws + WS_VBT) + (size_t)(b * 4 + h) * 128 * SP;
        const float decay = expf(log_gamma_of(ld[dir * 4 + h]) * 128.f);
        const int d0 = 16 * c.wave;
        f32x4 st[2] = {(f32x4){0.f, 0.f, 0.f, 0.f}, (f32x4){0.f, 0.f, 0.f, 0.f}};
        bf16* STb = ST + ((size_t)((b * 4 + h) * 2 + dir) * NCHUNK) * 16384;
        const bf16* kp0 = KZ + (size_t)(d0 + fr) * SP + fq * 8;
        const bf16* vp0 = VT + (size_t)(eq * 32 + fr) * SP + fq * 8;
        for (int n = 0; n < NCHUNK; ++n) {
            const int jn = dir == 0 ? n : (n < 2 ? 1 - n : 35 - n);
#pragma unroll
            for (int eb = 0; eb < 2; ++eb) { u32x2 w; w.x = cvt_pk_bf16(st[eb][0], st[eb][1]); w.y = cvt_pk_bf16(st[eb][2], st[eb][3]);
                *(u32x2*)(STb + (size_t)jn * 16384 + (eq * 32 + eb * 16 + fr) * 128 + d0 + 4 * fq) = w; }
            if (n == NCHUNK - 1) break;
            bf16x8 af[4], bfr[2][4];
#pragma unroll
            for (int kk = 0; kk < 4; ++kk) { af[kk] = *(const bf16x8*)(kp0 + jn * 128 + kk * 32);
                bfr[0][kk] = *(const bf16x8*)(vp0 + jn * 128 + kk * 32); bfr[1][kk] = *(const bf16x8*)(vp0 + (size_t)16 * SP + jn * 128 + kk * 32); }
            f32x4 kv[2] = {(f32x4){0.f, 0.f, 0.f, 0.f}, (f32x4){0.f, 0.f, 0.f, 0.f}};
#pragma unroll
            for (int kk = 0; kk < 4; ++kk) { kv[0] = MFMA16(af[kk], bfr[0][kk], kv[0]); kv[1] = MFMA16(af[kk], bfr[1][kk], kv[1]); }
            st[0] = st[0] * decay + kv[0]; st[1] = st[1] * decay + kv[1];
        }
    }
}
__device__ __forceinline__ void ph4_attn(const Args& a, const Ctx& c) {
    const bf16* P = (const bf16*)(a.ws + WS_P); bf16* MIX = (bf16*)(a.ws + WS_MIX);
    for (int task = c.vcu; task < 512 + 32; task += c.G) {
        int b, h, r0, seq;
        if (task < 512) { b = task >> 6; h = (task >> 4) & 3; r0 = b * SP + NCTX + (task & 15) * 256; seq = SP; }
        else { const int t2 = task - 512; b = t2 >> 2; h = t2 & 3; r0 = b * SP; seq = NCTX; }
        const int kvh = h >> 1;
        att::attn_dense_body<128, AB_IN, AB_IN, AB_IN, 1024>(P + (size_t)r0 * AB_IN + h * 128, P + (size_t)b * SP * AB_IN + 512 + kvh * 128, P + (size_t)b * SP * AB_IN + 768 + kvh * 128,
                                                             MIX + (size_t)r0 * 1024 + h * 128, seq, (char*)c.lds);
    }
}

__device__ __forceinline__ bf16x8 scale_frag(bf16x8 f, float s) {
    const u32x4 w = __builtin_bit_cast(u32x4, f); float v[8]; unpack8(w, v);
#pragma unroll
    for (int i = 0; i < 8; ++i) v[i] *= s;
    return __builtin_bit_cast(bf16x8, pack8(v));
}
__device__ __forceinline__ void ph5_r2(const Args& a, const Ctx& c) {
    const bf16* P = (const bf16*)(a.ws + WS_P); bf16* MIX = (bf16*)(a.ws + WS_MIX);
    const bf16* VBT = (const bf16*)(a.ws + WS_VBT); const bf16* ST = (const bf16*)(a.ws + WS_ST);
    const float* ld = a.in[I_ABLD]; const float* gn = a.in[I_ABGN];
    const int fr = c.lane & 15, fq = c.lane >> 4;
    LAS bf16* pl = (LAS bf16*)(c.lds + c.wave * (16 * 272));
    constexpr float L2E = 1.4426950408889634f;
    for (int task = c.vcu; task < NB * 4 * NCHUNK; task += c.G) {
        const int jn = task % NCHUNK, bh = task / NCHUNK, b = bh >> 2, h = bh & 3;
        const int rowbase = b * SP + jn * 128, c0 = 16 * c.wave;
        const float l2f = log_gamma_of(ld[h]) * L2E, l2b = log_gamma_of(ld[4 + h]) * L2E;
        const bf16* qp = P + (size_t)(rowbase + c0 + fr) * AB_IN + 1024 + h * 128 + fq * 8;
        bf16x8 qf[4];
#pragma unroll
        for (int kk = 0; kk < 4; ++kk) qf[kk] = *(const bf16x8*)(qp + kk * 32);
        f32x4 sc[8];
#pragma unroll
        for (int nb = 0; nb < 8; ++nb) { const bf16* kp = P + (size_t)(rowbase + nb * 16 + fr) * AB_IN + 1536 + h * 128 + fq * 8;
            sc[nb] = (f32x4){0.f, 0.f, 0.f, 0.f};
#pragma unroll
            for (int kk = 0; kk < 4; ++kk) sc[nb] = MFMA16(qf[kk], *(const bf16x8*)(kp + kk * 32), sc[nb]); }
#pragma unroll
        for (int nb = 0; nb < 8; ++nb)
#pragma unroll
            for (int i = 0; i < 4; ++i) { const int cc = c0 + fq * 4 + i, ss = nb * 16 + fr, diff = cc - ss;
                const float f = diff >= 0 ? __builtin_amdgcn_exp2f(l2f * (float)diff) : __builtin_amdgcn_exp2f(l2b * (float)(-diff));
                pl[(fq * 4 + i) * 136 + ss] = f2bf(sc[nb][i] * f); }
        LDS_WAIT();
        bf16x8 pf[4];
#pragma unroll
        for (int kk = 0; kk < 4; ++kk) pf[kk] = *(const LAS bf16x8*)(pl + fr * 136 + kk * 32 + fq * 8);
        LDS_WAIT();
        f32x4 o[8];
#pragma unroll
        for (int eb = 0; eb < 8; ++eb) { const bf16* vp = VBT + ((size_t)((b * 4 + h) * 128 + eb * 16 + fr)) * SP + jn * 128 + fq * 8;
            o[eb] = (f32x4){0.f, 0.f, 0.f, 0.f};
#pragma unroll
            for (int kk = 0; kk < 4; ++kk) o[eb] = MFMA16(pf[kk], *(const bf16x8*)(vp + kk * 32), o[eb]); }
        const float xf = __builtin_amdgcn_exp2f(l2f * (float)(c0 + fr + 1)), xb = __builtin_amdgcn_exp2f(l2b * (float)(128 - (c0 + fr)));
        const bf16* STf = ST + ((size_t)((b * 4 + h) * 2 + 0) * NCHUNK + jn) * 16384; const bf16* STb = ST + ((size_t)((b * 4 + h) * 2 + 1) * NCHUNK + jn) * 16384;
        {   bf16x8 qF[4];
#pragma unroll
            for (int kk = 0; kk < 4; ++kk) qF[kk] = scale_frag(qf[kk], xf);
#pragma unroll
            for (int eb = 0; eb < 8; ++eb) { const bf16* sp = STf + (eb * 16 + fr) * 128 + fq * 8;
#pragma unroll
                for (int kk = 0; kk < 4; ++kk) o[eb] = MFMA16(qF[kk], *(const bf16x8*)(sp + kk * 32), o[eb]); } }
        {   bf16x8 qB[4];
#pragma unroll
            for (int kk = 0; kk < 4; ++kk) qB[kk] = scale_frag(qf[kk], xb);
#pragma unroll
            for (int eb = 0; eb < 8; ++eb) { const bf16* sp = STb + (eb * 16 + fr) * 128 + fq * 8;
#pragma unroll
                for (int kk = 0; kk < 4; ++kk) o[eb] = MFMA16(qB[kk], *(const bf16x8*)(sp + kk * 32), o[eb]); } }
#pragma unroll
        for (int i = 0; i < 4; ++i) {
            float s1 = 0.f;
#pragma unroll
            for (int eb = 0; eb < 8; ++eb) s1 += o[eb][i];
            s1 += __shfl_xor(s1, 1); s1 += __shfl_xor(s1, 2); s1 += __shfl_xor(s1, 4); s1 += __shfl_xor(s1, 8);
            const float mean = s1 * (1.f / 128.f); float s2 = 0.f;
#pragma unroll
            for (int eb = 0; eb < 8; ++eb) { const float dlt = o[eb][i] - mean; s2 += dlt * dlt; }
            s2 += __shfl_xor(s2, 1); s2 += __shfl_xor(s2, 2); s2 += __shfl_xor(s2, 4); s2 += __shfl_xor(s2, 8);
            const float rstd = rsqrtf(s2 * (1.f / 128.f) + 1e-5f);
            const int row = rowbase + c0 + fq * 4 + i;
#pragma unroll
            for (int eb = 0; eb < 8; ++eb) { const int e = eb * 16 + fr; const float g = bf2f(P[(size_t)row * AB_IN + 2560 + h * 128 + e]);
                const float y = (o[eb][i] - mean) * rstd * gn[h * 128 + e] * (g / (1.f + __expf(-g)));
                MIX[(size_t)row * 1024 + 512 + h * 128 + e] = f2bf(y); }
        }
    }
}
__device__ __forceinline__ void moe_setup_tiles(const Args& a, const Ctx& c, int L) {
    LAS int* misc = (LAS int*)(c.lds + MISC_OFF);
    const unsigned* cur = (const unsigned*)(a.ws + WS_CTL) + CW_CNT + 64 * L;
    __syncthreads();
    if (c.tid < 32) misc[64 + c.tid] = (int)__hip_atomic_load(cur + c.tid, __ATOMIC_RELAXED, __HIP_MEMORY_SCOPE_AGENT);
    __syncthreads();
    if (c.tid == 0) { int acc = 0; for (int e = 0; e < NE; ++e) { misc[e] = acc; acc += (misc[64 + e] + 255) >> 8; } misc[NE] = acc; }
    __syncthreads();
}
template <bool GATHER_> struct MoeOrder {
    static constexpr bool GATHER = GATHER_;
    const LAS int* misc; const int* ltok; int nN, G, c, total;
    __device__ void init(const LAS int* misc_, const int* ltok_, int nN_, int G_, int c_) { misc = misc_; ltok = ltok_; nN = nN_; G = G_; c = c_; total = misc_[NE] * nN_; }
    __device__ bool next(int i, pg8::Unit& u) const {
        const int L = i * G + c; if (L >= total) return false;
        const int mt = L / nN, nt = L % nN; int e = 0;
        while (misc[e + 1] <= mt) ++e;
        u.pm = mt; u.pn = nt; u.pb = e * nN + nt; u.e = e; return true;
    }
    __device__ __forceinline__ unsigned arow(const pg8::Unit& u, int r) const {
        int local = (u.pm - misc[u.e]) * 256 + r; if (local >= misc[64 + u.e]) local = 0;
        return (unsigned)ltok[(size_t)u.e * CAP + local];
    }
};
__device__ __forceinline__ float swiglu(float g, float l) {
    g = fminf(g, 7.0f); l = fminf(fmaxf(l, -7.0f), 7.0f);
    return g * __builtin_amdgcn_rcpf(1.f + __builtin_amdgcn_exp2f(-1.702f * 1.4426950408889634f * g)) * (l + 1.0f);
}
struct EpiMoeUp {
    static constexpr bool PERM = true;
    bf16* ACT; const float* bup  ;
    __device__ __forceinline__ void operator()(const f32x4 (&acc)[2][2][4][2], const pg8::Unit& u, int wr, int wc, int fr, int fq) const {
        const int col0 = u.pn * 128 + wc * 32 + 8 * fq; const float* bb = bup + (size_t)u.e * 2048 + col0;
        f32x4 bg[2], bl[2];
#pragma unroll
        for (int n = 0; n < 2; ++n) { bg[n] = *(const f32x4*)(bb + 4 * n); bl[n] = *(const f32x4*)(bb + 1024 + 4 * n); }
        const unsigned rb = ((unsigned)(u.pm * 256 + wr * 64 + fr) * 1024u + (unsigned)col0) * 2u;
#pragma unroll
        for (int ai = 0; ai < 2; ++ai)
#pragma unroll
            for (int m = 0; m < 4; ++m) { float v[8];
#pragma unroll
                for (int n = 0; n < 2; ++n)
#pragma unroll
                    for (int k = 0; k < 4; ++k) v[4 * n + k] = swiglu(acc[ai][0][m][n][k] + bg[n][k], acc[ai][1][m][n][k] + bl[n][k]);
                st16(ACT, rb + (unsigned)((ai * 128 + m * 16) * 1024) * 2u, pack8(v)); }
    }
};
struct EpiMoeDown {
    static constexpr bool PERM = true;
    bf16* YK; const float* bdn  ; const float* lgate; const LAS int* misc;
    __device__ __forceinline__ void operator()(const f32x4 (&acc)[2][2][4][2], const pg8::Unit& u, int wr, int wc, int fr, int fq) const {
        const int col0 = u.pn * 256 + wc * 32 + 8 * fq; const float* bb = bdn + (size_t)u.e * 1024 + col0;
        f32x4 bv[2][2];
#pragma unroll
        for (int bj = 0; bj < 2; ++bj)
#pragma unroll
            for (int n = 0; n < 2; ++n) bv[bj][n] = *(const f32x4*)(bb + bj * 128 + 4 * n);
        const int lbase = (u.pm - misc[u.e]) * 256 + wr * 64 + fr, cnt = misc[64 + u.e];
        const float* gp = lgate + (size_t)u.e * CAP;
        const unsigned rb = ((unsigned)(u.pm * 256 + wr * 64 + fr) * 1024u + (unsigned)col0) * 2u;
#pragma unroll
        for (int ai = 0; ai < 2; ++ai)
#pragma unroll
            for (int m = 0; m < 4; ++m) { const int local = lbase + ai * 128 + m * 16;
                const float g = local < cnt ? *(const float*)((const char*)gp + (unsigned)local * 4u) : 0.f;
                const unsigned ro = rb + (unsigned)((ai * 128 + m * 16) * 1024) * 2u;
#pragma unroll
                for (int bj = 0; bj < 2; ++bj) st16(YK, ro + bj * 256, pack2x4((acc[ai][bj][m][0] + bv[bj][0]) * g, (acc[ai][bj][m][1] + bv[bj][1]) * g)); }
    }
};

template <int L> __device__ __forceinline__ void ph_ln1_router(const Args& a, const Ctx& c) {
    constexpr int NROWS = (L == 0) ? R : NB * SEQ;
    float* ACC = (float*)(a.ws + WS_ACC); bf16* H = (bf16*)(a.ws + WS_H);
    const float* mods = (const float*)(a.ws + WS_MODS) + (size_t)L * 9 * 6144;
    const float* g1 = a.in[I_LN1G] + L * D; const float* b1 = a.in[I_LN1B] + L * D;
    const float* Wr = a.in[I_RW] + (size_t)L * D * NE; const float* rb = a.in[I_RB] + L * NE;
    int* LTOK = (int*)(a.ws + WS_LTOK); float* LGATE = (float*)(a.ws + WS_LGATE); int* TOKSLOT = (int*)(a.ws + WS_TOKSLOT);
    unsigned* cur = (unsigned*)(a.ws + WS_CTL) + CW_CNT + 64 * L;
    LAS float* wr = (LAS float*)c.lds;
    LAS int* misc = (LAS int*)(c.lds + MISC_OFF);
    LAS int* rec = (LAS int*)(c.lds + XTRA_OFF);
    LAS float* recg = (LAS float*)(c.lds + XTRA_OFF + 6144);
    LAS int* recrow = (LAS int*)(c.lds + XTRA_OFF + 12288);
    for (int i = c.tid; i < D * NE; i += 512) { const int d = i >> 5, e = i & 31; wr[e * 1024 + d] = Wr[i]; }
    if (c.tid < 32) misc[128 + c.tid] = 0;
    __syncthreads();
    int nq = 0;
    for (int q = c.wave;; q += 8) {
        const int rl = blockIdx.x + c.G * q; if (rl >= NROWS) break;
        nq = q + 1;
        int row, b, isc;
        if constexpr (L == 0) { row = rl; b = row / SP; isc = (row % SP) < NCTX; } else { b = rl / SEQ; row = b * SP + NCTX + (rl % SEQ); isc = 0; }
        const float* m = mods + (size_t)(isc ? 8 : b) * 6144;
        float* xr = ACC + (size_t)row * D;
        f32x4 v[4]; float s = 0.f;
#pragma unroll
        for (int j = 0; j < 4; ++j) { v[j] = *(const f32x4*)(xr + 4 * c.lane + 256 * j); s += (v[j][0] + v[j][1]) + (v[j][2] + v[j][3]); }
        const float mean = wave_sum(s) * (1.f / D); float s2 = 0.f;
#pragma unroll
        for (int j = 0; j < 4; ++j) { v[j] = v[j] - mean; s2 += (v[j][0] * v[j][0] + v[j][1] * v[j][1]) + (v[j][2] * v[j][2] + v[j][3] * v[j][3]); }
        const float rstd = rsqrtf(wave_sum(s2) * (1.f / D) + 1e-5f);
        f32x4 hv[4];
#pragma unroll
        for (int j = 0; j < 4; ++j) { const int col = 4 * c.lane + 256 * j;
            const f32x4 x1 = v[j] * rstd * *(const f32x4*)(g1 + col) + *(const f32x4*)(b1 + col);
            *(f32x4*)(xr + col) = x1;
            hv[j] = x1 * (*(const f32x4*)(m + 4 * 1024 + col) + 1.0f) + *(const f32x4*)(m + 3 * 1024 + col);
            u32x2 o; o.x = cvt_pk_bf16(hv[j][0], hv[j][1]); o.y = cvt_pk_bf16(hv[j][2], hv[j][3]); *(u32x2*)(H + (size_t)row * D + col) = o; }
        float lg[NE];
#pragma unroll
        for (int e = 0; e < NE; ++e) { float p = 0.f;
#pragma unroll
            for (int j = 0; j < 4; ++j) { const f32x4 w = *(const LAS f32x4*)(wr + e * 1024 + 4 * c.lane + 256 * j); p += (hv[j][0] * w[0] + hv[j][1] * w[1]) + (hv[j][2] * w[2] + hv[j][3] * w[3]); }
            lg[e] = wave_sum(p) + rb[e]; }
        int te[4]; float tv[4];
#pragma unroll
        for (int k = 0; k < 4; ++k) { float best = -3.0e38f; int bi = 0;
#pragma unroll
            for (int e = 0; e < NE; ++e) { const bool better = lg[e] > best; best = better ? lg[e] : best; bi = better ? e : bi; }
            te[k] = bi; tv[k] = best;
#pragma unroll
            for (int e = 0; e < NE; ++e) lg[e] = (e == bi) ? -3.0e38f : lg[e]; }
        float ex[4], es = 0.f;
#pragma unroll
        for (int k = 0; k < 4; ++k) { ex[k] = expf(tv[k] - tv[0]); es += ex[k]; }
        if (c.lane == 0) {
#pragma unroll
            for (int k = 0; k < 4; ++k) { const int lpos = atomicAdd((int*)&misc[128 + te[k]], 1); rec[q * 4 + k] = (te[k] << 20) | lpos; recg[q * 4 + k] = ex[k] / es; }
            recrow[q] = row; }
    }
    __syncthreads();
    if (c.tid < 32) { const int n = misc[128 + c.tid]; misc[160 + c.tid] = n ? (int)__hip_atomic_fetch_add(cur + c.tid, (unsigned)n, __ATOMIC_RELAXED, __HIP_MEMORY_SCOPE_AGENT) : 0; }
    __syncthreads();
    const int nqb = (NROWS - (int)blockIdx.x + c.G - 1) / c.G;
    for (int i = c.tid; i < nqb * 4; i += 512) { const int q = i >> 2, rc = rec[i], e = rc >> 20, pos = misc[160 + e] + (rc & 0xfffff); const int row = recrow[q];
        LTOK[(size_t)e * CAP + pos] = row; LGATE[(size_t)e * CAP + pos] = recg[i]; TOKSLOT[row * 4 + (i & 3)] = (e << 24) | pos; }
    (void)nq;
}

template <int L> __device__ __forceinline__ void ph_ln2(const Args& a, const Ctx& c) {
    constexpr int NROWS = (L == 0) ? R : NB * SEQ;
    const float* ACC = (const float*)(a.ws + WS_ACC); const bf16* YK = (const bf16*)(a.ws + WS_YK); const int* TOKSLOT = (const int*)(a.ws + WS_TOKSLOT);
    const float* mods = (const float*)(a.ws + WS_MODS) + (size_t)L * 9 * 6144;
    const float* g2 = a.in[I_LN2G] + L * D; const float* b2 = a.in[I_LN2B] + L * D;
    LAS int* misc = (LAS int*)(c.lds + MISC_OFF);
    moe_setup_tiles(a, c, L);
    for (int rl = c.gw; rl < NROWS; rl += c.NGW) {
        int row, b, isc, t = 0;
        if constexpr (L == 0) { row = rl; b = row / SP; isc = (row % SP) < NCTX; } else { b = rl / SEQ; t = rl % SEQ; row = b * SP + NCTX + t; isc = 0; }
        const float* m = mods + (size_t)(isc ? 8 : b) * 6144;
        const bf16* yk[4];
#pragma unroll
        for (int k = 0; k < 4; ++k) { const int ts = TOKSLOT[row * 4 + k], e = ts >> 24, pos = ts & 0xffffff; yk[k] = YK + ((size_t)misc[e] * 256 + pos) * 1024; }
        f32x4 v[4]; float s = 0.f;
#pragma unroll
        for (int j = 0; j < 4; ++j) { const int col = 4 * c.lane + 256 * j; f32x4 fl = (f32x4){0.f, 0.f, 0.f, 0.f};
#pragma unroll
            for (int k = 0; k < 4; ++k) { const u32x2 w = *(const u32x2*)(yk[k] + col); fl[0] += bflo(w.x); fl[1] += bfhi(w.x); fl[2] += bflo(w.y); fl[3] += bfhi(w.y); }
            v[j] = *(const f32x4*)(ACC + (size_t)row * D + col) * DN_ALPHA + *(const f32x4*)(m + 5 * 1024 + col) * fl;
            s += (v[j][0] + v[j][1]) + (v[j][2] + v[j][3]); }
        const float mean = wave_sum(s) * (1.f / D); float s2 = 0.f;
#pragma unroll
        for (int j = 0; j < 4; ++j) { v[j] = v[j] - mean; s2 += (v[j][0] * v[j][0] + v[j][1] * v[j][1]) + (v[j][2] * v[j][2] + v[j][3] * v[j][3]); }
        const float rstd = rsqrtf(wave_sum(s2) * (1.f / D) + 1e-5f);
#pragma unroll
        for (int j = 0; j < 4; ++j) { const int col = 4 * c.lane + 256 * j;
            const f32x4 x2 = v[j] * rstd * *(const f32x4*)(g2 + col) + *(const f32x4*)(b2 + col);
            if constexpr (L == 0) {
                *(f32x4*)((float*)(a.ws + WS_X) + (size_t)row * D + col) = x2;
                const float* mn = m + 9 * 6144;
                const f32x4 h = x2 * (*(const f32x4*)(mn + 1024 + col) + 1.0f) + *(const f32x4*)(mn + col);
                u32x2 o; o.x = cvt_pk_bf16(h[0], h[1]); o.y = cvt_pk_bf16(h[2], h[3]); *(u32x2*)((bf16*)(a.ws + WS_H) + (size_t)row * D + col) = o;
            } else {
                *(f32x4*)(a.out + ((size_t)b * SEQ + t) * D + col) = x2;
            } }
    }
}
__device__ __forceinline__ void ph12_mla_post(const Args& a, const Ctx& c) {
    const bf16* PM = (const bf16*)(a.ws + WS_PM); bf16* CQ = (bf16*)(a.ws + WS_CQ); bf16* CKV = (bf16*)(a.ws + WS_CKV); bf16* KM = (bf16*)(a.ws + WS_KM);
    const float* qn = a.in[I_MLAQN]; const float* kvn = a.in[I_MLAKVN];
    const float2* A64 = (const float2*)(a.ws + WS_TAB_A64);
    const int lane = c.lane;
    for (int row = c.gw; row < R; row += c.NGW) {
        const int s = row % SP; const bool lat = s >= NCTX;
        const bf16* pr = PM + (size_t)row * MLA_IN_P;
        float v0[8], v1[8];
        unpack8(*(const u32x4*)(pr + lane * 8), v0);
        if (lane < 32) unpack8(*(const u32x4*)(pr + 512 + lane * 8), v1);
        else {
#pragma unroll
            for (int i = 0; i < 8; ++i) v1[i] = 0.f; }
        float sq = 0.f, sk = 0.f, t0 = 0.f, t1 = 0.f;
#pragma unroll
        for (int i = 0; i < 8; ++i) { t0 += v0[i] * v0[i]; t1 += v1[i] * v1[i]; }
        if (lane < 48) sq = t0; else sk = t0;
        if (lane < 16) sk += t1;
        sq = wave_sum(sq); sk = wave_sum(sk);
        const float rq = rsqrtf(sq * (1.f / MLA_QL) + 1e-6f), rk = rsqrtf(sk * (1.f / MLA_KVL) + 1e-6f);
        float o[8];
        if (lane < 48) {
#pragma unroll
            for (int i = 0; i < 8; ++i) o[i] = v0[i] * rq * qn[lane * 8 + i];
            *(u32x4*)(CQ + (size_t)row * MLA_QL + lane * 8) = pack8(o);
        } else {
#pragma unroll
            for (int i = 0; i < 8; ++i) o[i] = v0[i] * rk * kvn[(lane - 48) * 8 + i];
            *(u32x4*)(CKV + (size_t)row * MLA_KVL + (lane - 48) * 8) = pack8(o);
        }
        if (lane < 16) {
#pragma unroll
            for (int i = 0; i < 8; ++i) o[i] = v1[i] * rk * kvn[128 + lane * 8 + i];
            *(u32x4*)(CKV + (size_t)row * MLA_KVL + 128 + lane * 8) = pack8(o);
        }
        float pr8[8];
#pragma unroll
        for (int i = 0; i < 8; ++i) pr8[i] = __shfl_xor(v1[i], 2);
        if (lane >= 16 && lane < 24) {
            if (lat) { const int t = s - NCTX, pos = lane < 20 ? t / GRID_W : t % GRID_W; const float2* cs = A64 + pos * 16 + (lane & 1) * 8; const bool second = (lane & 2) != 0;
#pragma unroll
                for (int i = 0; i < 8; ++i) { const float2 q = cs[i]; o[i] = second ? (pr8[i] * q.y + v1[i] * q.x) : (v1[i] * q.x - pr8[i] * q.y); } }
            else {
#pragma unroll
                for (int i = 0; i < 8; ++i) o[i] = v1[i]; }
            const u32x4 w = pack8(o);
#pragma unroll
            for (int h = 0; h < 8; ++h) *(u32x4*)(KM + (size_t)row * UQ_N + h * 192 + 128 + (lane - 16) * 8) = w;
        }
    }
}
struct LatOrder {
    pg8::StaticOrder S; static constexpr bool GATHER = false;
    __device__ void init(int nN, int G, int c) { S.init(NB * 16, nN, G, c); }
    __device__ bool next(int i, pg8::Unit& u) const { if (!S.next(i, u)) return false; u.pm = (u.pm >> 4) * 17 + 1 + (u.pm & 15); return true; }
    __device__ __forceinline__ unsigned arow(const pg8::Unit&, int) const { return 0u; }
};
struct EpiUq {
    static constexpr bool PERM = true;
    bf16* QM; const float2* A64;
    __device__ __forceinline__ void operator()(const f32x4 (&acc)[2][2][4][2], const pg8::Unit& u, int wr, int wc, int fr, int fq) const {
        constexpr float SC = 0.07216878364870322f;
        const int row0 = u.pm * 256 + wr * 64 + fr;
        if (u.pn < 4) {
            const unsigned rb = ((unsigned)row0 * UQ_N + (unsigned)(2 * u.pn * 192 + wc * 32 + 8 * fq)) * 2u;
#pragma unroll
            for (int ai = 0; ai < 2; ++ai)
#pragma unroll
                for (int m = 0; m < 4; ++m) { const unsigned ro = rb + (unsigned)((ai * 128 + m * 16) * UQ_N) * 2u;
#pragma unroll
                    for (int bj = 0; bj < 2; ++bj) st16(QM, ro + bj * 384, pack2x4(acc[ai][bj][m][0] * SC, acc[ai][bj][m][1] * SC)); }
        } else {
            const int head = 4 * (u.pn - 4) + wc, j0 = 8 * fq;
            const int d1 = j0 < 16 ? j0 : 16 + j0;
            const unsigned rb = ((unsigned)row0 * UQ_N + (unsigned)(head * 192 + 128 + d1)) * 2u;
            const int t0 = row0 % SP - NCTX;
#pragma unroll
            for (int ai = 0; ai < 2; ++ai)
#pragma unroll
                for (int m = 0; m < 4; ++m) { const int t = t0 + ai * 128 + m * 16;
                    const int pos = j0 < 16 ? t / GRID_W : t % GRID_W; const unsigned co = (unsigned)(pos * 16 + (j0 & 15)) * 8u;
                    const unsigned ro = rb + (unsigned)((ai * 128 + m * 16) * UQ_N) * 2u;
#pragma unroll
                    for (int n = 0; n < 2; ++n) { const f32x4 ca = *(const f32x4*)((const char*)A64 + co + 32 * n), cb = *(const f32x4*)((const char*)A64 + co + 32 * n + 16);
                        const f32x4 x1 = acc[ai][0][m][n], x2 = acc[ai][1][m][n];
                        u32x2 w1, w2;
                        w1.x = cvt_pk_bf16((x1[0] * ca[0] - x2[0] * ca[1]) * SC, (x1[1] * ca[2] - x2[1] * ca[3]) * SC);
                        w1.y = cvt_pk_bf16((x1[2] * cb[0] - x2[2] * cb[1]) * SC, (x1[3] * cb[2] - x2[3] * cb[3]) * SC);
                        w2.x = cvt_pk_bf16((x1[0] * ca[1] + x2[0] * ca[0]) * SC, (x1[1] * ca[3] + x2[1] * ca[2]) * SC);
                        w2.y = cvt_pk_bf16((x1[2] * cb[1] + x2[2] * cb[0]) * SC, (x1[3] * cb[3] + x2[3] * cb[2]) * SC);
                        st8(QM, ro + 8 * n, w1); st8(QM, ro + 32 + 8 * n, w2); } }
        }
    }
};
struct EpiUkv {
    static constexpr bool PERM = true;
    bf16* KM; bf16* VM;
    __device__ __forceinline__ void operator()(const f32x4 (&acc)[2][2][4][2], const pg8::Unit& u, int wr, int wc, int fr, int fq) const {
        const unsigned row0 = (unsigned)(u.pm * 256 + wr * 64 + fr), cw = (unsigned)(wc * 32 + 8 * fq);
        const unsigned kb = (row0 * UQ_N + (unsigned)u.pn * 192 + cw) * 2u, vb = (row0 * 1024u + (unsigned)u.pn * 128 + cw) * 2u;
#pragma unroll
        for (int ai = 0; ai < 2; ++ai)
#pragma unroll
            for (int m = 0; m < 4; ++m) {
                st16(KM, kb + (unsigned)((ai * 128 + m * 16) * UQ_N) * 2u, pack2x4(acc[ai][0][m][0], acc[ai][0][m][1]));
                st16(VM, vb + (unsigned)((ai * 128 + m * 16) * 1024) * 2u, pack2x4(acc[ai][1][m][0], acc[ai][1][m][1])); }
    }
};
__device__ __forceinline__ void ph14_mla_attn(const Args& a, const Ctx& c) {
    const bf16* QM = (const bf16*)(a.ws + WS_QM); const bf16* KM = (const bf16*)(a.ws + WS_KM); const bf16* VM = (const bf16*)(a.ws + WS_VM); bf16* MIX = (bf16*)(a.ws + WS_MIX);
    for (int task = c.vcu; task < 1024; task += c.G) {
        const int b = task >> 7, h = (task >> 4) & 7, r0 = b * SP + NCTX + (task & 15) * 256;
        att::attn_dense_body<192, UQ_N, UQ_N, 1024, 1024>(QM + (size_t)r0 * UQ_N + h * 192, KM + (size_t)b * SP * UQ_N + h * 192, VM + (size_t)b * SP * 1024 + h * 128,
                                                          MIX + (size_t)r0 * 1024 + h * 128, SP, (char*)c.lds);
    }
}
constexpr int NPH = 20;
#ifndef ONE_LAUNCH
#define ONE_LAUNCH 0
#endif
__global__ void __launch_bounds__(512, 2) fwd(Args a) {
    extern __shared__ __attribute__((aligned(16))) unsigned char lds_raw[];
    Ctx c; c.lds = (LAS unsigned char*)lds_raw; c.tid = threadIdx.x; c.lane = c.tid & 63; c.wave = __builtin_amdgcn_readfirstlane(c.tid >> 6);
    c.G = gridDim.x; { const int bx = blockIdx.x; c.vcu = (c.G % 8 == 0) ? (bx % 8) * (c.G / 8) + bx / 8 : bx; }
    c.gw = c.vcu * 8 + c.wave; c.NGW = c.G * 8;
    volatile LAS unsigned* MISC = (volatile LAS unsigned*)(c.lds + MISC_OFF);
    if (c.tid < 256) MISC[c.tid] = 0u;
    __syncthreads();
    unsigned* ctl = (unsigned*)(a.ws + WS_CTL);
    XcdBarrier bar; bar.bar = ctl + CW_BAR; bar.x = 0; bar.st = nullptr;
    const int lo = a.ph_lo, hi = a.ph_hi;
    if (hi - lo > 1) bar = xcd_barrier_post(ctl + CW_BAR, MISC + 248);
#ifndef PHMASK
#define PHMASK 0xFFFFFu
#endif
#define IN(k) ((((PHMASK) >> (k)) & 1u) && lo <= (k) && (k) < hi)
#define SEAM(k) do { if (IN(k) && IN((k) + 1)) xcd_barrier(bar); } while (0)
    unsigned char* ws = a.ws;
    const float* mods = (const float*)(ws + WS_MODS);
    LAS int* misc = (LAS int*)(c.lds + MISC_OFF);

    if (IN(0)) { ph0_prologue(a, c); } SEAM(0);
    if (IN(1)) { ph1_mod0(a, c); } SEAM(1);
    if (IN(2)) {
        pg8::Gemm g{(const bf16*)(ws + WS_H), (const bf16*)(ws + WS_WABIN), 1024}; pg8::StaticOrder S; S.init(R / 256, AB_IN / 256, c.G, (int)blockIdx.x);
        EpiStoreBf16 E{(bf16*)(ws + WS_P), AB_IN};
        pg8::gemm_phase(c.lds, g, S, E);
    } SEAM(2);
    if (IN(3)) { ph3_post(a, c); } SEAM(3);
    if (IN(4)) { ph4_r1(a, c); __syncthreads(); ph4_attn(a, c); } SEAM(4);
    if (IN(5)) { ph5_r2(a, c); } SEAM(5);
    if (IN(6)) {
        pg8::Gemm g{(const bf16*)(ws + WS_MIX), (const bf16*)(ws + WS_WABOUT), 1024}; pg8::StaticOrder S; S.init(R / 256, 4, c.G, (int)blockIdx.x);
        EpiResid<0> E{a.in[I_X], a.in[I_CTX], nullptr, mods, (float*)(ws + WS_ACC)};
        pg8::gemm_phase(c.lds, g, S, E);
    } SEAM(6);
    if (IN(7)) { ph_ln1_router<0>(a, c); } SEAM(7);
    if (IN(8)) {
        moe_setup_tiles(a, c, 0);
        pg8::Gemm g{(const bf16*)(ws + WS_H), (const bf16*)(ws + WS_WUP), 1024}; MoeOrder<true> S; S.init(misc, (const int*)(ws + WS_LTOK), 8, c.G, (int)blockIdx.x);
        EpiMoeUp E{(bf16*)(ws + WS_ACT), a.in[I_BUP]};
        pg8::gemm_phase(c.lds, g, S, E);
    } SEAM(8);
    if (IN(9)) {
        moe_setup_tiles(a, c, 0);
        pg8::Gemm g{(const bf16*)(ws + WS_ACT), (const bf16*)(ws + WS_WDOWN), 1024}; MoeOrder<false> S; S.init(misc, nullptr, 4, c.G, (int)blockIdx.x);
        EpiMoeDown E{(bf16*)(ws + WS_YK), a.in[I_BDOWN], (const float*)(ws + WS_LGATE), misc};
        pg8::gemm_phase(c.lds, g, S, E);
    } SEAM(9);
    if (IN(10)) { ph_ln2<0>(a, c); } SEAM(10);
    if (IN(11)) {
        pg8::Gemm g{(const bf16*)(ws + WS_H), (const bf16*)(ws + WS_WMLAIN), 1024}; pg8::StaticOrder S; S.init(R / 256, 3, c.G, (int)blockIdx.x);
        EpiStoreBf16 E{(bf16*)(ws + WS_PM), MLA_IN_P};
        pg8::gemm_phase(c.lds, g, S, E);
    } SEAM(11);
    if (IN(12)) { ph12_mla_post(a, c); } SEAM(12);
    if (IN(13)) {
#ifndef NO_UQ
        {   pg8::Gemm g{(const bf16*)(ws + WS_CQ), (const bf16*)(ws + WS_WUQ), MLA_QL}; LatOrder S; S.init(6, c.G, (int)blockIdx.x);
            EpiUq E{(bf16*)(ws + WS_QM), (const float2*)(ws + WS_TAB_A64)};
            pg8::gemm_phase(c.lds, g, S, E); }
#endif
#ifndef NO_UKV
        {   pg8::Gemm g{(const bf16*)(ws + WS_CKV), (const bf16*)(ws + WS_WUKV), MLA_KVL}; pg8::StaticOrder S; S.init(R / 256, 8, c.G, (int)blockIdx.x);
            EpiUkv E{(bf16*)(ws + WS_KM), (bf16*)(ws + WS_VM)};
            pg8::gemm_phase(c.lds, g, S, E); }
#endif
    } SEAM(13);
    if (IN(14)) { ph14_mla_attn(a, c); } SEAM(14);
    if (IN(15)) {
        pg8::Gemm g{(const bf16*)(ws + WS_MIX), (const bf16*)(ws + WS_WMLAOUT), 1024}; LatOrder S; S.init(4, c.G, (int)blockIdx.x);
        EpiResid<1> E{nullptr, nullptr, (const float*)(ws + WS_X), mods + 9 * 6144, (float*)(ws + WS_ACC)};
        pg8::gemm_phase(c.lds, g, S, E);
    } SEAM(15);
    if (IN(16)) { ph_ln1_router<1>(a, c); } SEAM(16);
    if (IN(17)) {
        moe_setup_tiles(a, c, 1);
        pg8::Gemm g{(const bf16*)(ws + WS_H), (const bf16*)(ws + WS_WUP) + (size_t)32 * 2048 * 1024, 1024}; MoeOrder<true> S; S.init(misc, (const int*)(ws + WS_LTOK), 8, c.G, (int)blockIdx.x);
        EpiMoeUp E{(bf16*)(ws + WS_ACT), a.in[I_BUP] + 32 * 2048};
        pg8::gemm_phase(c.lds, g, S, E);
    } SEAM(17);
    if (IN(18)) {
        moe_setup_tiles(a, c, 1);
        pg8::Gemm g{(const bf16*)(ws + WS_ACT), (const bf16*)(ws + WS_WDOWN) + (size_t)32 * 1024 * 1024, 1024}; MoeOrder<false> S; S.init(misc, nullptr, 4, c.G, (int)blockIdx.x);
        EpiMoeDown E{(bf16*)(ws + WS_YK), a.in[I_BDOWN] + 32 * 1024, (const float*)(ws + WS_LGATE), misc};
        pg8::gemm_phase(c.lds, g, S, E);
    } SEAM(18);
    if (IN(19)) { ph_ln2<1>(a, c); }
#undef IN
#undef SEAM
}

extern "C" void kernel_launch(void* const* d_in, const int* in_sizes, int n_in, void* d_out, int out_size, void* d_ws, size_t ws_size, hipStream_t stream) {
    static int grid = 0;
    if (grid == 0) {
        if (n_in != 28 || in_sizes[0] != NB * SEQ * D || out_size != NB * SEQ * D || ws_size < WS_END) {
            fprintf(stderr, "kernel_launch: shape mismatch: n_in %d in0 %d out %d ws %zu (need >= %zu)\n", n_in, n_in > 0 ? in_sizes[0] : -1, out_size, ws_size, (size_t)WS_END); grid = -1; return; }
        int dev = 0, cus = 0, per_cu = 0;
        if (hipGetDevice(&dev) != hipSuccess || hipDeviceGetAttribute(&cus, hipDeviceAttributeMultiprocessorCount, dev) != hipSuccess) { fprintf(stderr, "kernel_launch: device query failed\n"); grid = -1; return; }
        if (hipFuncSetAttribute((const void*)fwd, hipFuncAttributeMaxDynamicSharedMemorySize, LDS_BYTES) != hipSuccess) { fprintf(stderr, "kernel_launch: hipFuncSetAttribute failed\n"); grid = -1; return; }
        if (hipOccupancyMaxActiveBlocksPerMultiprocessor(&per_cu, (const void*)fwd, 512, LDS_BYTES) != hipSuccess || per_cu < 1) fprintf(stderr, "kernel_launch: occupancy query reports %d blocks per CU\n", per_cu);
        (void)hipGetLastError();
        grid = cus;
    }
    if (grid < 0) return;
    if (hipMemsetAsync((char*)d_ws + WS_CTL, 0, CTL_ZERO_BYTES, stream) != hipSuccess) { fprintf(stderr, "kernel_launch: memset failed\n"); return; }
    Args a{};
    for (int i = 0; i < 28; ++i) a.in[i] = (const float*)d_in[i];
    a.out = (float*)d_out; a.ws = (unsigned char*)d_ws;
#if ONE_LAUNCH
    a.ph_lo = 0; a.ph_hi = NPH;
    hipLaunchKernelGGL(fwd, dim3(grid), dim3(512), LDS_BYTES, stream, a);
#else
    for (int p = 0; p < NPH; ++p) { a.ph_lo = p; a.ph_hi = p + 1; hipLaunchKernelGGL(fwd, dim3(grid), dim3(512), LDS_BYTES, stream, a); }
#endif
    const hipError_t le = hipPeekAtLastError();
    if (le != hipSuccess) fprintf(stderr, "kernel_launch: launch failed: %s\n", hipGetErrorName(le));
}
```

```cpp
#include <hip/hip_runtime.h>
#include <cstdio>
#include <cstdint>

#define LAS __attribute__((address_space(3)))
#define GAS __attribute__((address_space(1)))
typedef unsigned short bf16;
typedef short bf16x8 __attribute__((ext_vector_type(8)));
typedef short s16x4 __attribute__((ext_vector_type(4)));
typedef float f32x4 __attribute__((ext_vector_type(4)));
typedef float f32x2 __attribute__((ext_vector_type(2)));
typedef float f32x8 __attribute__((ext_vector_type(8)));
typedef float f32x16 __attribute__((ext_vector_type(16)));
typedef unsigned u32x4 __attribute__((ext_vector_type(4)));
typedef unsigned u32x2 __attribute__((ext_vector_type(2)));
typedef GAS unsigned gu32;

constexpr int D = 1024, NB = 8, SEQ = 4096, NCTX = 256, SP = SEQ + NCTX  , R = NB * SP  ;
constexpr int GRID_W = 64;
constexpr int AB_IN = 3072, MLA_IN = 704, MLA_IN_P = 768, MLA_QL = 384, MLA_KVL = 256, UQ_N = 1536, UKV_N = 2048;
constexpr int NE = 32, TOPK = 4, DFF = 1024;
constexpr int NCHUNK = SP / 128;
constexpr float DN_ALPHA = 1.4142135623730951f;
constexpr int CAP = R * TOPK;
constexpr int NSLOT_MAX = R * TOPK + NE * 256;

__device__ __forceinline__ unsigned cvt_pk_bf16(float lo, float hi) { unsigned r; asm volatile("v_cvt_pk_bf16_f32 %0, %1, %2" : "=v"(r) : "v"(lo), "v"(hi)); return r; }
__device__ __forceinline__ float bflo(unsigned w) { return __uint_as_float(w << 16); }
__device__ __forceinline__ float bfhi(unsigned w) { return __uint_as_float(w & 0xffff0000u); }
__device__ __forceinline__ float bf2f(bf16 b) { return __uint_as_float((unsigned)b << 16); }
__device__ __forceinline__ bf16 f2bf(float f) { return (bf16)(cvt_pk_bf16(f, 0.f) & 0xffffu); }
__device__ __forceinline__ float wave_sum(float v) {
#pragma unroll
    for (int o = 1; o < 64; o <<= 1) v += __shfl_xor(v, o);
    return v;
}
#define LDS_WAIT() asm volatile("s_waitcnt lgkmcnt(0)" ::: "memory")
#define VM_WAIT() asm volatile("s_waitcnt vmcnt(0)" ::: "memory")
namespace pg8 {
typedef unsigned short bf16_t;
constexpr int BM = 256, BK = 64, HALF = 128, HTB = HALF * BK * 2  , STAGE_BYTES = 8 * HTB, NXCD = 8, WGM = 8;

__host__ __device__ __forceinline__ int lds_byte(int r, int c) { const int st = (r >> 4) * 2 + (c >> 5), rr = r & 15, cc = c & 31, ob = rr * 64 + cc * 2; return st * 1024 + (ob ^ (((ob >> 9) & 1) << 5)); }
__host__ __device__ __forceinline__ void stage_rc(int b, int& R_, int& C_) { const int st = b / 1024, sb = b % 1024, swz = sb ^ (((sb >> 9) & 1) << 5); R_ = (st >> 1) * 16 + swz / 64; C_ = (st & 1) * 32 + (swz % 64) / 2; }
__host__ __device__ __forceinline__ int perm32(int rho) { const int n = rho >> 4, i = rho & 15; return 8 * (i >> 2) + 4 * n + (i & 3); }

struct Unit { int pm, pn, pb, e; };
struct Gemm { const bf16_t* A; const bf16_t* Bt; int K; };

struct StaticOrder {
    int nM, nN, nwg, G, c;
    static constexpr bool GATHER = false;
    __device__ void init(int nM_, int nN_, int G_, int c_) { nM = nM_; nN = nN_; nwg = nM * nN; G = G_; c = c_; }
    __device__ bool next(int i, Unit& u) const {
        const long L = (long)i * G + c; if (L >= nwg) return false;
        int wgid = (int)L; { const int q = nwg / NXCD, r = nwg % NXCD, xcd = wgid % NXCD, off = wgid / NXCD; wgid = (xcd < r ? xcd * (q + 1) : r * (q + 1) + (xcd - r) * q) + off; }
        const int nig = WGM * nN, gid = wgid / nig, fm = gid * WGM, gsz = (nM - fm) < WGM ? (nM - fm) : WGM;
        u.pm = fm + ((wgid % nig) % gsz); u.pn = (wgid % nig) / gsz; u.pb = u.pn; u.e = 0; return true;
    }
    __device__ __forceinline__ unsigned arow(const Unit&, int) const { return 0u; }
};

template <class Epi, class Sched>
__device__ __forceinline__ void gemm_phase(LAS unsigned char* lds, const Gemm g, const Sched& S, const Epi& E) {
    constexpr bool GATHER = Sched::GATHER;
    const int tid = threadIdx.x, wid = __builtin_amdgcn_readfirstlane(tid >> 6), lane = tid & 63, wr = wid >> 2, wc = wid & 3, fr = lane & 15, fq = lane >> 4;
    const int K = g.K, nt = K / BK;
    unsigned voffB[2]; int RA[2], CA[2];
#pragma unroll
    for (int i = 0; i < 2; ++i) { int R_, C_; stage_rc(tid * 16 + i * 8192, R_, C_); const int Rb = Epi::PERM ? ((R_ & ~31) + perm32(R_ & 31)) : R_;
        RA[i] = R_; CA[i] = C_; voffB[i] = (unsigned)(Rb * K + C_) * 2u; }
    const size_t kstep = (size_t)(BK * 2);
    const size_t hstep = (size_t)HALF * K * 2;
    const size_t tstep = 2 * hstep;
    const unsigned ldsw = (unsigned)wid * 1024u;
    const int aoff = lds_byte(wr * 64 + fr, fq * 8), boff = lds_byte(wc * 32 + fr, fq * 8);
#define PG8_SA(b, h) (((b) * 2 + (h)) * HTB)
#define PG8_SB(b, h) ((4 + (b) * 2 + (h)) * HTB)
#define PG8_STAGE(bufoff, gbase, voff) do { _Pragma("unroll") for (int _i = 0; _i < 2; ++_i) \
        __builtin_amdgcn_global_load_lds((const unsigned*)((const char*)(gbase) + (voff)[_i]), (LAS unsigned*)(lds + (bufoff) + ldsw + _i * 8192), 16, 0, 0); } while (0)
#define PG8_LDA(dst, b, h) do { _Pragma("unroll") for (int m = 0; m < 4; ++m) _Pragma("unroll") for (int k = 0; k < 2; ++k) dst[m][k] = *(const LAS bf16x8*)(lds + PG8_SA(b, h) + aoff + m * 2048 + k * 1024); } while (0)
#define PG8_LDB(dst, b, h) do { _Pragma("unroll") for (int n = 0; n < 2; ++n) _Pragma("unroll") for (int k = 0; k < 2; ++k) dst[n][k] = *(const LAS bf16x8*)(lds + PG8_SB(b, h) + boff + n * 2048 + k * 1024); } while (0)
#define PG8_MMA(ai, bj, At, Bt) do { __builtin_amdgcn_s_setprio(1); _Pragma("unroll") for (int m = 0; m < 4; ++m) _Pragma("unroll") for (int n = 0; n < 2; ++n) _Pragma("unroll") for (int k = 0; k < 2; ++k) \
        acc[ai][bj][m][n] = __builtin_amdgcn_mfma_f32_16x16x32_bf16(Bt[n][k], At[m][k], acc[ai][bj][m][n], 0, 0, 0); __builtin_amdgcn_s_setprio(0); } while (0)
#define PG8_WAIT_V(n) asm volatile("s_waitcnt vmcnt(" #n ")" ::: "memory")
#define PG8_WAIT_L(n) asm volatile("s_waitcnt lgkmcnt(" #n ")" ::: "memory")
#define PG8_BAR __builtin_amdgcn_s_barrier()
#define PG8_SCHED __builtin_amdgcn_sched_barrier(0)
#define PG8_AOFFS(dst, u) do { _Pragma("unroll") for (int _h = 0; _h < 2; ++_h) _Pragma("unroll") for (int _i = 0; _i < 2; ++_i) { \
        if constexpr (GATHER) dst[_h][_i] = (S.arow(u, _h * HALF + RA[_i]) * (unsigned)K + (unsigned)CA[_i]) * 2u; \
        else dst[_h][_i] = ((unsigned)((_h * HALF + RA[_i]) * K + CA[_i])) * 2u; } } while (0)
    Unit cur, nxt; int ui = 0;
    if (!S.next(0, cur)) return;
    f32x4 acc[2][2][4][2];
#pragma unroll
    for (int a = 0; a < 2; ++a)
#pragma unroll
        for (int b = 0; b < 2; ++b)
#pragma unroll
            for (int m = 0; m < 4; ++m)
#pragma unroll
                for (int n = 0; n < 2; ++n) acc[a][b][m][n] = (f32x4){0.f, 0.f, 0.f, 0.f};
    bf16x8 At[4][2], B0[2][2], B1[2][2];
    unsigned vAc[2][2], vAn[2][2];
    PG8_AOFFS(vAc, cur);
    const char* cA = GATHER ? (const char*)g.A : (const char*)g.A + (size_t)cur.pm * tstep; const char* cB = (const char*)g.Bt + (size_t)cur.pb * tstep;
    PG8_STAGE(PG8_SB(0, 0), cB, voffB); PG8_STAGE(PG8_SB(0, 1), cB + hstep, voffB); PG8_STAGE(PG8_SA(0, 0), cA, vAc[0]); PG8_STAGE(PG8_SA(0, 1), cA, vAc[1]);
    if (wr == 1) PG8_BAR;
    PG8_WAIT_V(2); PG8_BAR;
    PG8_STAGE(PG8_SB(1, 0), cB + kstep, voffB); PG8_STAGE(PG8_SA(1, 0), cA + kstep, vAc[0]); PG8_STAGE(PG8_SB(1, 1), cB + hstep + kstep, voffB);
    PG8_WAIT_V(6); PG8_BAR;
    for (;;) {
        const bool has_next = S.next(ui + 1, nxt);
        if (has_next) { PG8_AOFFS(vAn, nxt); } else {
#pragma unroll
            for (int _h = 0; _h < 2; ++_h)
#pragma unroll
                for (int _i = 0; _i < 2; ++_i) vAn[_h][_i] = vAc[_h][_i]; }
        const char* nA = has_next ? (GATHER ? (const char*)g.A : (const char*)g.A + (size_t)nxt.pm * tstep) : cA; const char* nB = has_next ? (const char*)g.Bt + (size_t)nxt.pb * tstep : cB;
#pragma unroll 1
        for (int t = 0; t < nt; t += 2) {
            const bool last = (t == nt - 2);
            const char* a1 = cA + (size_t)(t + 1) * kstep;
            const char* a2 = last ? nA : cA + (size_t)(t + 2) * kstep; const char* b2 = last ? nB : cB + (size_t)(t + 2) * kstep;
            const char* a3 = a2 + kstep; const char* b3 = b2 + kstep;
            unsigned v2[2][2];
#pragma unroll
            for (int _h = 0; _h < 2; ++_h)
#pragma unroll
                for (int _i = 0; _i < 2; ++_i) v2[_h][_i] = last ? vAn[_h][_i] : vAc[_h][_i];
            PG8_LDB(B0, 0, 0); PG8_LDB(B1, 0, 1); PG8_SCHED; PG8_LDA(At, 0, 0); PG8_STAGE(PG8_SA(1, 1), a1, vAc[1]);
            PG8_WAIT_V(8); PG8_WAIT_L(0); PG8_BAR; PG8_MMA(0, 0, At, B0); PG8_MMA(0, 1, At, B1); PG8_BAR; PG8_SCHED;
            PG8_LDA(At, 0, 1); PG8_STAGE(PG8_SB(0, 0), b2, voffB); PG8_STAGE(PG8_SB(0, 1), b2 + hstep, voffB); PG8_STAGE(PG8_SA(0, 0), a2, v2[0]);
            PG8_WAIT_V(8); PG8_WAIT_L(0); PG8_BAR; PG8_MMA(1, 0, At, B0); PG8_MMA(1, 1, At, B1); PG8_BAR; PG8_SCHED;
            PG8_LDB(B0, 1, 0); PG8_LDB(B1, 1, 1); PG8_SCHED; PG8_LDA(At, 1, 0); PG8_STAGE(PG8_SA(0, 1), a2, v2[1]);
            PG8_WAIT_V(8); PG8_WAIT_L(0); PG8_BAR; PG8_MMA(0, 0, At, B0); PG8_MMA(0, 1, At, B1); PG8_BAR; PG8_SCHED;
            PG8_LDA(At, 1, 1); PG8_STAGE(PG8_SB(1, 0), b3, voffB); PG8_STAGE(PG8_SB(1, 1), b3 + hstep, voffB); PG8_STAGE(PG8_SA(1, 0), a3, v2[0]);
            PG8_WAIT_V(8); PG8_WAIT_L(0); PG8_BAR; PG8_MMA(1, 0, At, B0); PG8_MMA(1, 1, At, B1); PG8_BAR; PG8_SCHED;
        }
        if (wr == 0) PG8_BAR;
        E(acc, cur, wr, wc, fr, fq);
        if (!has_next) break;
#pragma unroll
        for (int a = 0; a < 2; ++a)
#pragma unroll
            for (int b = 0; b < 2; ++b)
#pragma unroll
                for (int m = 0; m < 4; ++m)
#pragma unroll
                    for (int n = 0; n < 2; ++n) acc[a][b][m][n] = (f32x4){0.f, 0.f, 0.f, 0.f};
        cur = nxt; cA = nA; cB = nB; ++ui;
#pragma unroll
        for (int _h = 0; _h < 2; ++_h)
#pragma unroll
            for (int _i = 0; _i < 2; ++_i) vAc[_h][_i] = vAn[_h][_i];
        if (wr == 1) PG8_BAR;
    }
    PG8_WAIT_V(0);
    PG8_BAR;
#undef PG8_SA
#undef PG8_SB
#undef PG8_STAGE
#undef PG8_LDA
#undef PG8_LDB
#undef PG8_MMA
#undef PG8_WAIT_V
#undef PG8_WAIT_L
#undef PG8_BAR
#undef PG8_SCHED
#undef PG8_AOFFS
}
}
namespace att {
constexpr int NW = 8, QBLK = 32, KVBLK = 64, DV = 128;
#define KSWZ(row, colB, RS) ((row) * (RS) + ((colB) ^ (((row) & 7) << 4)))
#define SBAR() __builtin_amdgcn_sched_barrier(0)
__device__ __forceinline__ int crow(int r, int hi) { return (r & 3) + 8 * (r >> 2) + 4 * hi; }
constexpr float THR = 8.f;
constexpr float LOG2E = 1.4426950408889634f;

__device__ __forceinline__ void partialSM(f32x16& p0, f32x16& p1, float& m_reg, float& mn, float& alpha) {
  constexpr float C = LOG2E;
  float pmax = p0[0];
#pragma unroll
  for (int r = 1; r < 16; ++r) pmax = fmaxf(pmax, p0[r]);
#pragma unroll
  for (int r = 0; r < 16; ++r) pmax = fmaxf(pmax, p1[r]);
  { auto rr = __builtin_amdgcn_permlane32_swap(__float_as_uint(pmax), __float_as_uint(pmax), false, false);
    pmax = fmaxf(__uint_as_float(rr[0]), __uint_as_float(rr[1])); }
  if (__builtin_expect(__all(pmax - m_reg <= THR), 1)) { mn = m_reg; alpha = 1.f; }
  else { mn = fmaxf(m_reg, pmax); alpha = __builtin_amdgcn_exp2f((m_reg - mn) * C); m_reg = mn; }
  float mnC = -mn * C;
#pragma unroll
  for (int r = 0; r < 16; ++r) p0[r] = fmaf(p0[r], C, mnC);
#pragma unroll
  for (int r = 0; r < 16; ++r) p1[r] = fmaf(p1[r], C, mnC);
#pragma unroll
  for (int r = 0; r < 16; ++r) p0[r] = __builtin_amdgcn_exp2f(p0[r]);
}
__device__ __forceinline__ void finishSM(f32x16& p0, f32x16& p1, float alpha, float& l_reg, bf16x8& pa0, bf16x8& pa1, bf16x8& pa2, bf16x8& pa3) {
#pragma unroll
  for (int r = 0; r < 16; ++r) p1[r] = __builtin_amdgcn_exp2f(p1[r]);
  float ps = 0;
#pragma unroll
  for (int r = 0; r < 16; ++r) ps += p0[r];
#pragma unroll
  for (int r = 0; r < 16; ++r) ps += p1[r];
  { auto rr = __builtin_amdgcn_permlane32_swap(__float_as_uint(ps), __float_as_uint(ps), false, false);
    ps = __uint_as_float(rr[0]) + __uint_as_float(rr[1]); }
  l_reg = l_reg * alpha + ps;
#define PK4(P, BASE, OUT) do { unsigned a0 = cvt_pk_bf16(P[BASE + 0], P[BASE + 1]), a1 = cvt_pk_bf16(P[BASE + 2], P[BASE + 3]);   \
    unsigned b0 = cvt_pk_bf16(P[BASE + 4], P[BASE + 5]), b1 = cvt_pk_bf16(P[BASE + 6], P[BASE + 7]);                              \
    auto r0 = __builtin_amdgcn_permlane32_swap(a0, b0, false, false); auto r1 = __builtin_amdgcn_permlane32_swap(a1, b1, false, false); \
    u32x4 w = {r0[0], r1[0], r0[1], r1[1]}; OUT = *reinterpret_cast<bf16x8*>(&w); } while (0)
  PK4(p0, 0, pa0); PK4(p0, 8, pa1); PK4(p1, 0, pa2); PK4(p1, 8, pa3);
#undef PK4
}
template <int DQK, int QL>
__device__ __forceinline__ void qkt(f32x16& p0, f32x16& p1, const char* Ks, const bf16x8* qr, const char* qlds, int r32, int hi) {
  p0 = f32x16{}; p1 = f32x16{};
  constexpr int NQ = DQK / 16, NR = NQ - QL;
#pragma unroll
  for (int d0 = 0; d0 < NQ; ++d0) { int cb = (d0 * 16 + hi * 8) * 2;
    bf16x8 b0 = *reinterpret_cast<const bf16x8*>(Ks + KSWZ(r32, cb, DQK * 2));
    bf16x8 b1 = *reinterpret_cast<const bf16x8*>(Ks + KSWZ(32 + r32, cb, DQK * 2));
    bf16x8 q; if (d0 < NR) q = qr[d0 < NR ? d0 : 0]; else q = *reinterpret_cast<const bf16x8*>(qlds + (d0 - NR) * 1024);
    p0 = __builtin_amdgcn_mfma_f32_32x32x16_bf16(b0, q, p0, 0, 0, 0);
    p1 = __builtin_amdgcn_mfma_f32_32x32x16_bf16(b1, q, p1, 0, 0, 0);
    if ((d0 & 1) == 1) asm volatile("" ::: "memory"); }
}
__device__ __forceinline__ int v_st(int k, int c) { const int kk = (k & ~0xC) | ((k & 4) << 1) | ((k & 8) >> 1); return ((kk >> 3) * 4 + (c >> 5)) * 512 + ((kk & 7) * 32 + (c & 31)) * 2; }
__device__ __forceinline__ int v_rd_base(int lane) { return ((lane & 3) << 3) | (((lane >> 2) & 3) << 6) | (((lane >> 4) & 1) << 5) | (((lane >> 5) & 1) << 8); }
constexpr int v_rd_off(int d0, int ks, int half) { return d0 * 512 + ks * 4096 + half * 2048; }
template <int OFF> __device__ __forceinline__ s16x4 tr_read(int vb) {
  s16x4 r; asm volatile("ds_read_b64_tr_b16 %0, %1 offset:%2" : "=&v"(r) : "v"(vb), "i"(OFF) : "memory"); return r;
}
template <int D0> __device__ __forceinline__ void pv_one(f32x16& od, int vb, bf16x8 pa0, bf16x8 pa1, bf16x8 pa2, bf16x8 pa3) {
  const s16x4 l0 = tr_read<v_rd_off(D0, 0, 0)>(vb), h0 = tr_read<v_rd_off(D0, 0, 1)>(vb), l1 = tr_read<v_rd_off(D0, 1, 0)>(vb), h1 = tr_read<v_rd_off(D0, 1, 1)>(vb);
  const s16x4 l2 = tr_read<v_rd_off(D0, 2, 0)>(vb), h2 = tr_read<v_rd_off(D0, 2, 1)>(vb), l3 = tr_read<v_rd_off(D0, 3, 0)>(vb), h3 = tr_read<v_rd_off(D0, 3, 1)>(vb);
  asm volatile("s_waitcnt lgkmcnt(0)" ::: "memory"); SBAR();
#define PK(L, H) (bf16x8){L[0], L[1], L[2], L[3], H[0], H[1], H[2], H[3]}
  od = __builtin_amdgcn_mfma_f32_32x32x16_bf16(pa0, PK(l0, h0), od, 0, 0, 0);
  od = __builtin_amdgcn_mfma_f32_32x32x16_bf16(pa1, PK(l1, h1), od, 0, 0, 0);
  od = __builtin_amdgcn_mfma_f32_32x32x16_bf16(pa2, PK(l2, h2), od, 0, 0, 0);
  od = __builtin_amdgcn_mfma_f32_32x32x16_bf16(pa3, PK(l3, h3), od, 0, 0, 0);
#undef PK
}
__device__ __forceinline__ void pv_d0(f32x16* o, int vb, bf16x8 pa0, bf16x8 pa1, bf16x8 pa2, bf16x8 pa3) {
  pv_one<0>(o[0], vb, pa0, pa1, pa2, pa3); pv_one<1>(o[1], vb, pa0, pa1, pa2, pa3); pv_one<2>(o[2], vb, pa0, pa1, pa2, pa3); pv_one<3>(o[3], vb, pa0, pa1, pa2, pa3);
}
template <int DQK> struct Shm { static constexpr int V = KVBLK * DV * 2, K = KVBLK * DQK * 2, QL = (DQK > 128 ? (DQK - 128) / 16 : 0), TOTAL = 3 * V + 3 * K + NW * 64 * 4 + QL * NW * 1024; };

template <int DQK, int LDQ, int LDK, int LDV, int LDO>
__device__ __forceinline__ void attn_dense_body(const bf16* __restrict__ Qb, const bf16* __restrict__ Kh, const bf16* __restrict__ Vh, bf16* __restrict__ Ob, int seq, char* lds) {
  constexpr int SHM_V = Shm<DQK>::V, SHM_K = Shm<DQK>::K, NQ = DQK / 16, QL = Shm<DQK>::QL, NR = NQ - QL, KP = DQK / 64  , KROWB = DQK * 2;
  const int tid = threadIdx.x, wid = __builtin_amdgcn_readfirstlane(tid >> 6), lane = tid & 63, r32 = lane & 31, hi = lane >> 5;
  char* K_lds = lds; char* V_lds = lds + 3 * SHM_K;
  float* ws = (float*)(lds + 3 * SHM_V + 3 * SHM_K) + wid * 64; float* li_l = ws; float* al_l = ws + 32;
  float m_reg = -1e30f, l_reg = 0; f32x16 o[4] = {}; bf16x8 qr[NR];
  char* qlds = lds + 3 * SHM_V + 3 * SHM_K + NW * 64 * 4 + wid * (QL * 1024) + lane * 16;
  const bf16* Qw = Qb + (long)(wid * QBLK + r32) * LDQ + hi * 8;
#pragma unroll
  for (int d0 = 0; d0 < NQ; ++d0) { const bf16x8 qv = *reinterpret_cast<const bf16x8*>(Qw + d0 * 16); if (d0 < NR) qr[d0 < NR ? d0 : 0] = qv; else *reinterpret_cast<bf16x8*>(qlds + (d0 - NR) * 1024) = qv; }
  unsigned koff[KP], voff[2];
#pragma unroll
  for (int i = 0; i < KP; ++i) { const int ob = 16 * (tid + 512 * i), row = ob / KROWB, cbs = ob % KROWB, cb = cbs ^ ((row & 7) << 4); koff[i] = (unsigned)(row * LDK * 2 + cb); }
#pragma unroll
  for (int i = 0; i < 2; ++i) { const int ob = 16 * (tid + 512 * i), sub = ob >> 9, rem = ob & 511, kk = (sub >> 2) * 8 + (rem >> 6), cc = (sub & 3) * 32 + ((rem & 63) >> 1);
    const int k = (kk & ~0xC) | ((kk & 4) << 1) | ((kk & 8) >> 1); voff[i] = (unsigned)(k * LDV * 2 + cc * 2); }
  const int vb0 = (int)(uintptr_t)V_lds + v_rd_base(lane);
  const int NT = seq / KVBLK;
#define KDMA(t_, slot_) do { const int _tt = (t_) < NT ? (t_) : NT - 1; const char* _b = (const char*)Kh + (size_t)_tt * (KVBLK * LDK * 2); \
    _Pragma("unroll") for (int _q = 0; _q < KP; ++_q) __builtin_amdgcn_global_load_lds((const unsigned*)(_b + koff[_q]), (LAS unsigned*)(K_lds + (slot_) * SHM_K + _q * 8192 + wid * 1024), 16, 0, 0); } while (0)
#define VDMA(t_, slot_) do { const int _tt = (t_) < NT ? (t_) : NT - 1; const char* _b = (const char*)Vh + (size_t)_tt * (KVBLK * LDV * 2); \
    _Pragma("unroll") for (int _q = 0; _q < 2; ++_q) __builtin_amdgcn_global_load_lds((const unsigned*)(_b + voff[_q]), (LAS unsigned*)(V_lds + (slot_) * SHM_V + _q * 8192 + wid * 1024), 16, 0, 0); } while (0)
#define WAITB() do { asm volatile("s_waitcnt vmcnt(%0)" :: "n"(KP + 2) : "memory"); __builtin_amdgcn_s_barrier(); asm volatile("" ::: "memory"); SBAR(); } while (0)
#define RESC(a) do { if (__any((a) < 1.f)) { if (hi == 0) al_l[r32] = (a); asm volatile("s_waitcnt lgkmcnt(0)" ::: "memory"); \
    _Pragma("unroll") for (int d = 0; d < 4; ++d) _Pragma("unroll") for (int r = 0; r < 16; ++r) o[d][r] *= al_l[crow(r, hi)]; } } while (0)
  f32x16 pA0, pA1, pB0, pB1; float mnA, mnB, alA, alB; bf16x8 pa0, pa1, pa2, pa3;
  KDMA(0, 0); KDMA(1, 1); VDMA(0, 0); KDMA(2, 2); VDMA(1, 1);
  asm volatile("s_waitcnt vmcnt(%0)" :: "n"(2 * (KP + 2)) : "memory"); __builtin_amdgcn_s_barrier(); asm volatile("" ::: "memory"); SBAR();
  int s0 = 0, s1 = 1, s2 = 2;
#define STEP(t_, X0, X1, mnX, alX, Y0, Y1, alY, HASPREV) do { \
    if (HASPREV) { finishSM(Y0, Y1, alY, l_reg, pa0, pa1, pa2, pa3); } \
    SBAR(); qkt<DQK, QL>(X0, X1, K_lds + s0 * SHM_K, qr, qlds, r32, hi); SBAR(); \
    if (HASPREV) { pv_d0(o, vb0 + s2 * SHM_V, pa0, pa1, pa2, pa3); } \
    partialSM(X0, X1, m_reg, mnX, alX); \
    WAITB(); \
    KDMA((t_) + 3, s0); VDMA((t_) + 2, s2); \
    RESC(alX); \
    { const int _r = s0; s0 = s1; s1 = s2; s2 = _r; } } while (0)
  for (int t = 0; t < NT; t += 2) {
    STEP(t, pA0, pA1, mnA, alA, pB0, pB1, alB, t > 0);
    STEP(t + 1, pB0, pB1, mnB, alB, pA0, pA1, alA, true);
  }
  finishSM(pB0, pB1, alB, l_reg, pa0, pa1, pa2, pa3); SBAR();
  pv_d0(o, vb0 + s2 * SHM_V, pa0, pa1, pa2, pa3);
  if (hi == 0) li_l[r32] = l_reg; asm volatile("s_waitcnt lgkmcnt(0)" ::: "memory");
  float rli[16];
#pragma unroll
  for (int r = 0; r < 16; ++r) rli[r] = __builtin_amdgcn_rcpf(li_l[crow(r, hi)]);
  bf16* Ow = Ob + (long)(wid * QBLK) * LDO;
#pragma unroll
  for (int r = 0; r < 16; ++r) { int orow = crow(r, hi);
#pragma unroll
    for (int d0 = 0; d0 < 4; ++d0) Ow[(long)orow * LDO + d0 * 32 + r32] = f2bf(o[d0][r] * rli[r]); }
  asm volatile("s_waitcnt vmcnt(0)" ::: "memory"); __builtin_amdgcn_s_barrier(); asm volatile("" ::: "memory");
  (void)mnA; (void)mnB;
#undef KDMA
#undef VDMA
#undef WAITB
#undef RESC
#undef STEP
}
}
constexpr size_t MiB = 1u << 20;
constexpr size_t WS_CTL = 0, CTL_ZERO_BYTES = 1 * MiB;
constexpr size_t WS_MODS = 1 * MiB;
constexpr size_t WS_TAB_RET = 2 * MiB;
constexpr size_t WS_TAB_A128 = 4 * MiB + 512 * 1024;
constexpr size_t WS_TAB_A64 = WS_TAB_A128 + 16384;
constexpr size_t WS_WABIN = 6 * MiB, WS_WABOUT = 12 * MiB, WS_WMLAIN = 14 * MiB, WS_WUQ = 16 * MiB, WS_WUKV = 18 * MiB, WS_WMLAOUT = 19 * MiB;
constexpr size_t WS_WUP = 22 * MiB, WS_WDOWN = 278 * MiB;
constexpr size_t WS_X = 406 * MiB, WS_ACC = 542 * MiB, WS_H = 678 * MiB, WS_P = 746 * MiB, WS_MIX = 950 * MiB;
constexpr size_t WS_KZTF = 1018 * MiB, WS_KZTB = 1052 * MiB, WS_VBT = 1086 * MiB, WS_ST = 1120 * MiB;
constexpr size_t WS_LTOK = 1188 * MiB, WS_LGATE = 1205 * MiB, WS_TOKSLOT = 1222 * MiB, WS_ACT = 1223 * MiB, WS_YK = 1511 * MiB, WS_END = 1799 * MiB;
constexpr size_t WS_PM = WS_P, WS_CQ = WS_P + 51 * MiB, WS_CKV = WS_CQ + 25 * MiB + 512 * 1024, WS_QM = WS_CKV + 17 * MiB;
constexpr size_t WS_KM = WS_KZTF, WS_VM = WS_ST;
static_assert(WS_QM + (size_t)R * UQ_N * 2 <= WS_MIX, "MLA overlay fits in P");
static_assert(WS_KM + (size_t)R * UQ_N * 2 <= WS_ST && WS_VM + (size_t)R * 1024 * 2 <= WS_LTOK, "MLA K/V overlay");
static_assert(WS_ACT + (size_t)NSLOT_MAX * 1024 * 2 <= WS_YK && WS_YK + (size_t)NSLOT_MAX * 1024 * 2 <= WS_END, "MoE buffers");
constexpr int CW_TMO = 0, CW_BAR = 4096, CW_CNT = 16384;

constexpr int RING_BYTES = 131072;
constexpr int ATT_BYTES = 157696;
constexpr int XTRA_OFF = RING_BYTES;
constexpr int MISC_OFF = ATT_BYTES;
constexpr int LDS_BYTES = ATT_BYTES + 1024;
static_assert(att::Shm<192>::TOTAL <= ATT_BYTES && att::Shm<128>::TOTAL <= ATT_BYTES && LDS_BYTES <= 163840, "LDS map");

#define XB_TMO      128
#define XB_XCNT(j)  (256  + 64 * (j))
#define XB_XSUB(j)  (1280 + 64 * (j))
#define XB_XGEN(j)  (2304 + 64 * (j))
#define XB_TOP      3328
#define XB_TOPGEN   3392
#define XCD_BAR_WORDS 3456
#define XB_SPIN_CAP (1u << 22)
__device__ __forceinline__ unsigned xb_ld(unsigned* p)              { return __hip_atomic_load(p, __ATOMIC_RELAXED, __HIP_MEMORY_SCOPE_AGENT); }
__device__ __forceinline__ unsigned xb_add(unsigned* p, unsigned v) { return __hip_atomic_fetch_add(p, v, __ATOMIC_RELAXED, __HIP_MEMORY_SCOPE_AGENT); }
__device__ __forceinline__ unsigned xb_xcc_id() { return (unsigned)__builtin_amdgcn_s_getreg((3 << 11) | 20) & 0xFu; }
#define XB_SPIN(cond, bar) do { unsigned _sp = 0; while (cond) { __builtin_amdgcn_s_sleep(1); \
    if ((++_sp & 255u) == 0u) { if (xb_ld(&(bar)[XB_TMO])) break; if (_sp > XB_SPIN_CAP) { atomicAdd(&(bar)[XB_TMO], 1u); break; } } } } while (0)
struct XcdBarrier { unsigned* bar; unsigned x; volatile LAS unsigned* st; };
__device__ __forceinline__ XcdBarrier xcd_barrier_post(unsigned* bar, volatile LAS unsigned* st) {
    XcdBarrier b; b.bar = bar; b.x = xb_xcc_id(); b.st = st;
    if (threadIdx.x == 0) (void)xb_add(&bar[XB_XCNT(b.x)], 1u);
    return b;
}
__device__ __forceinline__ void xcd_barrier_complete(unsigned* bar, unsigned x, unsigned& nloc, unsigned& nx) {
    const unsigned G = gridDim.x * gridDim.y * gridDim.z;
    unsigned sum, cnt, mine, sp = 0u;
    for (;;) {
        sum = 0u; cnt = 0u; mine = 0u;
#pragma unroll
        for (unsigned j = 0; j < 16; ++j) { const unsigned c = xb_ld(&bar[XB_XCNT(j)]); sum += c; cnt += (c > 0u) ? 1u : 0u; mine = (j == x) ? c : mine; }
        if (sum == G) break;
        __builtin_amdgcn_s_sleep(1);
        if ((++sp & 255u) == 0u) { if (xb_ld(&bar[XB_TMO])) break; if (sp > XB_SPIN_CAP) { atomicAdd(&bar[XB_TMO], 1u); break; } }
    }
    nloc = mine > 0u ? mine : 1u; nx = cnt > 0u ? cnt : 1u;
}
__device__ __forceinline__ void xcd_barrier(const XcdBarrier& b) {
    asm volatile("s_waitcnt vmcnt(0)" ::: "memory");
    __syncthreads();
    if (threadIdx.x == 0) {
        unsigned* bar = b.bar;
        __builtin_amdgcn_s_waitcnt(0);
        unsigned nloc = b.st[0], nx = b.st[1];
        if (nloc == 0u) { xcd_barrier_complete(bar, b.x, nloc, nx); b.st[0] = nloc; b.st[1] = nx; }
        const unsigned old = xb_add(&bar[XB_XSUB(b.x)], 1u);
        const unsigned gen = old / nloc;
        if (old + 1u == (gen + 1u) * nloc) {
            __builtin_amdgcn_fence(__ATOMIC_RELEASE, "agent");
            asm volatile("s_waitcnt vmcnt(0)" ::: "memory");
            const unsigned og = xb_add(&bar[XB_TOP], 1u);
            const unsigned tg = og / nx;
            if (og + 1u == (tg + 1u) * nx) xb_add(&bar[XB_TOPGEN], 1u);
            else XB_SPIN(xb_ld(&bar[XB_TOPGEN]) == tg, bar);
            __builtin_amdgcn_fence(__ATOMIC_ACQUIRE, "agent");
            xb_add(&bar[XB_XGEN(b.x)], 1u);
            asm volatile("s_waitcnt vmcnt(0)" ::: "memory");
        } else {
            XB_SPIN(xb_ld(&bar[XB_XGEN(b.x)]) == gen, bar);
            __builtin_amdgcn_fence(__ATOMIC_ACQUIRE, "agent");
            asm volatile("s_waitcnt vmcnt(0)" ::: "memory");
        }
    }
    __syncthreads();
}

struct Args { const float* in[28]; float* out; unsigned char* ws; int ph_lo, ph_hi; };
struct Ctx { LAS unsigned char* lds; int tid, lane, wave, vcu, G, gw, NGW; };
enum { I_X = 0, I_C, I_CTX, I_CCTX, I_ADAW, I_ADAB, I_LN1G, I_LN1B, I_LN2G, I_LN2B, I_ABWIN, I_ABQN, I_ABKN, I_ABLD, I_ABGN, I_ABWOUT,
       I_MLAWIN, I_MLAQN, I_MLAKVN, I_MLAWUQ, I_MLAWUKV, I_MLAWOUT, I_RW, I_RB, I_WUP, I_BUP, I_WDOWN, I_BDOWN };
template <int MAP> __device__ __forceinline__ int colmap(int r) {
    if constexpr (MAP == 0) return r;
    else if constexpr (MAP == 1) { const int t = r >> 8, cc = r & 255; return cc < 128 ? t * 128 + cc : 1024 + t * 128 + (cc - 128); }
    else if constexpr (MAP == 2) return r < MLA_IN ? r : -1;
    else {
        if (r < 1024) { const int h = r >> 7, i = r & 127; return h * 192 + i; }
        const int rr = r - 1024, t = rr >> 8, cc = rr & 255, bj = cc >> 7, c2 = cc & 127, head = 4 * t + (c2 >> 5), j = c2 & 31;
        return head * 192 + 128 + (j < 16 ? j : 16 + j) + (bj ? 16 : 0);
    }
}
template <int MAP> __device__ __forceinline__ void tr_item(const float* __restrict__ W, int K, int N, bf16* __restrict__ WT, LAS float* scr, int item, int nblk, int lane) {
    const int kb = item / nblk, nb = item % nblk, k0 = 64 * kb, n0 = 32 * nb;
    const int col = colmap<MAP>(n0 + (lane & 31));
    const float* src = W + (size_t)(k0 + (lane >> 5)) * N + (col >= 0 ? col : 0);
#pragma unroll 8
    for (int i = 0; i < 32; ++i) { const int kk = 2 * i + (lane >> 5); const float v = src[(size_t)(2 * i) * N]; scr[kk * 33 + (lane & 31)] = col >= 0 ? v : 0.f; }
    LDS_WAIT(); asm volatile("" ::: "memory");
    const int c8 = lane & 7;
#pragma unroll
    for (int j = 0; j < 4; ++j) { const int n = (lane >> 3) + 8 * j; const LAS float* s = scr + (8 * c8) * 33 + n;
        u32x4 o; o.x = cvt_pk_bf16(s[0 * 33], s[1 * 33]); o.y = cvt_pk_bf16(s[2 * 33], s[3 * 33]); o.z = cvt_pk_bf16(s[4 * 33], s[5 * 33]); o.w = cvt_pk_bf16(s[6 * 33], s[7 * 33]);
        *(u32x4*)(WT + (size_t)(n0 + n) * K + k0 + 8 * c8) = o; }
    LDS_WAIT(); asm volatile("" ::: "memory");
}
__device__ __forceinline__ void ph0_prologue(const Args& a, const Ctx& c) {
    unsigned char* ws = a.ws;
    float* mods = (float*)(ws + WS_MODS);
    {
        LAS float* sc = (LAS float*)c.lds;
        for (int i = c.tid; i < 9 * 1024; i += 512) { const float v = (i < 8192) ? a.in[I_C][i] : a.in[I_CCTX][i - 8192]; sc[i] = v / (1.f + expf(-v)); }
        __syncthreads();
        if (c.gw < 192) {
            const int l = c.gw / 96, j = (c.gw % 96) * 64 + c.lane;
            const float* W = a.in[I_ADAW] + (size_t)l * 1024 * 6144 + j;
            float acc[9];
#pragma unroll
            for (int b = 0; b < 9; ++b) acc[b] = 0.f;
#pragma unroll 8
            for (int d = 0; d < 1024; ++d) { const float w = W[(size_t)d * 6144];
#pragma unroll
                for (int b = 0; b < 9; ++b) acc[b] = fmaf(sc[b * 1024 + d], w, acc[b]); }
            const float bias = a.in[I_ADAB][l * 6144 + j];
#pragma unroll
            for (int b = 0; b < 9; ++b) mods[(size_t)(l * 9 + b) * 6144 + j] = acc[b] + bias;
        }
        __syncthreads();
    }
    {
        float2* ret = (float2*)(ws + WS_TAB_RET); float2* a128 = (float2*)(ws + WS_TAB_A128); float2* a64 = (float2*)(ws + WS_TAB_A64);
        const int gt = c.gw * 64 + c.lane, NT = c.NGW * 64;
        for (int i = gt; i < SP * 64; i += NT) { const int pos = i >> 6, f = i & 63; const double ang = (double)pos * pow(10000.0, -(double)f / 64.0); ret[i] = make_float2((float)cos(ang), (float)sin(ang)); }
        for (int i = gt; i < 64 * 32; i += NT) { const int pos = i >> 5, f = i & 31; const double ang = (double)pos * pow(10000.0, -(double)f / 32.0); a128[i] = make_float2((float)cos(ang), (float)sin(ang)); }
        for (int i = gt; i < 64 * 16; i += NT) { const int pos = i >> 4, f = i & 15; const double ang = (double)pos * pow(10000.0, -(double)f / 16.0); a64[i] = make_float2((float)cos(ang), (float)sin(ang)); }
    }
    {
        LAS float* scr = (LAS float*)(c.lds + c.wave * 16384);
        constexpr int I0 = 16 * 96, I1 = 16 * 32, I2 = 16 * 24, I3 = 6 * 48, I4 = 4 * 64, I5 = 16 * 32, IUP = 16 * 64, IDN = 16 * 32;
        constexpr int NITEMS = I0 + I1 + I2 + I3 + I4 + I5 + 64 * IUP + 64 * IDN;
        for (int it = c.gw; it < NITEMS; it += c.NGW) {
            int r = it;
            if (r < I0) { tr_item<0>(a.in[I_ABWIN], 1024, AB_IN, (bf16*)(ws + WS_WABIN), scr, r, 96, c.lane); continue; } r -= I0;
            if (r < I1) { tr_item<0>(a.in[I_ABWOUT], 1024, 1024, (bf16*)(ws + WS_WABOUT), scr, r, 32, c.lane); continue; } r -= I1;
            if (r < I2) { tr_item<2>(a.in[I_MLAWIN], 1024, MLA_IN, (bf16*)(ws + WS_WMLAIN), scr, r, 24, c.lane); continue; } r -= I2;
            if (r < I3) { tr_item<3>(a.in[I_MLAWUQ], MLA_QL, UQ_N, (bf16*)(ws + WS_WUQ), scr, r, 48, c.lane); continue; } r -= I3;
            if (r < I4) { tr_item<0>(a.in[I_MLAWUKV], MLA_KVL, UKV_N, (bf16*)(ws + WS_WUKV), scr, r, 64, c.lane); continue; } r -= I4;
            if (r < I5) { tr_item<0>(a.in[I_MLAWOUT], 1024, 1024, (bf16*)(ws + WS_WMLAOUT), scr, r, 32, c.lane); continue; } r -= I5;
            if (r < 64 * IUP) { const int m = r / IUP; tr_item<1>(a.in[I_WUP] + (size_t)m * 1024 * 2048, 1024, 2048, (bf16*)(ws + WS_WUP) + (size_t)m * 2048 * 1024, scr, r % IUP, 64, c.lane); continue; } r -= 64 * IUP;
            { const int m = r / IDN; tr_item<0>(a.in[I_WDOWN] + (size_t)m * 1024 * 1024, 1024, 1024, (bf16*)(ws + WS_WDOWN) + (size_t)m * 1024 * 1024, scr, r % IDN, 32, c.lane); }
        }
    }
}

__device__ __forceinline__ void ph1_mod0(const Args& a, const Ctx& c) {
    const float* mods = (const float*)(a.ws + WS_MODS); bf16* H = (bf16*)(a.ws + WS_H);
    for (int row = c.gw; row < R; row += c.NGW) {
        const int b = row / SP, s = row % SP;
        const float* src = s < NCTX ? a.in[I_CTX] + ((size_t)b * NCTX + s) * D : a.in[I_X] + ((size_t)b * SEQ + (s - NCTX)) * D;
        const float* m = mods + (size_t)(s < NCTX ? 8 : b) * 6144;
        bf16* dst = H + (size_t)row * D;
#pragma unroll
        for (int j = 0; j < 4; ++j) { const int col = 4 * c.lane + 256 * j;
            const f32x4 x = *(const f32x4*)(src + col), sh = *(const f32x4*)(m + col), sl = *(const f32x4*)(m + 1024 + col);
            const f32x4 h = x * (sl + 1.0f) + sh;
            u32x2 o; o.x = cvt_pk_bf16(h[0], h[1]); o.y = cvt_pk_bf16(h[2], h[3]); *(u32x2*)(dst + col) = o; }
    }
}

__device__ __forceinline__ void st16(void* base, unsigned off, u32x4 v) { *(u32x4*)((char*)base + off) = v; }
__device__ __forceinline__ void st8(void* base, unsigned off, u32x2 v) { *(u32x2*)((char*)base + off) = v; }
__device__ __forceinline__ u32x4 pack2x4(const f32x4 v0, const f32x4 v1) { u32x4 w; w.x = cvt_pk_bf16(v0[0], v0[1]); w.y = cvt_pk_bf16(v0[2], v0[3]); w.z = cvt_pk_bf16(v1[0], v1[1]); w.w = cvt_pk_bf16(v1[2], v1[3]); return w; }
struct EpiStoreBf16 {
    static constexpr bool PERM = true;
    bf16* O; int ldc;
    __device__ __forceinline__ void operator()(const f32x4 (&acc)[2][2][4][2], const pg8::Unit& u, int wr, int wc, int fr, int fq) const {
        const unsigned rb = ((unsigned)(u.pm * 256 + wr * 64 + fr) * (unsigned)ldc + (unsigned)(u.pn * 256 + wc * 32 + 8 * fq)) * 2u;
#pragma unroll
        for (int ai = 0; ai < 2; ++ai)
#pragma unroll
            for (int m = 0; m < 4; ++m) { const unsigned ro = rb + (unsigned)((ai * 128 + m * 16) * ldc) * 2u;
#pragma unroll
                for (int bj = 0; bj < 2; ++bj) st16(O, ro + bj * 256, pack2x4(acc[ai][bj][m][0], acc[ai][bj][m][1])); }
    }
};
template <int L> struct EpiResid {
    static constexpr bool PERM = false;
    const float* xlat; const float* xctx; const float* X; const float* mods  ; float* ACC;
    __device__ __forceinline__ void operator()(const f32x4 (&acc)[2][2][4][2], const pg8::Unit& u, int wr, int wc, int fr, int fq) const {
        const int b = u.pm / 17, tt = u.pm % 17; const bool isc = (tt == 0);
        const float* src; if constexpr (L == 0) src = isc ? xctx + (size_t)b * NCTX * D : xlat + ((size_t)b * SEQ + (size_t)(tt - 1) * 256) * D; else src = X + (size_t)u.pm * 256 * D;
        const float* m2 = mods + (size_t)(isc ? 8 : b) * 6144 + 2 * 1024;
        float* dst = ACC + (size_t)u.pm * 256 * D;
        const int col0 = u.pn * 256 + wc * 32 + 4 * fq;
        const unsigned rb = ((unsigned)(wr * 64 + fr) * D + (unsigned)col0) * 4u;
        f32x4 mv[2][2];
#pragma unroll
        for (int bj = 0; bj < 2; ++bj)
#pragma unroll
            for (int n = 0; n < 2; ++n) mv[bj][n] = *(const f32x4*)(m2 + col0 + bj * 128 + n * 16);
#pragma unroll
        for (int ai = 0; ai < 2; ++ai)
#pragma unroll
            for (int m = 0; m < 4; ++m) { const unsigned ro = rb + (unsigned)((ai * 128 + m * 16) * D) * 4u;
#pragma unroll
                for (int bj = 0; bj < 2; ++bj)
#pragma unroll
                    for (int n = 0; n < 2; ++n) { const unsigned o = ro + (bj * 128 + n * 16) * 4;
                        const f32x4 xv = *(const f32x4*)((const char*)src + o);
                        *(f32x4*)((char*)dst + o) = xv * DN_ALPHA + mv[bj][n] * acc[ai][bj][m][n]; } }
    }
};
__device__ __forceinline__ void unpack8(const u32x4 w, float* v) { v[0] = bflo(w.x); v[1] = bfhi(w.x); v[2] = bflo(w.y); v[3] = bfhi(w.y); v[4] = bflo(w.z); v[5] = bfhi(w.z); v[6] = bflo(w.w); v[7] = bfhi(w.w); }
__device__ __forceinline__ u32x4 pack8(const float* v) { u32x4 w; w.x = cvt_pk_bf16(v[0], v[1]); w.y = cvt_pk_bf16(v[2], v[3]); w.z = cvt_pk_bf16(v[4], v[5]); w.w = cvt_pk_bf16(v[6], v[7]); return w; }
__device__ __forceinline__ float log_gamma_of(float log_decay) { return (float)log1p(-exp((double)log_decay)); }

__device__ __forceinline__ void ph3_post(const Args& a, const Ctx& c) {
    bf16* P = (bf16*)(a.ws + WS_P);
    const float2* RET = (const float2*)(a.ws + WS_TAB_RET); const float2* A128 = (const float2*)(a.ws + WS_TAB_A128);
    const float* qn = a.in[I_ABQN]; const float* kn = a.in[I_ABKN]; const float* ld = a.in[I_ABLD];
    bf16* KZTF = (bf16*)(a.ws + WS_KZTF); bf16* KZTB = (bf16*)(a.ws + WS_KZTB); bf16* VBT = (bf16*)(a.ws + WS_VBT);
    LAS bf16* T0 = (LAS bf16*)c.lds; LAS bf16* T1 = T0 + 128 * 72;
    const int tok = c.tid >> 3, j = c.tid & 7;
    constexpr float QK_SCALE = 0.08838834764831845f;
    for (int u = c.vcu; u < (R / 64) * 18; u += c.G) {
        const int rb = u / 18, kind = u % 18;
        const int row0 = rb * 64, b0 = row0 / SP, s0 = row0 % SP;
        const int row = row0 + tok, s = s0 + tok; const bool lat = s0 >= NCTX;
        bf16* prow = P + (size_t)row * AB_IN;
        if (kind < 14) {
            int cb, x1c, x2c;
            if (kind < 6) { cb = kind * 128; x1c = j < 4 ? 8 * j : 64 + 8 * (j - 4); x2c = x1c + 32; }
            else { cb = 1024 + (kind - 6) * 128; x1c = 8 * j; x2c = 64 + 8 * j; }
            float v1[8], v2[8], o1[8], o2[8];
            unpack8(*(const u32x4*)(prow + cb + x1c), v1); unpack8(*(const u32x4*)(prow + cb + x2c), v2);
            if (kind < 6) {
                float ss = 0.f;
#pragma unroll
                for (int i = 0; i < 8; ++i) ss += v1[i] * v1[i] + v2[i] * v2[i];
                ss += __shfl_xor(ss, 1); ss += __shfl_xor(ss, 2); ss += __shfl_xor(ss, 4);
                const float rinv = rsqrtf(ss * (1.f / 128.f) + 1e-6f);
                const float* g = kind < 4 ? qn : kn;
#pragma unroll
                for (int i = 0; i < 8; ++i) { v1[i] *= rinv * g[x1c + i]; v2[i] *= rinv * g[x2c + i]; }
                if (lat) { const int t = s - NCTX; const int pos = j < 4 ? t / GRID_W : t % GRID_W; const float2* cs = A128 + pos * 32 + (j & 3) * 8;
#pragma unroll
                    for (int i = 0; i < 8; ++i) { const float2 q = cs[i]; o1[i] = v1[i] * q.x - v2[i] * q.y; o2[i] = v1[i] * q.y + v2[i] * q.x; } }
                else {
#pragma unroll
                    for (int i = 0; i < 8; ++i) { o1[i] = v1[i]; o2[i] = v2[i]; } }
                if (kind < 4) {
#pragma unroll
                    for (int i = 0; i < 8; ++i) { o1[i] *= QK_SCALE; o2[i] *= QK_SCALE; } }
            } else {
                const float2* cs = RET + (size_t)s * 64 + 8 * j;
#pragma unroll
                for (int i = 0; i < 8; ++i) { const float2 q = cs[i]; o1[i] = v1[i] * q.x - v2[i] * q.y; o2[i] = v1[i] * q.y + v2[i] * q.x; }
                if (kind < 10) {
#pragma unroll
                    for (int i = 0; i < 8; ++i) { o1[i] *= QK_SCALE; o2[i] *= QK_SCALE; } }
            }
            *(u32x4*)(prow + cb + x1c) = pack8(o1); *(u32x4*)(prow + cb + x2c) = pack8(o2);
            if (kind >= 10) {
                const int h = kind - 10;
                const float lgf = log_gamma_of(ld[h]), lgb = log_gamma_of(ld[4 + h]);
                const int cpos = s & 127;
                const float zf = expf(lgf * (float)(127 - cpos)), zb = expf(lgb * (float)cpos);
#pragma unroll
                for (int i = 0; i < 8; ++i) { T0[(x1c + i) * 72 + tok] = f2bf(o1[i] * zf); T0[(x2c + i) * 72 + tok] = f2bf(o2[i] * zf);
                                              T1[(x1c + i) * 72 + tok] = f2bf(o1[i] * zb); T1[(x2c + i) * 72 + tok] = f2bf(o2[i] * zb); }
                __syncthreads();
#pragma unroll
                for (int q = 0; q < 2; ++q) { const int p = c.tid + 512 * q, d = p >> 3, seg = p & 7;
                    const size_t go = ((size_t)((b0 * 4 + h) * 128 + d)) * SP + s0 + seg * 8;
                    *(u32x4*)(KZTF + go) = *(const LAS u32x4*)(T0 + d * 72 + seg * 8);
                    *(u32x4*)(KZTB + go) = *(const LAS u32x4*)(T1 + d * 72 + seg * 8); }
                __syncthreads();
            }
        } else {
            const int h = kind - 14, cb = 2048 + h * 128;
            const u32x4 w0 = *(const u32x4*)(prow + cb + 16 * j), w1 = *(const u32x4*)(prow + cb + 16 * j + 8);
            const unsigned ww[8] = {w0.x, w0.y, w0.z, w0.w, w1.x, w1.y, w1.z, w1.w};
#pragma unroll
            for (int i = 0; i < 8; ++i) { T0[(16 * j + 2 * i) * 72 + tok] = (bf16)(ww[i] & 0xffffu); T0[(16 * j + 2 * i + 1) * 72 + tok] = (bf16)(ww[i] >> 16); }
            __syncthreads();
#pragma unroll
            for (int q = 0; q < 2; ++q) { const int p = c.tid + 512 * q, d = p >> 3, seg = p & 7;
                *(u32x4*)(VBT + ((size_t)((b0 * 4 + h) * 128 + d)) * SP + s0 + seg * 8) = *(const LAS u32x4*)(T0 + d * 72 + seg * 8); }
            __syncthreads();
        }
    }
}

#define MFMA16(a_, b_, c_) __builtin_amdgcn_mfma_f32_16x16x32_bf16((a_), (b_), (c_), 0, 0, 0)
__device__ __forceinline__ void ph4_r1(const Args& a, const Ctx& c) {
    const float* ld = a.in[I_ABLD];
    bf16* ST = (bf16*)(a.ws + WS_ST);
    const int fr = c.lane & 15, fq = c.lane >> 4;
    for (int task = blockIdx.x; task < 256; task += c.G) {
        const int eq = task & 3, dir = (task >> 2) & 1, h = (task >> 3) & 3, b = task >> 5;
        const bf16* KZ = (const bf16*)(a.ws + (dir ? WS_KZTB : WS_KZTF)) + (size_t)(b * 4 + h) * 128 * SP;
        const bf16* VT = (const bf16*)(a.ws + WS_VBT) + (size_t)(b * 4 + h) * 128 * SP;
        const float decay = expf(log_gamma_of(ld[dir * 4 + h]) * 128.f);
        const int d0 = 16 * c.wave;
        f32x4 st[2] = {(f32x4){0.f, 0.f, 0.f, 0.f}, (f32x4){0.f, 0.f, 0.f, 0.f}};
        bf16* STb = ST + ((size_t)((b * 4 + h) * 2 + dir) * NCHUNK) * 16384;
        const bf16* kp0 = KZ + (size_t)(d0 + fr) * SP + fq * 8;
        const bf16* vp0 = VT + (size_t)(eq * 32 + fr) * SP + fq * 8;
        for (int n = 0; n < NCHUNK; ++n) {
            const int jn = dir == 0 ? n : (n < 2 ? 1 - n : 35 - n);
#pragma unroll
            for (int eb = 0; eb < 2; ++eb) { u32x2 w; w.x = cvt_pk_bf16(st[eb][0], st[eb][1]); w.y = cvt_pk_bf16(st[eb][2], st[eb][3]);
                *(u32x2*)(STb + (size_t)jn * 16384 + (eq * 32 + eb * 16 + fr) * 128 + d0 + 4 * fq) = w; }
            if (n == NCHUNK - 1) break;
            bf16x8 af[4], bfr[2][4];
#pragma unroll
            for (int kk = 0; kk < 4; ++kk) { af[kk] = *(const bf16x8*)(kp0 + jn * 128 + kk * 32);
                bfr[0][kk] = *(const bf16x8*)(vp0 + jn * 128 + kk * 32); bfr[1][kk] = *(const bf16x8*)(vp0 + (size_t)16 * SP + jn * 128 + kk * 32); }
            f32x4 kv[2] = {(f32x4){0.f, 0.f, 0.f, 0.f}, (f32x4){0.f, 0.f, 0.f, 0.f}};
#pragma unroll
            for (int kk = 0; kk < 4; ++kk) { kv[0] = MFMA16(af[kk], bfr[0][kk], kv[0]); kv[1] = MFMA16(af[kk], bfr[1][kk], kv[1]); }
            st[0] = st[0] * decay + kv[0]; st[1] = st[1] * decay + kv[1];
        }
    }
}
__device__ __forceinline__ void ph4_attn(const Args& a, const Ctx& c) {
    const bf16* P = (const bf16*)(a.ws + WS_P); bf16* MIX = (bf16*)(a.ws + WS_MIX);
    for (int task = c.vcu; task < 512 + 32; task += c.G) {
        int b, h, r0, seq;
        if (task < 512) { b = task >> 6; h = (task >> 4) & 3; r0 = b * SP + NCTX + (task & 15) * 256; seq = SP; }
        else { const int t2 = task - 512; b = t2 >> 2; h = t2 & 3; r0 = b * SP; seq = NCTX; }
        const int kvh = h >> 1;
        att::attn_dense_body<128, AB_IN, AB_IN, AB_IN, 1024>(P + (size_t)r0 * AB_IN + h * 128, P + (size_t)b * SP * AB_IN + 512 + kvh * 128, P + (size_t)b * SP * AB_IN + 768 + kvh * 128,
                                                             MIX + (size_t)r0 * 1024 + h * 128, seq, (char*)c.lds);
    }
}

__device__ __forceinline__ bf16x8 scale_frag(bf16x8 f, float s) {
    const u32x4 w = __builtin_bit_cast(u32x4, f); float v[8]; unpack8(w, v);
#pragma unroll
    for (int i = 0; i < 8; ++i) v[i] *= s;
    return __builtin_bit_cast(bf16x8, pack8(v));
}
__device__ __forceinline__ void ph5_r2(const Args& a, const Ctx& c) {
    const bf16* P = (const bf16*)(a.ws + WS_P); bf16* MIX = (bf16*)(a.ws + WS_MIX);
    const bf16* VBT = (const bf16*)(a.ws + WS_VBT); const bf16* ST = (const bf16*)(a.ws + WS_ST);
    const float* ld = a.in[I_ABLD]; const float* gn = a.in[I_ABGN];
    const int fr = c.lane & 15, fq = c.lane >> 4;
    LAS bf16* pl = (LAS bf16*)(c.lds + c.wave * (16 * 272));
    constexpr float L2E = 1.4426950408889634f;
    for (int task = c.vcu; task < NB * 4 * NCHUNK; task += c.G) {
        const int jn = task % NCHUNK, bh = task / NCHUNK, b = bh >> 2, h = bh & 3;
        const int rowbase = b * SP + jn * 128, c0 = 16 * c.wave;
        const float l2f = log_gamma_of(ld[h]) * L2E, l2b = log_gamma_of(ld[4 + h]) * L2E;
        const bf16* qp = P + (size_t)(rowbase + c0 + fr) * AB_IN + 1024 + h * 128 + fq * 8;
        bf16x8 qf[4];
#pragma unroll
        for (int kk = 0; kk < 4; ++kk) qf[kk] = *(const bf16x8*)(qp + kk * 32);
        f32x4 sc[8];
#pragma unroll
        for (int nb = 0; nb < 8; ++nb) { const bf16* kp = P + (size_t)(rowbase + nb * 16 + fr) * AB_IN + 1536 + h * 128 + fq * 8;
            sc[nb] = (f32x4){0.f, 0.f, 0.f, 0.f};
#pragma unroll
            for (int kk = 0; kk < 4; ++kk) sc[nb] = MFMA16(qf[kk], *(const bf16x8*)(kp + kk * 32), sc[nb]); }
#pragma unroll
        for (int nb = 0; nb < 8; ++nb)
#pragma unroll
            for (int i = 0; i < 4; ++i) { const int cc = c0 + fq * 4 + i, ss = nb * 16 + fr, diff = cc - ss;
                const float f = diff >= 0 ? __builtin_amdgcn_exp2f(l2f * (float)diff) : __builtin_amdgcn_exp2f(l2b * (float)(-diff));
                pl[(fq * 4 + i) * 136 + ss] = f2bf(sc[nb][i] * f); }
        LDS_WAIT();
        bf16x8 pf[4];
#pragma unroll
        for (int kk = 0; kk < 4; ++kk) pf[kk] = *(const LAS bf16x8*)(pl + fr * 136 + kk * 32 + fq * 8);
        LDS_WAIT();
        f32x4 o[8];
#pragma unroll
        for (int eb = 0; eb < 8; ++eb) { const bf16* vp = VBT + ((size_t)((b * 4 + h) * 128 + eb * 16 + fr)) * SP + jn * 128 + fq * 8;
            o[eb] = (f32x4){0.f, 0.f, 0.f, 0.f};
#pragma unroll
            for (int kk = 0; kk < 4; ++kk) o[eb] = MFMA16(pf[kk], *(const bf16x8*)(vp + kk * 32), o[eb]); }
        const float xf = __builtin_amdgcn_exp2f(l2f * (float)(c0 + fr + 1)), xb = __builtin_amdgcn_exp2f(l2b * (float)(128 - (c0 + fr)));
        const bf16* STf = ST + ((size_t)((b * 4 + h) * 2 + 0) * NCHUNK + jn) * 16384; const bf16* STb = ST + ((size_t)((b * 4 + h) * 2 + 1) * NCHUNK + jn) * 16384;
        {   bf16x8 qF[4];
#pragma unroll
            for (int kk = 0; kk < 4; ++kk) qF[kk] = scale_frag(qf[kk], xf);
#pragma unroll
            for (int eb = 0; eb < 8; ++eb) { const bf16* sp = STf + (eb * 16 + fr) * 128 + fq * 8;
#pragma unroll
                for (int kk = 0; kk < 4; ++kk) o[eb] = MFMA16(qF[kk], *(const bf16x8*)(sp + kk * 32), o[eb]); } }
        {   bf16x8 qB[4];
#pragma unroll
            for (int kk = 0; kk < 4; ++kk) qB[kk] = scale_frag(qf[kk], xb);
#pragma unroll
            for (int eb = 0; eb < 8; ++eb) { const bf16* sp = STb + (eb * 16 + fr) * 128 + fq * 8;
#pragma unroll
                for (int kk = 0; kk < 4; ++kk) o[eb] = MFMA16(qB[kk], *(const bf16x8*)(sp + kk * 32), o[eb]); } }
#pragma unroll
        for (int i = 0; i < 4; ++i) {
            float s1 = 0.f;
#pragma unroll
            for (int eb = 0; eb < 8; ++eb) s1 += o[eb][i];
            s1 += __shfl_xor(s1, 1); s1 += __shfl_xor(s1, 2); s1 += __shfl_xor(s1, 4); s1 += __shfl_xor(s1, 8);
            const float mean = s1 * (1.f / 128.f); float s2 = 0.f;
#pragma unroll
            for (int eb = 0; eb < 8; ++eb) { const float dlt = o[eb][i] - mean; s2 += dlt * dlt; }
            s2 += __shfl_xor(s2, 1); s2 += __shfl_xor(s2, 2); s2 += __shfl_xor(s2, 4); s2 += __shfl_xor(s2, 8);
            const float rstd = rsqrtf(s2 * (1.f / 128.f) + 1e-5f);
            const int row = rowbase + c0 + fq * 4 + i;
#pragma unroll
            for (int eb = 0; eb < 8; ++eb) { const int e = eb * 16 + fr; const float g = bf2f(P[(size_t)row * AB_IN + 2560 + h * 128 + e]);
                const float y = (o[eb][i] - mean) * rstd * gn[h * 128 + e] * (g / (1.f + __expf(-g)));
                MIX[(size_t)row * 1024 + 512 + h * 128 + e] = f2bf(y); }
        }
    }
}
__device__ __forceinline__ void moe_setup_tiles(const Args& a, const Ctx& c, int L) {
    LAS int* misc = (LAS int*)(c.lds + MISC_OFF);
    const unsigned* cur = (const unsigned*)(a.ws + WS_CTL) + CW_CNT + 64 * L;
    __syncthreads();
    if (c.tid < 32) misc[64 + c.tid] = (int)__hip_atomic_load(cur + c.tid, __ATOMIC_RELAXED, __HIP_MEMORY_SCOPE_AGENT);
    __syncthreads();
    if (c.tid == 0) { int acc = 0; for (int e = 0; e < NE; ++e) { misc[e] = acc; acc += (misc[64 + e] + 255) >> 8; } misc[NE] = acc; }
    __syncthreads();
}
template <bool GATHER_> struct MoeOrder {
    static constexpr bool GATHER = GATHER_;
    const LAS int* misc; const int* ltok; int nN, G, c, total;
    __device__ void init(const LAS int* misc_, const int* ltok_, int nN_, int G_, int c_) { misc = misc_; ltok = ltok_; nN = nN_; G = G_; c = c_; total = misc_[NE] * nN_; }
    __device__ bool next(int i, pg8::Unit& u) const {
        const int L = i * G + c; if (L >= total) return false;
        const int mt = L / nN, nt = L % nN; int e = 0;
        while (misc[e + 1] <= mt) ++e;
        u.pm = mt; u.pn = nt; u.pb = e * nN + nt; u.e = e; return true;
    }
    __device__ __forceinline__ unsigned arow(const pg8::Unit& u, int r) const {
        int local = (u.pm - misc[u.e]) * 256 + r; if (local >= misc[64 + u.e]) local = 0;
        return (unsigned)ltok[(size_t)u.e * CAP + local];
    }
};
__device__ __forceinline__ float swiglu(float g, float l) {
    g = fminf(g, 7.0f); l = fminf(fmaxf(l, -7.0f), 7.0f);
    return g * __builtin_amdgcn_rcpf(1.f + __builtin_amdgcn_exp2f(-1.702f * 1.4426950408889634f * g)) * (l + 1.0f);
}
struct EpiMoeUp {
    static constexpr bool PERM = true;
    bf16* ACT; const float* bup  ;
    __device__ __forceinline__ void operator()(const f32x4 (&acc)[2][2][4][2], const pg8::Unit& u, int wr, int wc, int fr, int fq) const {
        const int col0 = u.pn * 128 + wc * 32 + 8 * fq; const float* bb = bup + (size_t)u.e * 2048 + col0;
        f32x4 bg[2], bl[2];
#pragma unroll
        for (int n = 0; n < 2; ++n) { bg[n] = *(const f32x4*)(bb + 4 * n); bl[n] = *(const f32x4*)(bb + 1024 + 4 * n); }
        const unsigned rb = ((unsigned)(u.pm * 256 + wr * 64 + fr) * 1024u + (unsigned)col0) * 2u;
#pragma unroll
        for (int ai = 0; ai < 2; ++ai)
#pragma unroll
            for (int m = 0; m < 4; ++m) { float v[8];
#pragma unroll
                for (int n = 0; n < 2; ++n)
#pragma unroll
                    for (int k = 0; k < 4; ++k) v[4 * n + k] = swiglu(acc[ai][0][m][n][k] + bg[n][k], acc[ai][1][m][n][k] + bl[n][k]);
                st16(ACT, rb + (unsigned)((ai * 128 + m * 16) * 1024) * 2u, pack8(v)); }
    }
};
struct EpiMoeDown {
    static constexpr bool PERM = true;
    bf16* YK; const float* bdn  ; const float* lgate; const LAS int* misc;
    __device__ __forceinline__ void operator()(const f32x4 (&acc)[2][2][4][2], const pg8::Unit& u, int wr, int wc, int fr, int fq) const {
        const int col0 = u.pn * 256 + wc * 32 + 8 * fq; const float* bb = bdn + (size_t)u.e * 1024 + col0;
        f32x4 bv[2][2];
#pragma unroll
        for (int bj = 0; bj < 2; ++bj)
#pragma unroll
            for (int n = 0; n < 2; ++n) bv[bj][n] = *(const f32x4*)(bb + bj * 128 + 4 * n);
        const int lbase = (u.pm - misc[u.e]) * 256 + wr * 64 + fr, cnt = misc[64 + u.e];
        const float* gp = lgate + (size_t)u.e * CAP;
        const unsigned rb = ((unsigned)(u.pm * 256 + wr * 64 + fr) * 1024u + (unsigned)col0) * 2u;
#pragma unroll
        for (int ai = 0; ai < 2; ++ai)
#pragma unroll
            for (int m = 0; m < 4; ++m) { const int local = lbase + ai * 128 + m * 16;
                const float g = local < cnt ? *(const float*)((const char*)gp + (unsigned)local * 4u) : 0.f;
                const unsigned ro = rb + (unsigned)((ai * 128 + m * 16) * 1024) * 2u;
#pragma unroll
                for (int bj = 0; bj < 2; ++bj) st16(YK, ro + bj * 256, pack2x4((acc[ai][bj][m][0] + bv[bj][0]) * g, (acc[ai][bj][m][1] + bv[bj][1]) * g)); }
    }
};

template <int L> __device__ __forceinline__ void ph_ln1_router(const Args& a, const Ctx& c) {
    constexpr int NROWS = (L == 0) ? R : NB * SEQ;
    float* ACC = (float*)(a.ws + WS_ACC); bf16* H = (bf16*)(a.ws + WS_H);
    const float* mods = (const float*)(a.ws + WS_MODS) + (size_t)L * 9 * 6144;
    const float* g1 = a.in[I_LN1G] + L * D; const float* b1 = a.in[I_LN1B] + L * D;
    const float* Wr = a.in[I_RW] + (size_t)L * D * NE; const float* rb = a.in[I_RB] + L * NE;
    int* LTOK = (int*)(a.ws + WS_LTOK); float* LGATE = (float*)(a.ws + WS_LGATE); int* TOKSLOT = (int*)(a.ws + WS_TOKSLOT);
    unsigned* cur = (unsigned*)(a.ws + WS_CTL) + CW_CNT + 64 * L;
    LAS float* wr = (LAS float*)c.lds;
    LAS int* misc = (LAS int*)(c.lds + MISC_OFF);
    LAS int* rec = (LAS int*)(c.lds + XTRA_OFF);
    LAS float* recg = (LAS float*)(c.lds + XTRA_OFF + 6144);
    LAS int* recrow = (LAS int*)(c.lds + XTRA_OFF + 12288);
    for (int i = c.tid; i < D * NE; i += 512) { const int d = i >> 5, e = i & 31; wr[e * 1024 + d] = Wr[i]; }
    if (c.tid < 32) misc[128 + c.tid] = 0;
    __syncthreads();
    int nq = 0;
    for (int q = c.wave;; q += 8) {
        const int rl = blockIdx.x + c.G * q; if (rl >= NROWS) break;
        nq = q + 1;
        int row, b, isc;
        if constexpr (L == 0) { row = rl; b = row / SP; isc = (row % SP) < NCTX; } else { b = rl / SEQ; row = b * SP + NCTX + (rl % SEQ); isc = 0; }
        const float* m = mods + (size_t)(isc ? 8 : b) * 6144;
        float* xr = ACC + (size_t)row * D;
        f32x4 v[4]; float s = 0.f;
#pragma unroll
        for (int j = 0; j < 4; ++j) { v[j] = *(const f32x4*)(xr + 4 * c.lane + 256 * j); s += (v[j][0] + v[j][1]) + (v[j][2] + v[j][3]); }
        const float mean = wave_sum(s) * (1.f / D); float s2 = 0.f;
#pragma unroll
        for (int j = 0; j < 4; ++j) { v[j] = v[j] - mean; s2 += (v[j][0] * v[j][0] + v[j][1] * v[j][1]) + (v[j][2] * v[j][2] + v[j][3] * v[j][3]); }
        const float rstd = rsqrtf(wave_sum(s2) * (1.f / D) + 1e-5f);
        f32x4 hv[4];
#pragma unroll
        for (int j = 0; j < 4; ++j) { const int col = 4 * c.lane + 256 * j;
            const f32x4 x1 = v[j] * rstd * *(const f32x4*)(g1 + col) + *(const f32x4*)(b1 + col);
            *(f32x4*)(xr + col) = x1;
            hv[j] = x1 * (*(const f32x4*)(m + 4 * 1024 + col) + 1.0f) + *(const f32x4*)(m + 3 * 1024 + col);
            u32x2 o; o.x = cvt_pk_bf16(hv[j][0], hv[j][1]); o.y = cvt_pk_bf16(hv[j][2], hv[j][3]); *(u32x2*)(H + (size_t)row * D + col) = o; }
        float lg[NE];
#pragma unroll
        for (int e = 0; e < NE; ++e) { float p = 0.f;
#pragma unroll
            for (int j = 0; j < 4; ++j) { const f32x4 w = *(const LAS f32x4*)(wr + e * 1024 + 4 * c.lane + 256 * j); p += (hv[j][0] * w[0] + hv[j][1] * w[1]) + (hv[j][2] * w[2] + hv[j][3] * w[3]); }
            lg[e] = wave_sum(p) + rb[e]; }
        int te[4]; float tv[4];
#pragma unroll
        for (int k = 0; k < 4; ++k) { float best = -3.0e38f; int bi = 0;
#pragma unroll
            for (int e = 0; e < NE; ++e) { const bool better = lg[e] > best; best = better ? lg[e] : best; bi = better ? e : bi; }
            te[k] = bi; tv[k] = best;
#pragma unroll
            for (int e = 0; e < NE; ++e) lg[e] = (e == bi) ? -3.0e38f : lg[e]; }
        float ex[4], es = 0.f;
#pragma unroll
        for (int k = 0; k < 4; ++k) { ex[k] = expf(tv[k] - tv[0]); es += ex[k]; }
        if (c.lane == 0) {
#pragma unroll
            for (int k = 0; k < 4; ++k) { const int lpos = atomicAdd((int*)&misc[128 + te[k]], 1); rec[q * 4 + k] = (te[k] << 20) | lpos; recg[q * 4 + k] = ex[k] / es; }
            recrow[q] = row; }
    }
    __syncthreads();
    if (c.tid < 32) { const int n = misc[128 + c.tid]; misc[160 + c.tid] = n ? (int)__hip_atomic_fetch_add(cur + c.tid, (unsigned)n, __ATOMIC_RELAXED, __HIP_MEMORY_SCOPE_AGENT) : 0; }
    __syncthreads();
    const int nqb = (NROWS - (int)blockIdx.x + c.G - 1) / c.G;
    for (int i = c.tid; i < nqb * 4; i += 512) { const int q = i >> 2, rc = rec[i], e = rc >> 20, pos = misc[160 + e] + (rc & 0xfffff); const int row = recrow[q];
        LTOK[(size_t)e * CAP + pos] = row; LGATE[(size_t)e * CAP + pos] = recg[i]; TOKSLOT[row * 4 + (i & 3)] = (e << 24) | pos; }
    (void)nq;
}

template <int L> __device__ __forceinline__ void ph_ln2(const Args& a, const Ctx& c) {
    constexpr int NROWS = (L == 0) ? R : NB * SEQ;
    const float* ACC = (const float*)(a.ws + WS_ACC); const bf16* YK = (const bf16*)(a.ws + WS_YK); const int* TOKSLOT = (const int*)(a.ws + WS_TOKSLOT);
    const float* mods = (const float*)(a.ws + WS_MODS) + (size_t)L * 9 * 6144;
    const float* g2 = a.in[I_LN2G] + L * D; const float* b2 = a.in[I_LN2B] + L * D;
    LAS int* misc = (LAS int*)(c.lds + MISC_OFF);
    moe_setup_tiles(a, c, L);
    for (int rl = c.gw; rl < NROWS; rl += c.NGW) {
        int row, b, isc, t = 0;
        if constexpr (L == 0) { row = rl; b = row / SP; isc = (row % SP) < NCTX; } else { b = rl / SEQ; t = rl % SEQ; row = b * SP + NCTX + t; isc = 0; }
        const float* m = mods + (size_t)(isc ? 8 : b) * 6144;
        const bf16* yk[4];
#pragma unroll
        for (int k = 0; k < 4; ++k) { const int ts = TOKSLOT[row * 4 + k], e = ts >> 24, pos = ts & 0xffffff; yk[k] = YK + ((size_t)misc[e] * 256 + pos) * 1024; }
        f32x4 v[4]; float s = 0.f;
#pragma unroll
        for (int j = 0; j < 4; ++j) { const int col = 4 * c.lane + 256 * j; f32x4 fl = (f32x4){0.f, 0.f, 0.f, 0.f};
#pragma unroll
            for (int k = 0; k < 4; ++k) { const u32x2 w = *(const u32x2*)(yk[k] + col); fl[0] += bflo(w.x); fl[1] += bfhi(w.x); fl[2] += bflo(w.y); fl[3] += bfhi(w.y); }
            v[j] = *(const f32x4*)(ACC + (size_t)row * D + col) * DN_ALPHA + *(const f32x4*)(m + 5 * 1024 + col) * fl;
            s += (v[j][0] + v[j][1]) + (v[j][2] + v[j][3]); }
        const float mean = wave_sum(s) * (1.f / D); float s2 = 0.f;
#pragma unroll
        for (int j = 0; j < 4; ++j) { v[j] = v[j] - mean; s2 += (v[j][0] * v[j][0] + v[j][1] * v[j][1]) + (v[j][2] * v[j][2] + v[j][3] * v[j][3]); }
        const float rstd = rsqrtf(wave_sum(s2) * (1.f / D) + 1e-5f);
#pragma unroll
        for (int j = 0; j < 4; ++j) { const int col = 4 * c.lane + 256 * j;
            const f32x4 x2 = v[j] * rstd * *(const f32x4*)(g2 + col) + *(const f32x4*)(b2 + col);
            if constexpr (L == 0) {
                *(f32x4*)((float*)(a.ws + WS_X) + (size_t)row * D + col) = x2;
                const float* mn = m + 9 * 6144;
                const f32x4 h = x2 * (*(const f32x4*)(mn + 1024 + col) + 1.0f) + *(const f32x4*)(mn + col);
                u32x2 o; o.x = cvt_pk_bf16(h[0], h[1]); o.y = cvt_pk_bf16(h[2], h[3]); *(u32x2*)((bf16*)(a.ws + WS_H) + (size_t)row * D + col) = o;
            } else {
                *(f32x4*)(a.out + ((size_t)b * SEQ + t) * D + col) = x2;
            } }
    }
}
__device__ __forceinline__ void ph12_mla_post(const Args& a, const Ctx& c) {
    const bf16* PM = (const bf16*)(a.ws + WS_PM); bf16* CQ = (bf16*)(a.ws + WS_CQ); bf16* CKV = (bf16*)(a.ws + WS_CKV); bf16* KM = (bf16*)(a.ws + WS_KM);
    const float* qn = a.in[I_MLAQN]; const float* kvn = a.in[I_MLAKVN];
    const float2* A64 = (const float2*)(a.ws + WS_TAB_A64);
    const int lane = c.lane;
    for (int row = c.gw; row < R; row += c.NGW) {
        const int s = row % SP; const bool lat = s >= NCTX;
        const bf16* pr = PM + (size_t)row * MLA_IN_P;
        float v0[8], v1[8];
        unpack8(*(const u32x4*)(pr + lane * 8), v0);
        if (lane < 32) unpack8(*(const u32x4*)(pr + 512 + lane * 8), v1);
        else {
#pragma unroll
            for (int i = 0; i < 8; ++i) v1[i] = 0.f; }
        float sq = 0.f, sk = 0.f, t0 = 0.f, t1 = 0.f;
#pragma unroll
        for (int i = 0; i < 8; ++i) { t0 += v0[i] * v0[i]; t1 += v1[i] * v1[i]; }
        if (lane < 48) sq = t0; else sk = t0;
        if (lane < 16) sk += t1;
        sq = wave_sum(sq); sk = wave_sum(sk);
        const float rq = rsqrtf(sq * (1.f / MLA_QL) + 1e-6f), rk = rsqrtf(sk * (1.f / MLA_KVL) + 1e-6f);
        float o[8];
        if (lane < 48) {
#pragma unroll
            for (int i = 0; i < 8; ++i) o[i] = v0[i] * rq * qn[lane * 8 + i];
            *(u32x4*)(CQ + (size_t)row * MLA_QL + lane * 8) = pack8(o);
        } else {
#pragma unroll
            for (int i = 0; i < 8; ++i) o[i] = v0[i] * rk * kvn[(lane - 48) * 8 + i];
            *(u32x4*)(CKV + (size_t)row * MLA_KVL + (lane - 48) * 8) = pack8(o);
        }
        if (lane < 16) {
#pragma unroll
            for (int i = 0; i < 8; ++i) o[i] = v1[i] * rk * kvn[128 + lane * 8 + i];
            *(u32x4*)(CKV + (size_t)row * MLA_KVL + 128 + lane * 8) = pack8(o);
        }
        float pr8[8];
#pragma unroll
        for (int i = 0; i < 8; ++i) pr8[i] = __shfl_xor(v1[i], 2);
        if (lane >= 16 && lane < 24) {
            if (lat) { const int t = s - NCTX, pos = lane < 20 ? t / GRID_W : t % GRID_W; const float2* cs = A64 + pos * 16 + (lane & 1) * 8; const bool second = (lane & 2) != 0;
#pragma unroll
                for (int i = 0; i < 8; ++i) { const float2 q = cs[i]; o[i] = second ? (pr8[i] * q.y + v1[i] * q.x) : (v1[i] * q.x - pr8[i] * q.y); } }
            else {
#pragma unroll
                for (int i = 0; i < 8; ++i) o[i] = v1[i]; }
            const u32x4 w = pack8(o);
#pragma unroll
            for (int h = 0; h < 8; ++h) *(u32x4*)(KM + (size_t)row * UQ_N + h * 192 + 128 + (lane - 16) * 8) = w;
        }
    }
}
struct LatOrder {
    pg8::StaticOrder S; static constexpr bool GATHER = false;
    __device__ void init(int nN, int G, int c) { S.init(NB * 16, nN, G, c); }
    __device__ bool next(int i, pg8::Unit& u) const { if (!S.next(i, u)) return false; u.pm = (u.pm >> 4) * 17 + 1 + (u.pm & 15); return true; }
    __device__ __forceinline__ unsigned arow(const pg8::Unit&, int) const { return 0u; }
};
struct EpiUq {
    static constexpr bool PERM = true;
    bf16* QM; const float2* A64;
    __device__ __forceinline__ void operator()(const f32x4 (&acc)[2][2][4][2], const pg8::Unit& u, int wr, int wc, int fr, int fq) const {
        constexpr float SC = 0.07216878364870322f;
        const int row0 = u.pm * 256 + wr * 64 + fr;
        if (u.pn < 4) {
            const unsigned rb = ((unsigned)row0 * UQ_N + (unsigned)(2 * u.pn * 192 + wc * 32 + 8 * fq)) * 2u;
#pragma unroll
            for (int ai = 0; ai < 2; ++ai)
#pragma unroll
                for (int m = 0; m < 4; ++m) { const unsigned ro = rb + (unsigned)((ai * 128 + m * 16) * UQ_N) * 2u;
#pragma unroll
                    for (int bj = 0; bj < 2; ++bj) st16(QM, ro + bj * 384, pack2x4(acc[ai][bj][m][0] * SC, acc[ai][bj][m][1] * SC)); }
        } else {
            const int head = 4 * (u.pn - 4) + wc, j0 = 8 * fq;
            const int d1 = j0 < 16 ? j0 : 16 + j0;
            const unsigned rb = ((unsigned)row0 * UQ_N + (unsigned)(head * 192 + 128 + d1)) * 2u;
            const int t0 = row0 % SP - NCTX;
#pragma unroll
            for (int ai = 0; ai < 2; ++ai)
#pragma unroll
                for (int m = 0; m < 4; ++m) { const int t = t0 + ai * 128 + m * 16;
                    const int pos = j0 < 16 ? t / GRID_W : t % GRID_W; const unsigned co = (unsigned)(pos * 16 + (j0 & 15)) * 8u;
                    const unsigned ro = rb + (unsigned)((ai * 128 + m * 16) * UQ_N) * 2u;
#pragma unroll
                    for (int n = 0; n < 2; ++n) { const f32x4 ca = *(const f32x4*)((const char*)A64 + co + 32 * n), cb = *(const f32x4*)((const char*)A64 + co + 32 * n + 16);
                        const f32x4 x1 = acc[ai][0][m][n], x2 = acc[ai][1][m][n];
                        u32x2 w1, w2;
                        w1.x = cvt_pk_bf16((x1[0] * ca[0] - x2[0] * ca[1]) * SC, (x1[1] * ca[2] - x2[1] * ca[3]) * SC);
                        w1.y = cvt_pk_bf16((x1[2] * cb[0] - x2[2] * cb[1]) * SC, (x1[3] * cb[2] - x2[3] * cb[3]) * SC);
                        w2.x = cvt_pk_bf16((x1[0] * ca[1] + x2[0] * ca[0]) * SC, (x1[1] * ca[3] + x2[1] * ca[2]) * SC);
                        w2.y = cvt_pk_bf16((x1[2] * cb[1] + x2[2] * cb[0]) * SC, (x1[3] * cb[3] + x2[3] * cb[2]) * SC);
                        st8(QM, ro + 8 * n, w1); st8(QM, ro + 32 + 8 * n, w2); } }
        }
    }
};
struct EpiUkv {
    static constexpr bool PERM = true;
    bf16* KM; bf16* VM;
    __device__ __forceinline__ void operator()(const f32x4 (&acc)[2][2][4][2], const pg8::Unit& u, int wr, int wc, int fr, int fq) const {
        const unsigned row0 = (unsigned)(u.pm * 256 + wr * 64 + fr), cw = (unsigned)(wc * 32 + 8 * fq);
        const unsigned kb = (row0 * UQ_N + (unsigned)u.pn * 192 + cw) * 2u, vb = (row0 * 1024u + (unsigned)u.pn * 128 + cw) * 2u;
#pragma unroll
        for (int ai = 0; ai < 2; ++ai)
#pragma unroll
            for (int m = 0; m < 4; ++m) {
                st16(KM, kb + (unsigned)((ai * 128 + m * 16) * UQ_N) * 2u, pack2x4(acc[ai][0][m][0], acc[ai][0][m][1]));
                st16(VM, vb + (unsigned)((ai * 128 + m * 16) * 1024) * 2u, pack2x4(acc[ai][1][m][0], acc[ai][1][m][1])); }
    }
};
__device__ __forceinline__ void ph14_mla_attn(const Args& a, const Ctx& c) {
    const bf16* QM = (const bf16*)(a.ws + WS_QM); const bf16* KM = (const bf16*)(a.ws + WS_KM); const bf16* VM = (const bf16*)(a.ws + WS_VM); bf16* MIX = (bf16*)(a.ws + WS_MIX);
    for (int task = c.vcu; task < 1024; task += c.G) {
        const int b = task >> 7, h = (task >> 4) & 7, r0 = b * SP + NCTX + (task & 15) * 256;
        att::attn_dense_body<192, UQ_N, UQ_N, 1024, 1024>(QM + (size_t)r0 * UQ_N + h * 192, KM + (size_t)b * SP * UQ_N + h * 192, VM + (size_t)b * SP * 1024 + h * 128,
                                                          MIX + (size_t)r0 * 1024 + h * 128, SP, (char*)c.lds);
    }
}
constexpr int NPH = 20;
#ifndef ONE_LAUNCH
#define ONE_LAUNCH 1
#endif
__global__ void __launch_bounds__(512, 2) fwd(Args a) {
    extern __shared__ __attribute__((aligned(16))) unsigned char lds_raw[];
    Ctx c; c.lds = (LAS unsigned char*)lds_raw; c.tid = threadIdx.x; c.lane = c.tid & 63; c.wave = __builtin_amdgcn_readfirstlane(c.tid >> 6);
    c.G = gridDim.x; { const int bx = blockIdx.x; c.vcu = (c.G % 8 == 0) ? (bx % 8) * (c.G / 8) + bx / 8 : bx; }
    c.gw = c.vcu * 8 + c.wave; c.NGW = c.G * 8;
    volatile LAS unsigned* MISC = (volatile LAS unsigned*)(c.lds + MISC_OFF);
    if (c.tid < 256) MISC[c.tid] = 0u;
    __syncthreads();
    unsigned* ctl = (unsigned*)(a.ws + WS_CTL);
    XcdBarrier bar; bar.bar = ctl + CW_BAR; bar.x = 0; bar.st = nullptr;
    const int lo = a.ph_lo, hi = a.ph_hi;
    if (hi - lo > 1) bar = xcd_barrier_post(ctl + CW_BAR, MISC + 248);
#ifndef PHMASK
#define PHMASK 0xFFFFFu
#endif
#define IN(k) ((((PHMASK) >> (k)) & 1u) && lo <= (k) && (k) < hi)
#define SEAM(k) do { if (IN(k) && IN((k) + 1)) xcd_barrier(bar); } while (0)
    unsigned char* ws = a.ws;
    const float* mods = (const float*)(ws + WS_MODS);
    LAS int* misc = (LAS int*)(c.lds + MISC_OFF);

    if (IN(0)) { ph0_prologue(a, c); } SEAM(0);
    if (IN(1)) { ph1_mod0(a, c); } SEAM(1);
    if (IN(2)) {
        pg8::Gemm g{(const bf16*)(ws + WS_H), (const bf16*)(ws + WS_WABIN), 1024}; pg8::StaticOrder S; S.init(R / 256, AB_IN / 256, c.G, (int)blockIdx.x);
        EpiStoreBf16 E{(bf16*)(ws + WS_P), AB_IN};
        pg8::gemm_phase(c.lds, g, S, E);
    } SEAM(2);
    if (IN(3)) { ph3_post(a, c); } SEAM(3);
    if (IN(4)) { ph4_r1(a, c); __syncthreads(); ph4_attn(a, c); } SEAM(4);
    if (IN(5)) { ph5_r2(a, c); } SEAM(5);
    if (IN(6)) {
        pg8::Gemm g{(const bf16*)(ws + WS_MIX), (const bf16*)(ws + WS_WABOUT), 1024}; pg8::StaticOrder S; S.init(R / 256, 4, c.G, (int)blockIdx.x);
        EpiResid<0> E{a.in[I_X], a.in[I_CTX], nullptr, mods, (float*)(ws + WS_ACC)};
        pg8::gemm_phase(c.lds, g, S, E);
    } SEAM(6);
    if (IN(7)) { ph_ln1_router<0>(a, c); } SEAM(7);
    if (IN(8)) {
        moe_setup_tiles(a, c, 0);
        pg8::Gemm g{(const bf16*)(ws + WS_H), (const bf16*)(ws + WS_WUP), 1024}; MoeOrder<true> S; S.init(misc, (const int*)(ws + WS_LTOK), 8, c.G, (int)blockIdx.x);
        EpiMoeUp E{(bf16*)(ws + WS_ACT), a.in[I_BUP]};
        pg8::gemm_phase(c.lds, g, S, E);
    } SEAM(8);
    if (IN(9)) {
        moe_setup_tiles(a, c, 0);
        pg8::Gemm g{(const bf16*)(ws + WS_ACT), (const bf16*)(ws + WS_WDOWN), 1024}; MoeOrder<false> S; S.init(misc, nullptr, 4, c.G, (int)blockIdx.x);
        EpiMoeDown E{(bf16*)(ws + WS_YK), a.in[I_BDOWN], (const float*)(ws + WS_LGATE), misc};
        pg8::gemm_phase(c.lds, g, S, E);
    } SEAM(9);
    if (IN(10)) { ph_ln2<0>(a, c); } SEAM(10);
    if (IN(11)) {
        pg8::Gemm g{(const bf16*)(ws + WS_H), (const bf16*)(ws + WS_WMLAIN), 1024}; pg8::StaticOrder S; S.init(R / 256, 3, c.G, (int)blockIdx.x);
        EpiStoreBf16 E{(bf16*)(ws + WS_PM), MLA_IN_P};
        pg8::gemm_phase(c.lds, g, S, E);
    } SEAM(11);
    if (IN(12)) { ph12_mla_post(a, c); } SEAM(12);
    if (IN(13)) {
#ifndef NO_UQ
        {   pg8::Gemm g{(const bf16*)(ws + WS_CQ), (const bf16*)(ws + WS_WUQ), MLA_QL}; LatOrder S; S.init(6, c.G, (int)blockIdx.x);
            EpiUq E{(bf16*)(ws + WS_QM), (const float2*)(ws + WS_TAB_A64)};
            pg8::gemm_phase(c.lds, g, S, E); }
#endif
#ifndef NO_UKV
        {   pg8::Gemm g{(const bf16*)(ws + WS_CKV), (const bf16*)(ws + WS_WUKV), MLA_KVL}; pg8::StaticOrder S; S.init(R / 256, 8, c.G, (int)blockIdx.x);
            EpiUkv E{(bf16*)(ws + WS_KM), (bf16*)(ws + WS_VM)};
            pg8::gemm_phase(c.lds, g, S, E); }
#endif
    } SEAM(13);
    if (IN(14)) { ph14_mla_attn(a, c); } SEAM(14);
    if (IN(15)) {
        pg8::Gemm g{(const bf16*)(ws + WS_MIX), (const bf16*)(ws + WS_WMLAOUT), 1024}; LatOrder S; S.init(4, c.G, (int)blockIdx.x);
        EpiResid<1> E{nullptr, nullptr, (const float*)(ws + WS_X), mods + 9 * 6144, (float*)(ws + WS_ACC)};
        pg8::gemm_phase(c.lds, g, S, E);
    } SEAM(15);
    if (IN(16)) { ph_ln1_router<1>(a, c); } SEAM(16);
    if (IN(17)) {
        moe_setup_tiles(a, c, 1);
        pg8::Gemm g{(const bf16*)(ws + WS_H), (const bf16*)(ws + WS_WUP) + (size_t)32 * 2048 * 1024, 1024}; MoeOrder<true> S; S.init(misc, (const int*)(ws + WS_LTOK), 8, c.G, (int)blockIdx.x);
        EpiMoeUp E{(bf16*)(ws + WS_ACT), a.in[I_BUP] + 32 * 2048};
        pg8::gemm_phase(c.lds, g, S, E);
    } SEAM(17);
    if (IN(18)) {
        moe_setup_tiles(a, c, 1);
        pg8::Gemm g{(const bf16*)(ws + WS_ACT), (const bf16*)(ws + WS_WDOWN) + (size_t)32 * 1024 * 1024, 1024}; MoeOrder<false> S; S.init(misc, nullptr, 4, c.G, (int)blockIdx.x);
        EpiMoeDown E{(bf16*)(ws + WS_YK), a.in[I_BDOWN] + 32 * 1024, (const float*)(ws + WS_LGATE), misc};
        pg8::gemm_phase(c.lds, g, S, E);
    } SEAM(18);
    if (IN(19)) { ph_ln2<1>(a, c); }
#undef IN
#undef SEAM
}

extern "C" void kernel_launch(void* const* d_in, const int* in_sizes, int n_in, void* d_out, int out_size, void* d_ws, size_t ws_size, hipStream_t stream) {
    static int grid = 0;
    if (grid == 0) {
        if (n_in != 28 || in_sizes[0] != NB * SEQ * D || out_size != NB * SEQ * D || ws_size < WS_END) {
            fprintf(stderr, "kernel_launch: shape mismatch: n_in %d in0 %d out %d ws %zu (need >= %zu)\n", n_in, n_in > 0 ? in_sizes[0] : -1, out_size, ws_size, (size_t)WS_END); grid = -1; return; }
        int dev = 0, cus = 0, per_cu = 0;
        if (hipGetDevice(&dev) != hipSuccess || hipDeviceGetAttribute(&cus, hipDeviceAttributeMultiprocessorCount, dev) != hipSuccess) { fprintf(stderr, "kernel_launch: device query failed\n"); grid = -1; return; }
        if (hipFuncSetAttribute((const void*)fwd, hipFuncAttributeMaxDynamicSharedMemorySize, LDS_BYTES) != hipSuccess) { fprintf(stderr, "kernel_launch: hipFuncSetAttribute failed\n"); grid = -1; return; }
        if (hipOccupancyMaxActiveBlocksPerMultiprocessor(&per_cu, (const void*)fwd, 512, LDS_BYTES) != hipSuccess || per_cu < 1) fprintf(stderr, "kernel_launch: occupancy query reports %d blocks per CU\n", per_cu);
        (void)hipGetLastError();
        grid = cus;
    }
    if (grid < 0) return;
    if (hipMemsetAsync((char*)d_ws + WS_CTL, 0, CTL_ZERO_BYTES, stream) != hipSuccess) { fprintf(stderr, "kernel_launch: memset failed\n"); return; }
    Args a{};
    for (int i = 0; i < 28; ++i) a.in[i] = (const float*)d_in[i];
    a.out = (float*)d_out; a.ws = (unsigned char*)d_ws;
#if ONE_LAUNCH
    a.ph_lo = 0; a.ph_hi = NPH;
    hipLaunchKernelGGL(fwd, dim3(grid), dim3(512), LDS_BYTES, stream, a);
#else
    for (int p = 0; p < NPH; ++p) { a.ph_lo = p; a.ph_hi = p + 1; hipLaunchKernelGGL(fwd, dim3(grid), dim3(512), LDS_BYTES, stream, a); }
#endif
    const hipError_t le = hipPeekAtLastError();
    if (le != hipSuccess) fprintf(stderr, "kernel_launch: launch failed: %s\n", hipGetErrorName(le));
}
```

```cpp
#include <hip/hip_runtime.h>
#include <cstdio>
#include <cstdint>

#define LAS __attribute__((address_space(3)))
#define GAS __attribute__((address_space(1)))
typedef unsigned short bf16;
typedef short bf16x8 __attribute__((ext_vector_type(8)));
typedef short s16x4 __attribute__((ext_vector_type(4)));
typedef float f32x4 __attribute__((ext_vector_type(4)));
typedef float f32x2 __attribute__((ext_vector_type(2)));
typedef float f32x8 __attribute__((ext_vector_type(8)));
typedef float f32x16 __attribute__((ext_vector_type(16)));
typedef unsigned u32x4 __attribute__((ext_vector_type(4)));
typedef unsigned u32x2 __attribute__((ext_vector_type(2)));
typedef GAS unsigned gu32;

constexpr int D = 1024, NB = 8, SEQ = 4096, NCTX = 256, SP = SEQ + NCTX  , R = NB * SP  ;
constexpr int GRID_W = 64;
constexpr int AB_IN = 3072, MLA_IN = 704, MLA_IN_P = 768, MLA_QL = 384, MLA_KVL = 256, UQ_N = 1536, UKV_N = 2048;
constexpr int NE = 32, TOPK = 4, DFF = 1024;
constexpr int NCHUNK = SP / 128;
constexpr float DN_ALPHA = 1.4142135623730951f;
constexpr int CAP = R * TOPK;
constexpr int NSLOT_MAX = R * TOPK + NE * 256;

#if defined(PROBE_K) && !defined(PROBE_END)
#define PROBE_END (PROBE_K + 1)
#endif
__device__ __forceinline__ unsigned cvt_pk_bf16(float lo, float hi) { unsigned r; asm volatile("v_cvt_pk_bf16_f32 %0, %1, %2" : "=v"(r) : "v"(lo), "v"(hi)); return r; }
__device__ __forceinline__ unsigned cvt_pk_nv(float lo, float hi) { unsigned r; asm("v_cvt_pk_bf16_f32 %0, %1, %2" : "=v"(r) : "v"(lo), "v"(hi)); return r; }
__device__ __forceinline__ float bflo(unsigned w) { return __uint_as_float(w << 16); }
__device__ __forceinline__ float bfhi(unsigned w) { return __uint_as_float(w & 0xffff0000u); }
__device__ __forceinline__ float bf2f(bf16 b) { return __uint_as_float((unsigned)b << 16); }
__device__ __forceinline__ bf16 f2bf(float f) { return (bf16)(cvt_pk_bf16(f, 0.f) & 0xffffu); }
__device__ __forceinline__ float wave_sum(float v) {
#pragma unroll
    for (int o = 1; o < 64; o <<= 1) v += __shfl_xor(v, o);
    return v;
}
#define LDS_WAIT() asm volatile("s_waitcnt lgkmcnt(0)" ::: "memory")
#define VM_WAIT() asm volatile("s_waitcnt vmcnt(0)" ::: "memory")
namespace pg8 {
typedef unsigned short bf16_t;
constexpr int BM = 256, BK = 64, HALF = 128, HTB = HALF * BK * 2  , STAGE_BYTES = 8 * HTB, NXCD = 8, WGM = 8;

__host__ __device__ __forceinline__ int lds_byte(int r, int c) { const int st = (r >> 4) * 2 + (c >> 5), rr = r & 15, cc = c & 31, ob = rr * 64 + cc * 2; return st * 1024 + (ob ^ (((ob >> 9) & 1) << 5)); }
__host__ __device__ __forceinline__ void stage_rc(int b, int& R_, int& C_) { const int st = b / 1024, sb = b % 1024, swz = sb ^ (((sb >> 9) & 1) << 5); R_ = (st >> 1) * 16 + swz / 64; C_ = (st & 1) * 32 + (swz % 64) / 2; }
__host__ __device__ __forceinline__ int perm32(int rho) { const int n = rho >> 4, i = rho & 15; return 8 * (i >> 2) + 4 * n + (i & 3); }

struct Unit { int pm, pn, pb, e; };
struct Gemm { const bf16_t* A; const bf16_t* Bt; int K; int lda; };

struct StaticOrder {
    int nM, nN, nwg, G, c;
    static constexpr bool GATHER = false;
    __device__ void init(int nM_, int nN_, int G_, int c_) { nM = nM_; nN = nN_; nwg = nM * nN; G = G_; c = c_; }
    __device__ bool next(int i, Unit& u) const {
        const long L = (long)i * G + c; if (L >= nwg) return false;
        int wgid = (int)L; { const int q = nwg / NXCD, r = nwg % NXCD, xcd = wgid % NXCD, off = wgid / NXCD; wgid = (xcd < r ? xcd * (q + 1) : r * (q + 1) + (xcd - r) * q) + off; }
        const int nig = WGM * nN, gid = wgid / nig, fm = gid * WGM, gsz = (nM - fm) < WGM ? (nM - fm) : WGM;
        u.pm = fm + ((wgid % nig) % gsz); u.pn = (wgid % nig) / gsz; u.pb = u.pn; u.e = 0; return true;
    }
    __device__ __forceinline__ unsigned arow(const Unit&, int) const { return 0u; }
};

template <class Epi, class Sched>
__device__ __forceinline__ void gemm_phase(LAS unsigned char* lds, const Gemm g, const Sched& S, const Epi& E) {
    constexpr bool GATHER = Sched::GATHER;
    const int tid = threadIdx.x, wid = __builtin_amdgcn_readfirstlane(tid >> 6), lane = tid & 63, wr = wid >> 2, wc = wid & 3, fr = lane & 15, fq = lane >> 4;
    const int K = g.K, nt = K / BK, LDA = g.lda;
    unsigned voffB[2]; int RA[2], CA[2];
#pragma unroll
    for (int i = 0; i < 2; ++i) { int R_, C_; stage_rc(tid * 16 + i * 8192, R_, C_); const int Rb = Epi::PERM ? ((R_ & ~31) + perm32(R_ & 31)) : R_;
        RA[i] = R_; CA[i] = C_; voffB[i] = (unsigned)(Rb * K + C_) * 2u; }
    const size_t kstep = (size_t)(BK * 2);
    const size_t hstep = (size_t)HALF * K * 2;
    const size_t tstep = 2 * hstep;
    const size_t tstepA = (size_t)2 * HALF * LDA * 2;
    const unsigned ldsw = (unsigned)wid * 1024u;
    const int aoff = lds_byte(wr * 64 + fr, fq * 8), boff = lds_byte(wc * 32 + fr, fq * 8);
#define PG8_SA(b, h) (((b) * 2 + (h)) * HTB)
#define PG8_SB(b, h) ((4 + (b) * 2 + (h)) * HTB)
#define PG8_STAGE(bufoff, gbase, voff) do { _Pragma("unroll") for (int _i = 0; _i < 2; ++_i) \
        __builtin_amdgcn_global_load_lds((const unsigned*)((const char*)(gbase) + (voff)[_i]), (LAS unsigned*)(lds + (bufoff) + ldsw + _i * 8192), 16, 0, 0); } while (0)
#define PG8_LDA(dst, b, h) do { _Pragma("unroll") for (int m = 0; m < 4; ++m) _Pragma("unroll") for (int k = 0; k < 2; ++k) dst[m][k] = *(const LAS bf16x8*)(lds + PG8_SA(b, h) + aoff + m * 2048 + k * 1024); } while (0)
#define PG8_LDB(dst, b, h) do { _Pragma("unroll") for (int n = 0; n < 2; ++n) _Pragma("unroll") for (int k = 0; k < 2; ++k) dst[n][k] = *(const LAS bf16x8*)(lds + PG8_SB(b, h) + boff + n * 2048 + k * 1024); } while (0)
#define PG8_MMA(ai, bj, At, Bt) do { __builtin_amdgcn_s_setprio(1); _Pragma("unroll") for (int m = 0; m < 4; ++m) _Pragma("unroll") for (int n = 0; n < 2; ++n) _Pragma("unroll") for (int k = 0; k < 2; ++k) \
        acc[ai][bj][m][n] = __builtin_amdgcn_mfma_f32_16x16x32_bf16(Bt[n][k], At[m][k], acc[ai][bj][m][n], 0, 0, 0); __builtin_amdgcn_s_setprio(0); } while (0)
#define PG8_WAIT_V(n) asm volatile("s_waitcnt vmcnt(" #n ")" ::: "memory")
#define PG8_WAIT_L(n) asm volatile("s_waitcnt lgkmcnt(" #n ")" ::: "memory")
#define PG8_BAR __builtin_amdgcn_s_barrier()
#define PG8_SCHED __builtin_amdgcn_sched_barrier(0)
#define PG8_AOFFS(dst, u) do { _Pragma("unroll") for (int _h = 0; _h < 2; ++_h) _Pragma("unroll") for (int _i = 0; _i < 2; ++_i) { \
        if constexpr (GATHER) dst[_h][_i] = (S.arow(u, _h * HALF + RA[_i]) * (unsigned)LDA + (unsigned)CA[_i]) * 2u; \
        else dst[_h][_i] = ((unsigned)((_h * HALF + RA[_i]) * LDA + CA[_i])) * 2u; } } while (0)
    Unit cur, nxt; int ui = 0;
    if (!S.next(0, cur)) return;
    f32x4 acc[2][2][4][2];
#pragma unroll
    for (int a = 0; a < 2; ++a)
#pragma unroll
        for (int b = 0; b < 2; ++b)
#pragma unroll
            for (int m = 0; m < 4; ++m)
#pragma unroll
                for (int n = 0; n < 2; ++n) acc[a][b][m][n] = (f32x4){0.f, 0.f, 0.f, 0.f};
    bf16x8 At[4][2], B0[2][2], B1[2][2];
    unsigned vAc[2][2], vAn[2][2];
    PG8_AOFFS(vAc, cur);
    const char* cA = GATHER ? (const char*)g.A : (const char*)g.A + (size_t)cur.pm * tstepA; const char* cB = (const char*)g.Bt + (size_t)cur.pb * tstep;
    PG8_STAGE(PG8_SB(0, 0), cB, voffB); PG8_STAGE(PG8_SB(0, 1), cB + hstep, voffB); PG8_STAGE(PG8_SA(0, 0), cA, vAc[0]); PG8_STAGE(PG8_SA(0, 1), cA, vAc[1]);
    if (wr == 1) PG8_BAR;
    PG8_WAIT_V(2); PG8_BAR;
    PG8_STAGE(PG8_SB(1, 0), cB + kstep, voffB); PG8_STAGE(PG8_SA(1, 0), cA + kstep, vAc[0]); PG8_STAGE(PG8_SB(1, 1), cB + hstep + kstep, voffB);
    PG8_WAIT_V(6); PG8_BAR;
    for (;;) {
        const bool has_next = S.next(ui + 1, nxt);
        if (has_next) { PG8_AOFFS(vAn, nxt); } else {
#pragma unroll
            for (int _h = 0; _h < 2; ++_h)
#pragma unroll
                for (int _i = 0; _i < 2; ++_i) vAn[_h][_i] = vAc[_h][_i]; }
        const char* nA = has_next ? (GATHER ? (const char*)g.A : (const char*)g.A + (size_t)nxt.pm * tstepA) : cA; const char* nB = has_next ? (const char*)g.Bt + (size_t)nxt.pb * tstep : cB;
#pragma unroll 1
        for (int t = 0; t < nt; t += 2) {
            const bool last = (t == nt - 2);
            const char* a1 = cA + (size_t)(t + 1) * kstep;
            const char* a2 = last ? nA : cA + (size_t)(t + 2) * kstep; const char* b2 = last ? nB : cB + (size_t)(t + 2) * kstep;
            const char* a3 = a2 + kstep; const char* b3 = b2 + kstep;
            unsigned v2[2][2];
#pragma unroll
            for (int _h = 0; _h < 2; ++_h)
#pragma unroll
                for (int _i = 0; _i < 2; ++_i) v2[_h][_i] = last ? vAn[_h][_i] : vAc[_h][_i];
            PG8_LDB(B0, 0, 0); PG8_LDB(B1, 0, 1); PG8_SCHED; PG8_LDA(At, 0, 0); PG8_STAGE(PG8_SA(1, 1), a1, vAc[1]);
            PG8_WAIT_V(8); PG8_WAIT_L(0); PG8_BAR; PG8_MMA(0, 0, At, B0); PG8_MMA(0, 1, At, B1); PG8_BAR; PG8_SCHED;
            PG8_LDA(At, 0, 1); PG8_STAGE(PG8_SB(0, 0), b2, voffB); PG8_STAGE(PG8_SB(0, 1), b2 + hstep, voffB); PG8_STAGE(PG8_SA(0, 0), a2, v2[0]);
            PG8_WAIT_V(8); PG8_WAIT_L(0); PG8_BAR; PG8_MMA(1, 0, At, B0); PG8_MMA(1, 1, At, B1); PG8_BAR; PG8_SCHED;
            PG8_LDB(B0, 1, 0); PG8_LDB(B1, 1, 1); PG8_SCHED; PG8_LDA(At, 1, 0); PG8_STAGE(PG8_SA(0, 1), a2, v2[1]);
            PG8_WAIT_V(8); PG8_WAIT_L(0); PG8_BAR; PG8_MMA(0, 0, At, B0); PG8_MMA(0, 1, At, B1); PG8_BAR; PG8_SCHED;
            PG8_LDA(At, 1, 1); PG8_STAGE(PG8_SB(1, 0), b3, voffB); PG8_STAGE(PG8_SB(1, 1), b3 + hstep, voffB); PG8_STAGE(PG8_SA(1, 0), a3, v2[0]);
            PG8_WAIT_V(8); PG8_WAIT_L(0); PG8_BAR; PG8_MMA(1, 0, At, B0); PG8_MMA(1, 1, At, B1); PG8_BAR; PG8_SCHED;
        }
#ifndef NO_ALIGN_EPI
        if (wr == 0) PG8_BAR;
#endif
        E(acc, cur, wr, wc, fr, fq);
        if (!has_next) break;
#pragma unroll
        for (int a = 0; a < 2; ++a)
#pragma unroll
            for (int b = 0; b < 2; ++b)
#pragma unroll
                for (int m = 0; m < 4; ++m)
#pragma unroll
                    for (int n = 0; n < 2; ++n) acc[a][b][m][n] = (f32x4){0.f, 0.f, 0.f, 0.f};
        cur = nxt; cA = nA; cB = nB; ++ui;
#pragma unroll
        for (int _h = 0; _h < 2; ++_h)
#pragma unroll
            for (int _i = 0; _i < 2; ++_i) vAc[_h][_i] = vAn[_h][_i];
#ifndef NO_ALIGN_EPI
        if (wr == 1) PG8_BAR;
#endif
    }
    PG8_WAIT_V(0);
#ifdef NO_ALIGN_EPI
    if (wr == 0) PG8_BAR;
#endif
    PG8_BAR;
#undef PG8_SA
#undef PG8_SB
#undef PG8_STAGE
#undef PG8_LDA
#undef PG8_LDB
#undef PG8_MMA
#undef PG8_WAIT_V
#undef PG8_WAIT_L
#undef PG8_BAR
#undef PG8_SCHED
#undef PG8_AOFFS
}
}
namespace att {
constexpr int NW = 8, QBLK = 32, KVBLK = 64, DV = 128;
template <int DQK> __device__ __forceinline__ int kswz_f(int row) { if constexpr (DQK == 128) return (row & 3) | (((row >> 3) & 3) << 2); else return ((row >> 1) & 1) | (((row >> 3) & 3) << 1); }
#define KSWZ(row, colB, RS) ((row) * (RS) + ((colB) ^ (kswz_f<(RS) / 2>(row) << 4)))
#define SBAR() __builtin_amdgcn_sched_barrier(0)
__device__ __forceinline__ int crow(int r, int hi) { return (r & 3) + 8 * (r >> 2) + 4 * hi; }
constexpr float THR = 8.f;
constexpr float LOG2E = 1.4426950408889634f;

__device__ __forceinline__ void partialSM(f32x16& p0, f32x16& p1, float& m_reg, float& mn, float& alpha) {
  constexpr float C = LOG2E;
  float pmax = p0[0];
#pragma unroll
  for (int r = 1; r < 16; ++r) pmax = fmaxf(pmax, p0[r]);
#pragma unroll
  for (int r = 0; r < 16; ++r) pmax = fmaxf(pmax, p1[r]);
  { auto rr = __builtin_amdgcn_permlane32_swap(__float_as_uint(pmax), __float_as_uint(pmax), false, false);
    pmax = fmaxf(__uint_as_float(rr[0]), __uint_as_float(rr[1])); }
  if (__builtin_expect(__all(pmax - m_reg <= THR), 1)) { mn = m_reg; alpha = 1.f; }
  else { mn = fmaxf(m_reg, pmax); alpha = __builtin_amdgcn_exp2f((m_reg - mn) * C); m_reg = mn; }
  float mnC = -mn * C;
#pragma unroll
  for (int r = 0; r < 16; ++r) p0[r] = fmaf(p0[r], C, mnC);
#pragma unroll
  for (int r = 0; r < 16; ++r) p1[r] = fmaf(p1[r], C, mnC);
#pragma unroll
  for (int r = 0; r < 16; ++r) p0[r] = __builtin_amdgcn_exp2f(p0[r]);
}
__device__ __forceinline__ void finishSM(f32x16& p0, f32x16& p1, float alpha, float& l_reg, bf16x8& pa0, bf16x8& pa1, bf16x8& pa2, bf16x8& pa3) {
#pragma unroll
  for (int r = 0; r < 16; ++r) p1[r] = __builtin_amdgcn_exp2f(p1[r]);
  float ps = 0;
#pragma unroll
  for (int r = 0; r < 16; ++r) ps += p0[r];
#pragma unroll
  for (int r = 0; r < 16; ++r) ps += p1[r];
  { auto rr = __builtin_amdgcn_permlane32_swap(__float_as_uint(ps), __float_as_uint(ps), false, false);
    ps = __uint_as_float(rr[0]) + __uint_as_float(rr[1]); }
  l_reg = l_reg * alpha + ps;
#define PK4(P, BASE, OUT) do { unsigned a0 = cvt_pk_bf16(P[BASE + 0], P[BASE + 1]), a1 = cvt_pk_bf16(P[BASE + 2], P[BASE + 3]);   \
    unsigned b0 = cvt_pk_bf16(P[BASE + 4], P[BASE + 5]), b1 = cvt_pk_bf16(P[BASE + 6], P[BASE + 7]);                              \
    auto r0 = __builtin_amdgcn_permlane32_swap(a0, b0, false, false); auto r1 = __builtin_amdgcn_permlane32_swap(a1, b1, false, false); \
    u32x4 w = {r0[0], r1[0], r0[1], r1[1]}; OUT = *reinterpret_cast<bf16x8*>(&w); } while (0)
  PK4(p0, 0, pa0); PK4(p0, 8, pa1); PK4(p1, 0, pa2); PK4(p1, 8, pa3);
#undef PK4
}
__device__ __forceinline__ void finishSM_min(f32x16& p0, f32x16& p1, bf16x8& pa0, bf16x8& pa1, bf16x8& pa2, bf16x8& pa3) {
#define PK4(P, BASE, OUT) do { unsigned a0 = cvt_pk_bf16(P[BASE + 0], P[BASE + 1]), a1 = cvt_pk_bf16(P[BASE + 2], P[BASE + 3]);   \
    unsigned b0 = cvt_pk_bf16(P[BASE + 4], P[BASE + 5]), b1 = cvt_pk_bf16(P[BASE + 6], P[BASE + 7]);                              \
    auto r0 = __builtin_amdgcn_permlane32_swap(a0, b0, false, false); auto r1 = __builtin_amdgcn_permlane32_swap(a1, b1, false, false); \
    u32x4 w = {r0[0], r1[0], r0[1], r1[1]}; OUT = *reinterpret_cast<bf16x8*>(&w); } while (0)
  PK4(p0, 0, pa0); PK4(p0, 8, pa1); PK4(p1, 0, pa2); PK4(p1, 8, pa3);
#undef PK4
}
template <int DQK, int QL, int VAR = 0>
__device__ __forceinline__ void qkt(f32x16& p0, f32x16& p1, const char* Ks, const bf16x8* qr, const char* qlds, int r32, int hi) {
  p0 = f32x16{}; p1 = f32x16{};
  constexpr int NQ = DQK / 16, NR = NQ - QL, NG = NQ / 2;
  bf16x8 kb[2][4], qv[2];
#define QK_LD(buf_, g_) do { _Pragma("unroll") for (int dd = 0; dd < 2; ++dd) { const int d0 = 2 * (g_) + dd, cb = (d0 * 16 + hi * 8) * 2; \
      if constexpr (VAR == 9) { kb[buf_][2 * dd] = *reinterpret_cast<const bf16x8*>(Ks + cb); kb[buf_][2 * dd + 1] = *reinterpret_cast<const bf16x8*>(Ks + 32 * DQK * 2 + cb); } \
      else if constexpr (VAR == 8) { kb[buf_][2 * dd] = *reinterpret_cast<const bf16x8*>(Ks + r32 * (DQK * 2) + cb); kb[buf_][2 * dd + 1] = *reinterpret_cast<const bf16x8*>(Ks + (32 + r32) * (DQK * 2) + cb); } \
      else { kb[buf_][2 * dd] = *reinterpret_cast<const bf16x8*>(Ks + KSWZ(r32, cb, DQK * 2)); kb[buf_][2 * dd + 1] = *reinterpret_cast<const bf16x8*>(Ks + KSWZ(32 + r32, cb, DQK * 2)); } } } while (0)
#define QV_LD(g_) do { _Pragma("unroll") for (int dd = 0; dd < 2; ++dd) { const int d0 = 2 * (g_) + dd; if (d0 >= NR) qv[dd] = *reinterpret_cast<const bf16x8*>(qlds + (d0 - NR) * 1024); } } while (0)
  if constexpr (VAR == 6) { _Pragma("unroll") for (int i = 0; i < 2; ++i) _Pragma("unroll") for (int j = 0; j < 4; ++j) kb[i][j] = qr[0]; qv[0] = qr[0]; qv[1] = qr[0]; }
  if constexpr (VAR != 6) { QK_LD(0, 0); QV_LD(0); }
#pragma unroll
  for (int g = 0; g < NG; ++g) {
    if constexpr (VAR != 6) { if (g + 1 < NG) QK_LD((g + 1) & 1, g + 1); }
    SBAR();
#pragma unroll
    for (int dd = 0; dd < 2; ++dd) { const int d0 = 2 * g + dd; const bf16x8 q = d0 < NR ? qr[d0 < NR ? d0 : 0] : qv[dd];
      p0 = __builtin_amdgcn_mfma_f32_32x32x16_bf16(kb[g & 1][2 * dd], q, p0, 0, 0, 0);
      p1 = __builtin_amdgcn_mfma_f32_32x32x16_bf16(kb[g & 1][2 * dd + 1], q, p1, 0, 0, 0); }
    if constexpr (VAR != 6) if (g + 1 < NG) QV_LD(g + 1);
    SBAR();
  }
#undef QV_LD
#undef QK_LD
}
__device__ __forceinline__ int v_st(int k, int c) { const int kk = (k & ~0xC) | ((k & 4) << 1) | ((k & 8) >> 1); return ((kk >> 3) * 4 + (c >> 5)) * 512 + ((kk & 7) * 32 + (c & 31)) * 2; }
__device__ __forceinline__ int v_rd_base(int lane) { return ((lane & 3) << 3) | (((lane >> 2) & 3) << 6) | (((lane >> 4) & 1) << 5) | (((lane >> 5) & 1) << 8); }
constexpr int v_rd_off(int d0, int ks, int half) { return d0 * 512 + ks * 4096 + half * 2048; }
typedef short v4i16_t __attribute__((ext_vector_type(4)));
__device__ __forceinline__ s16x4 vtr(int addr) { return __builtin_bit_cast(s16x4, __builtin_amdgcn_ds_read_tr16_b64_v4i16(reinterpret_cast<LAS v4i16_t*>(addr))); }
template <int VAR = 0>
__device__ __forceinline__ void pv_d0(f32x16* o, int vb, bf16x8 pa0, bf16x8 pa1, bf16x8 pa2, bf16x8 pa3) {
  s16x4 vf[2][8];
  if constexpr (VAR == 7) { _Pragma("unroll") for (int i = 0; i < 2; ++i) _Pragma("unroll") for (int j = 0; j < 8; ++j) vf[i][j] = (s16x4){(short)pa0[0], (short)pa0[1], (short)pa1[0], (short)pa1[1]}; }
#define PV_LD(buf_, d0_) do { _Pragma("unroll") for (int ks = 0; ks < 4; ++ks) { vf[buf_][2 * ks] = vtr(vb + v_rd_off(d0_, ks, 0)); vf[buf_][2 * ks + 1] = vtr(vb + v_rd_off(d0_, ks, 1)); } } while (0)
#define PK(L, H) (bf16x8){L[0], L[1], L[2], L[3], H[0], H[1], H[2], H[3]}
  if constexpr (VAR != 7) PV_LD(0, 0);
#pragma unroll
  for (int d0 = 0; d0 < 4; ++d0) {
    if constexpr (VAR != 7) { if (d0 + 1 < 4) PV_LD((d0 + 1) & 1, d0 + 1); }
    SBAR();
    o[d0] = __builtin_amdgcn_mfma_f32_32x32x16_bf16(pa0, PK(vf[d0 & 1][0], vf[d0 & 1][1]), o[d0], 0, 0, 0);
    o[d0] = __builtin_amdgcn_mfma_f32_32x32x16_bf16(pa1, PK(vf[d0 & 1][2], vf[d0 & 1][3]), o[d0], 0, 0, 0);
    o[d0] = __builtin_amdgcn_mfma_f32_32x32x16_bf16(pa2, PK(vf[d0 & 1][4], vf[d0 & 1][5]), o[d0], 0, 0, 0);
    o[d0] = __builtin_amdgcn_mfma_f32_32x32x16_bf16(pa3, PK(vf[d0 & 1][6], vf[d0 & 1][7]), o[d0], 0, 0, 0);
    SBAR();
  }
#undef PK
#undef PV_LD
}
template <int DQK> struct Shm { static constexpr int V = KVBLK * DV * 2, K = KVBLK * DQK * 2, QL = (DQK > 128 ? (DQK - 128) / 16 : 0), TOTAL = 3 * V + 3 * K + NW * 64 * 4 + QL * NW * 1024; };

template <int DQK, int LDQ, int LDK, int LDV, int LDO, int VAR = 0>
__device__ __forceinline__ void attn_dense_body(const bf16* __restrict__ Qb, const bf16* __restrict__ Kh, const bf16* __restrict__ Vh, bf16* __restrict__ Ob, int seq, char* lds) {
  constexpr int SHM_V = Shm<DQK>::V, SHM_K = Shm<DQK>::K, NQ = DQK / 16, QL = Shm<DQK>::QL, NR = NQ - QL, KP = DQK / 64  , KROWB = DQK * 2;
  const int tid = threadIdx.x, wid = __builtin_amdgcn_readfirstlane(tid >> 6), lane = tid & 63, r32 = lane & 31, hi = lane >> 5;
  char* K_lds = lds; char* V_lds = lds + 3 * SHM_K;
  float* ws = (float*)(lds + 3 * SHM_V + 3 * SHM_K) + wid * 64; float* li_l = ws; float* al_l = ws + 32;
  float m_reg = -1e30f, l_reg = 0; f32x16 o[4] = {}; bf16x8 qr[NR];
  char* qlds = lds + 3 * SHM_V + 3 * SHM_K + NW * 64 * 4 + wid * (QL * 1024) + lane * 16;
  const bf16* Qw = Qb + (long)(wid * QBLK + r32) * LDQ + hi * 8;
#pragma unroll
  for (int d0 = 0; d0 < NQ; ++d0) { const bf16x8 qv = *reinterpret_cast<const bf16x8*>(Qw + d0 * 16); if (d0 < NR) qr[d0 < NR ? d0 : 0] = qv; else *reinterpret_cast<bf16x8*>(qlds + (d0 - NR) * 1024) = qv; }
  unsigned koff[KP], voff[2];
#pragma unroll
  for (int i = 0; i < KP; ++i) { const int ob = 16 * (tid + 512 * i), row = ob / KROWB, cbs = ob % KROWB, cb = cbs ^ (kswz_f<DQK>(row) << 4); koff[i] = (unsigned)(row * LDK * 2 + cb); }
#pragma unroll
  for (int i = 0; i < 2; ++i) { const int ob = 16 * (tid + 512 * i), sub = ob >> 9, rem = ob & 511, kk = (sub >> 2) * 8 + (rem >> 6), cc = (sub & 3) * 32 + ((rem & 63) >> 1);
    const int k = (kk & ~0xC) | ((kk & 4) << 1) | ((kk & 8) >> 1); voff[i] = (unsigned)(k * LDV * 2 + cc * 2); }
  const int vb0 = (int)(uintptr_t)V_lds + v_rd_base(lane);
  const int NT = seq / KVBLK;
#define KDMA(t_, slot_) do { if constexpr (VAR == 2 || VAR == 3) break; const int _tt = (t_) < NT ? (t_) : NT - 1; const char* _b = (const char*)Kh + (size_t)_tt * (KVBLK * LDK * 2); \
    _Pragma("unroll") for (int _q = 0; _q < KP; ++_q) { unsigned _o = koff[_q]; asm volatile("" : "+v"(_o)); __builtin_amdgcn_global_load_lds((const unsigned*)(_b + _o), (LAS unsigned*)(K_lds + (slot_) * SHM_K + _q * 8192 + wid * 1024), 16, 0, 0); } } while (0)
#define VDMA(t_, slot_) do { if constexpr (VAR == 2 || VAR == 3) break; const int _tt = (t_) < NT ? (t_) : NT - 1; const char* _b = (const char*)Vh + (size_t)_tt * (KVBLK * LDV * 2); \
    _Pragma("unroll") for (int _q = 0; _q < 2; ++_q) { unsigned _o = voff[_q]; asm volatile("" : "+v"(_o)); __builtin_amdgcn_global_load_lds((const unsigned*)(_b + _o), (LAS unsigned*)(V_lds + (slot_) * SHM_V + _q * 8192 + wid * 1024), 16, 0, 0); } } while (0)
#define WAITB() do { asm volatile("s_waitcnt vmcnt(%0)" :: "n"(KP + 2) : "memory"); __builtin_amdgcn_s_barrier(); asm volatile("" ::: "memory"); SBAR(); } while (0)
#define RESC(a) do { if (__any((a) < 1.f)) { if (hi == 0) al_l[r32] = (a); asm volatile("s_waitcnt lgkmcnt(0)" ::: "memory"); \
    _Pragma("unroll") for (int d = 0; d < 4; ++d) _Pragma("unroll") for (int r = 0; r < 16; ++r) o[d][r] *= al_l[crow(r, hi)]; } } while (0)
  f32x16 pA0 = {}, pA1 = {}, pB0 = {}, pB1 = {}; float mnA, mnB, alA = 1.f, alB = 1.f; bf16x8 pa0 = {}, pa1 = {}, pa2 = {}, pa3 = {};
#define WAITN(n_) do { if constexpr (VAR != 2 && VAR != 3) asm volatile("s_waitcnt vmcnt(%0)" :: "n"(n_) : "memory"); } while (0)
#define BARX() do { if constexpr (VAR != 3) __builtin_amdgcn_s_barrier(); asm volatile("" ::: "memory"); SBAR(); } while (0)
#define H1(X0, X1, Y0, Y1, alY, HASPREV) do { if (HASPREV) { if constexpr (VAR == 1) finishSM_min(Y0, Y1, pa0, pa1, pa2, pa3); else finishSM(Y0, Y1, alY, l_reg, pa0, pa1, pa2, pa3); } \
    SBAR(); if constexpr (VAR != 4) qkt<DQK, QL, VAR>(X0, X1, K_lds + s0 * SHM_K, qr, qlds, r32, hi); SBAR(); } while (0)
#define H2(X0, X1, mnX, alX, HASPREV) do { if (HASPREV) { if constexpr (VAR != 5) pv_d0<VAR>(o, vb0 + s2 * SHM_V, pa0, pa1, pa2, pa3); } \
    if constexpr (VAR != 1) { partialSM(X0, X1, m_reg, mnX, alX); RESC(alX); } else { alX = 1.f; mnX = 0.f; } } while (0)
#define ROT() do { const int _r = s0; s0 = s1; s1 = s2; s2 = _r; } while (0)
  KDMA(0, 0); KDMA(1, 1); VDMA(0, 0); KDMA(2, 2);
  WAITN(2 * KP + 2); BARX();
  int s0 = 0, s1 = 1, s2 = 2;
  if (wid < 4) {
#define STEP_A(t_, X0, X1, mnX, alX, Y0, Y1, alY, HASPREV) do { \
    H1(X0, X1, Y0, Y1, alY, HASPREV); WAITN(2 * KP + 2); BARX(); VDMA((t_) + 1, s1); \
    H2(X0, X1, mnX, alX, HASPREV);    WAITN(KP + 4);     BARX(); KDMA((t_) + 3, s0); ROT(); } while (0)
    for (int t = 0; t < NT; t += 2) {
      STEP_A(t, pA0, pA1, mnA, alA, pB0, pB1, alB, t > 0);
      STEP_A(t + 1, pB0, pB1, mnB, alB, pA0, pA1, alA, true);
    }
    if constexpr (VAR == 1) finishSM_min(pB0, pB1, pa0, pa1, pa2, pa3); else finishSM(pB0, pB1, alB, l_reg, pa0, pa1, pa2, pa3);
    WAITN(2 * KP + 2); BARX(); VDMA(NT + 1, s1);
    SBAR(); pv_d0<VAR>(o, vb0 + s2 * SHM_V, pa0, pa1, pa2, pa3);
    BARX();
#undef STEP_A
  } else {
    WAITN(2 * KP + 2); BARX(); VDMA(1, 1);
#define STEP_B(t_, X0, X1, mnX, alX, Y0, Y1, alY, HASPREV) do { \
    H1(X0, X1, Y0, Y1, alY, HASPREV); WAITN(KP + 4);     BARX(); KDMA((t_) + 3, s0); \
    H2(X0, X1, mnX, alX, HASPREV);    WAITN(2 * KP + 2); BARX(); VDMA((t_) + 2, s2); ROT(); } while (0)
    for (int t = 0; t < NT; t += 2) {
      STEP_B(t, pA0, pA1, mnA, alA, pB0, pB1, alB, t > 0);
      STEP_B(t + 1, pB0, pB1, mnB, alB, pA0, pA1, alA, true);
    }
    if constexpr (VAR == 1) finishSM_min(pB0, pB1, pa0, pa1, pa2, pa3); else finishSM(pB0, pB1, alB, l_reg, pa0, pa1, pa2, pa3);
    BARX();
    SBAR(); pv_d0<VAR>(o, vb0 + s2 * SHM_V, pa0, pa1, pa2, pa3);
#undef STEP_B
  }
  if (hi == 0) li_l[r32] = l_reg; asm volatile("s_waitcnt lgkmcnt(0)" ::: "memory");
  float rli[16];
#pragma unroll
  for (int r = 0; r < 16; ++r) rli[r] = __builtin_amdgcn_rcpf(li_l[crow(r, hi)]);
  int lane_e = lane; asm volatile("" : "+v"(lane_e));
  char* Ow = (char*)(Ob + (long)(wid * QBLK) * LDO);
  const unsigned ob0 = (unsigned)((4 * (lane_e >> 5)) * LDO + (lane_e & 31)) * 2u;
#pragma unroll
  for (int r = 0; r < 16; ++r) { const unsigned orow = (unsigned)(((r & 3) + 8 * (r >> 2)) * LDO) * 2u;
#pragma unroll
    for (int d0 = 0; d0 < 4; ++d0) *(bf16*)(Ow + (ob0 + orow + d0 * 64)) = f2bf(o[d0][r] * rli[r]); }
  asm volatile("s_waitcnt vmcnt(0)" ::: "memory"); __builtin_amdgcn_s_barrier(); asm volatile("" ::: "memory");
  (void)mnA; (void)mnB;
#undef KDMA
#undef VDMA
#undef WAITB
#undef RESC
#undef WAITN
#undef BARX
#undef H1
#undef H2
#undef ROT
}
}
constexpr size_t MiB = 1u << 20;
constexpr size_t WS_CTL = 0, CTL_ZERO_BYTES = 1 * MiB;
constexpr size_t WS_MODS = 1 * MiB;
constexpr size_t WS_TAB_RET = 2 * MiB;
constexpr size_t WS_TAB_A128 = 4 * MiB + 512 * 1024;
constexpr size_t WS_TAB_A64 = WS_TAB_A128 + 16384;
constexpr size_t WS_WABIN = 6 * MiB, WS_WABOUT = 12 * MiB, WS_WMLAIN = 14 * MiB, WS_WUQ = 16 * MiB, WS_WUKV = 18 * MiB, WS_WMLAOUT = 19 * MiB;
constexpr size_t WS_WUP = 22 * MiB, WS_WDOWN = 278 * MiB;
constexpr size_t WS_X = 406 * MiB, WS_ACC = 542 * MiB, WS_H = 678 * MiB, WS_P = 746 * MiB, WS_MIX = 950 * MiB;
constexpr size_t WS_KZTF = 1018 * MiB, WS_KZTB = 1052 * MiB, WS_VBT = 1086 * MiB, WS_ST = 1120 * MiB;
constexpr size_t WS_LTOK = 1188 * MiB, WS_LGATE = 1205 * MiB, WS_TOKSLOT = 1222 * MiB, WS_ACT = 1223 * MiB, WS_YK = 1511 * MiB, WS_END = 1799 * MiB;
constexpr size_t WS_PM = WS_P, WS_CQ = WS_P + 51 * MiB, WS_CKV = WS_CQ + 25 * MiB + 512 * 1024, WS_QM = WS_CKV + 17 * MiB;
constexpr size_t WS_KM = WS_KZTF, WS_VM = WS_ST;
constexpr size_t WS_SS = WS_CQ;
static_assert(WS_QM + (size_t)R * UQ_N * 2 <= WS_MIX, "MLA overlay fits in P");
static_assert(WS_KM + (size_t)R * UQ_N * 2 <= WS_ST && WS_VM + (size_t)R * 1024 * 2 <= WS_LTOK, "MLA K/V overlay");
static_assert(WS_ACT + (size_t)NSLOT_MAX * 1024 * 2 <= WS_YK && WS_YK + (size_t)NSLOT_MAX * 1024 * 2 <= WS_END, "MoE buffers");
constexpr int CW_TMO = 0, CW_BAR = 4096, CW_CNT = 16384;

constexpr int RING_BYTES = 131072;
constexpr int ATT_BYTES = 157696;
constexpr int XTRA_OFF = RING_BYTES;
constexpr int MISC_OFF = ATT_BYTES;
constexpr int TMAP_OFF = ATT_BYTES + 1024;
constexpr int LDS_BYTES = ATT_BYTES + 2048;
static_assert(att::Shm<192>::TOTAL <= ATT_BYTES && att::Shm<128>::TOTAL <= ATT_BYTES && LDS_BYTES <= 163840, "LDS map");

#define XB_TMO      128
#define XB_XCNT(j)  (256  + 64 * (j))
#define XB_XSUB(j)  (1280 + 64 * (j))
#define XB_XGEN(j)  (2304 + 64 * (j))
#define XB_TOP      3328
#define XB_TOPGEN   3392
#define XCD_BAR_WORDS 3456
#define XB_SPIN_CAP (1u << 22)
__device__ __forceinline__ unsigned xb_ld(unsigned* p)              { return __hip_atomic_load(p, __ATOMIC_RELAXED, __HIP_MEMORY_SCOPE_AGENT); }
__device__ __forceinline__ unsigned xb_add(unsigned* p, unsigned v) { return __hip_atomic_fetch_add(p, v, __ATOMIC_RELAXED, __HIP_MEMORY_SCOPE_AGENT); }
__device__ __forceinline__ unsigned xb_xcc_id() { return (unsigned)__builtin_amdgcn_s_getreg((3 << 11) | 20) & 0xFu; }
#define XB_SPIN(cond, bar) do { unsigned _sp = 0; while (cond) { __builtin_amdgcn_s_sleep(1); \
    if ((++_sp & 255u) == 0u) { if (xb_ld(&(bar)[XB_TMO])) break; if (_sp > XB_SPIN_CAP) { atomicAdd(&(bar)[XB_TMO], 1u); break; } } } } while (0)
struct XcdBarrier { unsigned* bar; unsigned x; volatile LAS unsigned* st; };
__device__ __forceinline__ XcdBarrier xcd_barrier_post(unsigned* bar, volatile LAS unsigned* st) {
    XcdBarrier b; b.bar = bar; b.x = xb_xcc_id(); b.st = st;
    if (threadIdx.x == 0) (void)xb_add(&bar[XB_XCNT(b.x)], 1u);
    return b;
}
__device__ __forceinline__ void xcd_barrier_complete(unsigned* bar, unsigned x, unsigned& nloc, unsigned& nx) {
    const unsigned G = gridDim.x * gridDim.y * gridDim.z;
    unsigned sum, cnt, mine, sp = 0u;
    for (;;) {
        sum = 0u; cnt = 0u; mine = 0u;
#pragma unroll
        for (unsigned j = 0; j < 16; ++j) { const unsigned c = xb_ld(&bar[XB_XCNT(j)]); sum += c; cnt += (c > 0u) ? 1u : 0u; mine = (j == x) ? c : mine; }
        if (sum == G) break;
        __builtin_amdgcn_s_sleep(1);
        if ((++sp & 255u) == 0u) { if (xb_ld(&bar[XB_TMO])) break; if (sp > XB_SPIN_CAP) { atomicAdd(&bar[XB_TMO], 1u); break; } }
    }
    nloc = mine > 0u ? mine : 1u; nx = cnt > 0u ? cnt : 1u;
}
__device__ __forceinline__ void xcd_barrier(const XcdBarrier& b) {
    asm volatile("s_waitcnt vmcnt(0)" ::: "memory");
    __syncthreads();
    if (threadIdx.x == 0) {
        unsigned* bar = b.bar;
        __builtin_amdgcn_s_waitcnt(0);
        unsigned nloc = b.st[0], nx = b.st[1];
        if (nloc == 0u) { xcd_barrier_complete(bar, b.x, nloc, nx); b.st[0] = nloc; b.st[1] = nx; }
        const unsigned old = xb_add(&bar[XB_XSUB(b.x)], 1u);
        const unsigned gen = old / nloc;
        if (old + 1u == (gen + 1u) * nloc) {
            __builtin_amdgcn_fence(__ATOMIC_RELEASE, "agent");
            asm volatile("s_waitcnt vmcnt(0)" ::: "memory");
            const unsigned og = xb_add(&bar[XB_TOP], 1u);
            const unsigned tg = og / nx;
            if (og + 1u == (tg + 1u) * nx) xb_add(&bar[XB_TOPGEN], 1u);
            else XB_SPIN(xb_ld(&bar[XB_TOPGEN]) == tg, bar);
            __builtin_amdgcn_fence(__ATOMIC_ACQUIRE, "agent");
            xb_add(&bar[XB_XGEN(b.x)], 1u);
            asm volatile("s_waitcnt vmcnt(0)" ::: "memory");
        } else {
            XB_SPIN(xb_ld(&bar[XB_XGEN(b.x)]) == gen, bar);
            __builtin_amdgcn_fence(__ATOMIC_ACQUIRE, "agent");
            asm volatile("s_waitcnt vmcnt(0)" ::: "memory");
        }
    }
    __syncthreads();
}

struct Args { const float* in[28]; float* out; unsigned char* ws; int ph_lo, ph_hi; };
struct Ctx { LAS unsigned char* lds; int tid, lane, wave, vcu, G, gw, NGW; };
enum { I_X = 0, I_C, I_CTX, I_CCTX, I_ADAW, I_ADAB, I_LN1G, I_LN1B, I_LN2G, I_LN2B, I_ABWIN, I_ABQN, I_ABKN, I_ABLD, I_ABGN, I_ABWOUT,
       I_MLAWIN, I_MLAQN, I_MLAKVN, I_MLAWUQ, I_MLAWUKV, I_MLAWOUT, I_RW, I_RB, I_WUP, I_BUP, I_WDOWN, I_BDOWN };
template <int MAP> __device__ __forceinline__ int colmap(int r) {
    if constexpr (MAP == 0) return r;
    else if constexpr (MAP == 1) { const int t = r >> 8, cc = r & 255; return cc < 128 ? t * 128 + cc : 1024 + t * 128 + (cc - 128); }
    else if constexpr (MAP == 2) {
        if (r < 384) return r;
        if (r < 448) { const int t = r - 384, wc = t >> 5, fq = (t >> 3) & 3, n = (t >> 2) & 1, k = t & 3; return 640 + 32 * wc + 16 * n + 4 * fq + k; }
        if (r < 512) return -1;
        return 384 + (r - 512);
    }
    else {
        if (r < 1024) { const int h = r >> 7, i = r & 127; return h * 192 + i; }
        const int rr = r - 1024, t = rr >> 8, cc = rr & 255, bj = cc >> 7, c2 = cc & 127, head = 4 * t + (c2 >> 5), j = c2 & 31;
        return head * 192 + 128 + (j < 16 ? j : 16 + j) + (bj ? 16 : 0);
    }
}
template <int MAP> __device__ __forceinline__ void tr_item(const float* __restrict__ W, int K, int N, bf16* __restrict__ WT, LAS float* scr, int item, int nblk, int lane, const float* __restrict__ gk = nullptr) {
    const int kb = item / nblk, nb = item % nblk, k0 = 64 * kb, n0 = 32 * nb;
    const int col = colmap<MAP>(n0 + (lane & 31));
    const float* src = W + (size_t)(k0 + (lane >> 5)) * N + (col >= 0 ? col : 0);
    float v[32];
#pragma unroll
    for (int i = 0; i < 32; ++i) v[i] = src[(size_t)(2 * i) * N];
#pragma unroll
    for (int i = 0; i < 32; ++i) { const int kk = 2 * i + (lane >> 5); float x = col >= 0 ? v[i] : 0.f; if (gk) x *= gk[k0 + kk]; scr[kk * 33 + (lane & 31)] = x; }
    LDS_WAIT(); asm volatile("" ::: "memory");
    const int c8 = lane & 7;
#pragma unroll
    for (int j = 0; j < 4; ++j) { const int n = (lane >> 3) + 8 * j; const LAS float* s = scr + (8 * c8) * 33 + n;
        u32x4 o; o.x = cvt_pk_nv(s[0 * 33], s[1 * 33]); o.y = cvt_pk_nv(s[2 * 33], s[3 * 33]); o.z = cvt_pk_nv(s[4 * 33], s[5 * 33]); o.w = cvt_pk_nv(s[6 * 33], s[7 * 33]);
        *(u32x4*)(WT + (size_t)(n0 + n) * K + k0 + 8 * c8) = o; }
    LDS_WAIT(); asm volatile("" ::: "memory");
}
__device__ __forceinline__ void ph0_prologue(const Args& a, const Ctx& c) {
    unsigned char* ws = a.ws;
    float* mods = (float*)(ws + WS_MODS);
    {
        LAS float* sc = (LAS float*)c.lds;
        LAS float* part = (LAS float*)(c.lds + 40960);
        for (int i = c.tid; i < 9 * 1024; i += 512) { const float v = (i < 8192) ? a.in[I_C][i] : a.in[I_CCTX][i - 8192]; sc[i] = v / (1.f + expf(-v)); }
        __syncthreads();
        for (int task = blockIdx.x; task < 192; task += c.G) {
            const int l = task / 96, j = (task % 96) * 64 + c.lane;
            const float* W = a.in[I_ADAW] + (size_t)l * 1024 * 6144 + (size_t)(128 * c.wave) * 6144 + j;
            float acc[9];
#pragma unroll
            for (int b = 0; b < 9; ++b) acc[b] = 0.f;
#pragma unroll 1
            for (int d0 = 0; d0 < 128; d0 += 32) { float w[32];
#pragma unroll
                for (int i = 0; i < 32; ++i) w[i] = W[(size_t)(d0 + i) * 6144];
#pragma unroll
                for (int i = 0; i < 32; ++i)
#pragma unroll
                    for (int b = 0; b < 9; ++b) acc[b] = fmaf(sc[b * 1024 + 128 * c.wave + d0 + i], w[i], acc[b]); }
#pragma unroll
            for (int b = 0; b < 9; ++b) part[(c.wave * 9 + b) * 64 + c.lane] = acc[b];
            __syncthreads();
            for (int i = c.tid; i < 9 * 64; i += 512) { float sum = 0.f;
#pragma unroll
                for (int w8 = 0; w8 < 8; ++w8) sum += part[w8 * 576 + i];
                const int b = i >> 6, jj = (task % 96) * 64 + (i & 63);
                mods[(size_t)(l * 9 + b) * 6144 + jj] = sum + a.in[I_ADAB][l * 6144 + jj]; }
            __syncthreads();
        }
    }
    {
        float2* ret = (float2*)(ws + WS_TAB_RET); float2* a128 = (float2*)(ws + WS_TAB_A128); float2* a64 = (float2*)(ws + WS_TAB_A64);
        const int gt = c.gw * 64 + c.lane, NT = c.NGW * 64;
        for (int i = gt; i < SP * 64; i += NT) { const int pos = i >> 6, f = i & 63; const double ang = (double)pos * pow(10000.0, -(double)f / 64.0); ret[i] = make_float2((float)cos(ang), (float)sin(ang)); }
        for (int i = gt; i < 64 * 32; i += NT) { const int pos = i >> 5, f = i & 31; const double ang = (double)pos * pow(10000.0, -(double)f / 32.0); a128[i] = make_float2((float)cos(ang), (float)sin(ang)); }
        for (int i = gt; i < 64 * 16; i += NT) { const int pos = i >> 4, f = i & 15; const double ang = (double)pos * pow(10000.0, -(double)f / 16.0); a64[i] = make_float2((float)cos(ang), (float)sin(ang)); }
    }
    {
        LAS float* scr = (LAS float*)(c.lds + c.wave * 16384);
        constexpr int I0 = 16 * 96, I1 = 16 * 32, I2 = 16 * 24, I3 = 6 * 48, I4 = 4 * 64, I5 = 16 * 32, IUP = 16 * 64, IDN = 16 * 32;
        constexpr int NITEMS = I0 + I1 + I2 + I3 + I4 + I5 + 64 * IUP + 64 * IDN;
        for (int it = c.gw; it < NITEMS; it += c.NGW) {
            int r = it;
            if (r < I0) { tr_item<0>(a.in[I_ABWIN], 1024, AB_IN, (bf16*)(ws + WS_WABIN), scr, r, 96, c.lane); continue; } r -= I0;
            if (r < I1) { tr_item<0>(a.in[I_ABWOUT], 1024, 1024, (bf16*)(ws + WS_WABOUT), scr, r, 32, c.lane); continue; } r -= I1;
            if (r < I2) { tr_item<2>(a.in[I_MLAWIN], 1024, MLA_IN, (bf16*)(ws + WS_WMLAIN), scr, r, 24, c.lane); continue; } r -= I2;
            if (r < I3) { tr_item<3>(a.in[I_MLAWUQ], MLA_QL, UQ_N, (bf16*)(ws + WS_WUQ), scr, r, 48, c.lane, a.in[I_MLAQN]); continue; } r -= I3;
            if (r < I4) { tr_item<0>(a.in[I_MLAWUKV], MLA_KVL, UKV_N, (bf16*)(ws + WS_WUKV), scr, r, 64, c.lane, a.in[I_MLAKVN]); continue; } r -= I4;
            if (r < I5) { tr_item<0>(a.in[I_MLAWOUT], 1024, 1024, (bf16*)(ws + WS_WMLAOUT), scr, r, 32, c.lane); continue; } r -= I5;
            if (r < 64 * IUP) { const int m = r / IUP; tr_item<1>(a.in[I_WUP] + (size_t)m * 1024 * 2048, 1024, 2048, (bf16*)(ws + WS_WUP) + (size_t)m * 2048 * 1024, scr, r % IUP, 64, c.lane); continue; } r -= 64 * IUP;
            { const int m = r / IDN; tr_item<0>(a.in[I_WDOWN] + (size_t)m * 1024 * 1024, 1024, 1024, (bf16*)(ws + WS_WDOWN) + (size_t)m * 1024 * 1024, scr, r % IDN, 32, c.lane); }
        }
    }
}

__device__ __forceinline__ void ph1_mod0(const Args& a, const Ctx& c) {
    const float* mods = (const float*)(a.ws + WS_MODS); bf16* H = (bf16*)(a.ws + WS_H);
#define P1_SRC(row_) (((row_) % SP) < NCTX ? a.in[I_CTX] + ((size_t)((row_) / SP) * NCTX + ((row_) % SP)) * D : a.in[I_X] + ((size_t)((row_) / SP) * SEQ + (((row_) % SP) - NCTX)) * D)
    f32x4 xn[4];
    if (c.gw < R) { const float* src = P1_SRC(c.gw);
#pragma unroll
        for (int j = 0; j < 4; ++j) xn[j] = *(const f32x4*)(src + 4 * c.lane + 256 * j); }
    for (int row = c.gw; row < R; row += c.NGW) {
        f32x4 x[4];
#pragma unroll
        for (int j = 0; j < 4; ++j) x[j] = xn[j];
        if (row + c.NGW < R) { const float* src = P1_SRC(row + c.NGW);
#pragma unroll
            for (int j = 0; j < 4; ++j) xn[j] = *(const f32x4*)(src + 4 * c.lane + 256 * j); }
        const int b = row / SP, s = row % SP;
        const float* m = mods + (size_t)(s < NCTX ? 8 : b) * 6144;
        bf16* dst = H + (size_t)row * D;
#pragma unroll
        for (int j = 0; j < 4; ++j) { const int col = 4 * c.lane + 256 * j;
            const f32x4 sh = *(const f32x4*)(m + col), sl = *(const f32x4*)(m + 1024 + col);
            const f32x4 h = x[j] * (sl + 1.0f) + sh;
            u32x2 o; o.x = cvt_pk_bf16(h[0], h[1]); o.y = cvt_pk_bf16(h[2], h[3]); *(u32x2*)(dst + col) = o; }
    }
#undef P1_SRC
}

#ifdef NT_EPI
__device__ __forceinline__ void st16(void* base, unsigned off, u32x4 v) { __builtin_nontemporal_store(v, (u32x4*)((char*)base + off)); }
#else
__device__ __forceinline__ void st16(void* base, unsigned off, u32x4 v) { *(u32x4*)((char*)base + off) = v; }
#endif
__device__ __forceinline__ void st8(void* base, unsigned off, u32x2 v) { *(u32x2*)((char*)base + off) = v; }
__device__ __forceinline__ u32x4 pack2x4(const f32x4 v0, const f32x4 v1) { u32x4 w; w.x = cvt_pk_bf16(v0[0], v0[1]); w.y = cvt_pk_bf16(v0[2], v0[3]); w.z = cvt_pk_bf16(v1[0], v1[1]); w.w = cvt_pk_bf16(v1[2], v1[3]); return w; }
struct EpiStoreBf16 {
    static constexpr bool PERM = true;
    bf16* O; int ldc;
    __device__ __forceinline__ void operator()(const f32x4 (&acc)[2][2][4][2], const pg8::Unit& u, int wr, int wc, int fr, int fq) const {
        const unsigned rb = ((unsigned)(u.pm * 256 + wr * 64 + fr) * (unsigned)ldc + (unsigned)(u.pn * 256 + wc * 32 + 8 * fq)) * 2u;
#pragma unroll
        for (int ai = 0; ai < 2; ++ai)
#pragma unroll
            for (int m = 0; m < 4; ++m) { const unsigned ro = rb + (unsigned)((ai * 128 + m * 16) * ldc) * 2u;
#pragma unroll
                for (int bj = 0; bj < 2; ++bj) st16(O, ro + bj * 256, pack2x4(acc[ai][bj][m][0], acc[ai][bj][m][1])); }
    }
};
template <int L> struct EpiResid {
    static constexpr bool PERM = true;
    const float* xlat; const float* xctx; const bf16* X; const float* mods  ; bf16* ACC;
    __device__ __forceinline__ void operator()(const f32x4 (&acc)[2][2][4][2], const pg8::Unit& u, int wr, int wc, int fr, int fq) const {
        const int b = u.pm / 17, tt = u.pm % 17; const bool isc = (tt == 0);
        const float* src = nullptr; const bf16* srcb = nullptr; if constexpr (L == 0) src = isc ? xctx + (size_t)b * NCTX * D : xlat + ((size_t)b * SEQ + (size_t)(tt - 1) * 256) * D; else srcb = X + (size_t)u.pm * 256 * D;
        const float* m2 = mods + (size_t)(isc ? 8 : b) * 6144 + 2 * 1024;
        bf16* dst = ACC + (size_t)u.pm * 256 * D;
        const int col0 = u.pn * 256 + wc * 32 + 8 * fq;
        const unsigned rb = ((unsigned)(wr * 64 + fr) * D + (unsigned)col0);
        f32x4 mv[2][2];
#pragma unroll
        for (int bj = 0; bj < 2; ++bj)
#pragma unroll
            for (int n = 0; n < 2; ++n) mv[bj][n] = *(const f32x4*)(m2 + col0 + bj * 128 + n * 4);
#pragma unroll
        for (int ai = 0; ai < 2; ++ai)
#pragma unroll
            for (int m = 0; m < 4; ++m) { const unsigned ro = rb + (unsigned)((ai * 128 + m * 16) * D);
#pragma unroll
                for (int bj = 0; bj < 2; ++bj) { const unsigned o = ro + bj * 128; f32x4 x0, x1;
                    if constexpr (L == 0) { x0 = *(const f32x4*)(src + o); x1 = *(const f32x4*)(src + o + 4); }
                    else { const u32x4 w = *(const u32x4*)(srcb + o); x0 = (f32x4){bflo(w.x), bfhi(w.x), bflo(w.y), bfhi(w.y)}; x1 = (f32x4){bflo(w.z), bfhi(w.z), bflo(w.w), bfhi(w.w)}; }
                    st16(dst, o * 2u, pack2x4(x0 * DN_ALPHA + mv[bj][0] * acc[ai][bj][m][0], x1 * DN_ALPHA + mv[bj][1] * acc[ai][bj][m][1])); } }
    }
};
__device__ __forceinline__ void unpack8(const u32x4 w, float* v) { v[0] = bflo(w.x); v[1] = bfhi(w.x); v[2] = bflo(w.y); v[3] = bfhi(w.y); v[4] = bflo(w.z); v[5] = bfhi(w.z); v[6] = bflo(w.w); v[7] = bfhi(w.w); }
__device__ __forceinline__ u32x4 pack8(const float* v) { u32x4 w; w.x = cvt_pk_bf16(v[0], v[1]); w.y = cvt_pk_bf16(v[2], v[3]); w.z = cvt_pk_bf16(v[4], v[5]); w.w = cvt_pk_bf16(v[6], v[7]); return w; }
__device__ __forceinline__ float log_gamma_of(float log_decay) { return (float)log1p(-exp((double)log_decay)); }

__device__ __forceinline__ void ph3_post(const Args& a, const Ctx& c) {
    bf16* P = (bf16*)(a.ws + WS_P);
    const float2* RET = (const float2*)(a.ws + WS_TAB_RET); const float2* A128 = (const float2*)(a.ws + WS_TAB_A128);
    const float* qn = a.in[I_ABQN]; const float* kn = a.in[I_ABKN]; const float* ld = a.in[I_ABLD];
    bf16* KZTF = (bf16*)(a.ws + WS_KZTF); bf16* KZTB = (bf16*)(a.ws + WS_KZTB); bf16* VBT = (bf16*)(a.ws + WS_VBT);
    LAS bf16* T0 = (LAS bf16*)c.lds; LAS bf16* T1 = T0 + 128 * 72;
    const int tok = c.tid >> 3, j = c.tid & 7;
    constexpr float QK_SCALE = 0.08838834764831845f;
#define P3_COLS(kind_, c1_, c2_) do { if ((kind_) < 6) { const int _x = j < 4 ? 8 * j : 64 + 8 * (j - 4); c1_ = (kind_) * 128 + _x; c2_ = c1_ + 32; } \
        else if ((kind_) < 14) { c1_ = 1024 + ((kind_) - 6) * 128 + 8 * j; c2_ = c1_ + 64; } else { c1_ = 2048 + ((kind_) - 14) * 128 + 16 * j; c2_ = c1_ + 8; } } while (0)
    u32x4 nw1 = (u32x4){0u, 0u, 0u, 0u}, nw2 = nw1;
    if (c.vcu < (R / 64) * 18) { const int rb = c.vcu / 18, kind = c.vcu % 18; int c1, c2; P3_COLS(kind, c1, c2); const bf16* pr = P + (size_t)(rb * 64 + tok) * AB_IN; nw1 = *(const u32x4*)(pr + c1); nw2 = *(const u32x4*)(pr + c2); }
    for (int u = c.vcu; u < (R / 64) * 18; u += c.G) {
        const int rb = u / 18, kind = u % 18;
        const int row0 = rb * 64, b0 = row0 / SP, s0 = row0 % SP;
        const int row = row0 + tok, s = s0 + tok; const bool lat = s0 >= NCTX;
        bf16* prow = P + (size_t)row * AB_IN;
        const u32x4 cw1 = nw1, cw2 = nw2;
        if (u + c.G < (R / 64) * 18) { const int rbn = (u + c.G) / 18, kn = (u + c.G) % 18; int c1, c2; P3_COLS(kn, c1, c2); const bf16* pr = P + (size_t)(rbn * 64 + tok) * AB_IN; nw1 = *(const u32x4*)(pr + c1); nw2 = *(const u32x4*)(pr + c2); }
        if (kind < 14) {
            int cb, x1c, x2c;
            if (kind < 6) { cb = kind * 128; x1c = j < 4 ? 8 * j : 64 + 8 * (j - 4); x2c = x1c + 32; }
            else { cb = 1024 + (kind - 6) * 128; x1c = 8 * j; x2c = 64 + 8 * j; }
            float v1[8], v2[8], o1[8], o2[8];
            unpack8(cw1, v1); unpack8(cw2, v2);
            if (kind < 6) {
                float ss = 0.f;
#pragma unroll
                for (int i = 0; i < 8; ++i) ss += v1[i] * v1[i] + v2[i] * v2[i];
                ss += __shfl_xor(ss, 1); ss += __shfl_xor(ss, 2); ss += __shfl_xor(ss, 4);
                const float rinv = rsqrtf(ss * (1.f / 128.f) + 1e-6f);
                const float* g = kind < 4 ? qn : kn;
#pragma unroll
                for (int i = 0; i < 8; ++i) { v1[i] *= rinv * g[x1c + i]; v2[i] *= rinv * g[x2c + i]; }
                if (lat) { const int t = s - NCTX; const int pos = j < 4 ? t / GRID_W : t % GRID_W; const float2* cs = A128 + pos * 32 + (j & 3) * 8;
#pragma unroll
                    for (int i = 0; i < 8; ++i) { const float2 q = cs[i]; o1[i] = v1[i] * q.x - v2[i] * q.y; o2[i] = v1[i] * q.y + v2[i] * q.x; } }
                else {
#pragma unroll
                    for (int i = 0; i < 8; ++i) { o1[i] = v1[i]; o2[i] = v2[i]; } }
                if (kind < 4) {
#pragma unroll
                    for (int i = 0; i < 8; ++i) { o1[i] *= QK_SCALE; o2[i] *= QK_SCALE; } }
            } else {
                const float2* cs = RET + (size_t)s * 64 + 8 * j;
#pragma unroll
                for (int i = 0; i < 8; ++i) { const float2 q = cs[i]; o1[i] = v1[i] * q.x - v2[i] * q.y; o2[i] = v1[i] * q.y + v2[i] * q.x; }
                if (kind < 10) {
#pragma unroll
                    for (int i = 0; i < 8; ++i) { o1[i] *= QK_SCALE; o2[i] *= QK_SCALE; } }
            }
            *(u32x4*)(prow + cb + x1c) = pack8(o1); *(u32x4*)(prow + cb + x2c) = pack8(o2);
            if (kind >= 10) {
                const int h = kind - 10;
                const float lgf = log_gamma_of(ld[h]), lgb = log_gamma_of(ld[4 + h]);
                const int cpos = s & 127;
                const float zf = expf(lgf * (float)(127 - cpos)), zb = expf(lgb * (float)cpos);
#pragma unroll
                for (int i = 0; i < 8; ++i) { T0[(x1c + i) * 72 + tok] = f2bf(o1[i] * zf); T0[(x2c + i) * 72 + tok] = f2bf(o2[i] * zf);
                                              T1[(x1c + i) * 72 + tok] = f2bf(o1[i] * zb); T1[(x2c + i) * 72 + tok] = f2bf(o2[i] * zb); }
                __syncthreads();
#pragma unroll
                for (int q = 0; q < 2; ++q) { const int p = c.tid + 512 * q, d = p >> 3, seg = p & 7;
                    const size_t go = ((size_t)((b0 * 4 + h) * 128 + d)) * SP + s0 + seg * 8;
                    *(u32x4*)(KZTF + go) = *(const LAS u32x4*)(T0 + d * 72 + seg * 8);
                    *(u32x4*)(KZTB + go) = *(const LAS u32x4*)(T1 + d * 72 + seg * 8); }
                __syncthreads();
            }
        } else {
            const int h = kind - 14, cb = 2048 + h * 128;
            const u32x4 w0 = cw1, w1 = cw2; (void)cb;
            const unsigned ww[8] = {w0.x, w0.y, w0.z, w0.w, w1.x, w1.y, w1.z, w1.w};
#pragma unroll
            for (int i = 0; i < 8; ++i) { T0[(16 * j + 2 * i) * 72 + tok] = (bf16)(ww[i] & 0xffffu); T0[(16 * j + 2 * i + 1) * 72 + tok] = (bf16)(ww[i] >> 16); }
            __syncthreads();
#pragma unroll
            for (int q = 0; q < 2; ++q) { const int p = c.tid + 512 * q, d = p >> 3, seg = p & 7;
                *(u32x4*)(VBT + ((size_t)((b0 * 4 + h) * 128 + d)) * SP + s0 + seg * 8) = *(const LAS u32x4*)(T0 + d * 72 + seg * 8); }
            __syncthreads();
        }
    }
#undef P3_COLS
}

#define MFMA16(a_, b_, c_) __builtin_amdgcn_mfma_f32_16x16x32_bf16((a_), (b_), (c_), 0, 0, 0)
__device__ __forceinline__ void ph4_r1(const Args& a, const Ctx& c) {
    const float* ld = a.in[I_ABLD];
    bf16* ST = (bf16*)(a.ws + WS_ST);
    const int fr = c.lane & 15, fq = c.lane >> 4;
    constexpr int GS = 6, VPITCH = GS * 256 + 16;
    LAS unsigned char* VS = c.lds;
#define R1_JN(n_) (dir == 0 ? (n_) : ((n_) < 2 ? 1 - (n_) : 35 - (n_)))
    for (int task = blockIdx.x; task < 256; task += c.G) {
        const int eq = task & 3, dir = (task >> 2) & 1, h = (task >> 3) & 3, b = task >> 5;
        const bf16* KZ = (const bf16*)(a.ws + (dir ? WS_KZTB : WS_KZTF)) + (size_t)(b * 4 + h) * 128 * SP;
        const bf16* VT = (const bf16*)(a.ws + WS_VBT) + (size_t)(b * 4 + h) * 128 * SP;
        const float decay = expf(log_gamma_of(ld[dir * 4 + h]) * 128.f);
        const int d0 = 16 * c.wave;
        f32x4 st[2] = {(f32x4){0.f, 0.f, 0.f, 0.f}, (f32x4){0.f, 0.f, 0.f, 0.f}};
        bf16* STb = ST + ((size_t)((b * 4 + h) * 2 + dir) * NCHUNK) * 16384;
        const bf16* kp0 = KZ + (size_t)(d0 + fr) * SP + fq * 8;
#pragma unroll 1
        for (int g0 = 0; g0 < NCHUNK; g0 += GS) {
            const int ns = NCHUNK - g0 < GS ? NCHUNK - g0 : GS;
            bf16x8 kf[GS][4]; u32x4 vst[GS];
#pragma unroll
            for (int s8 = 0; s8 < GS; ++s8) { const int jn = R1_JN(g0 + (s8 < ns ? s8 : 0));
#pragma unroll
                for (int kk = 0; kk < 4; ++kk) kf[s8][kk] = *(const bf16x8*)(kp0 + jn * 128 + kk * 32); }
#pragma unroll
            for (int i = 0; i < GS; ++i) { const int p = c.tid + 512 * i, e = p / (GS * 16), cc = p % (GS * 16), s8 = cc >> 4, u = cc & 15; const int jn = R1_JN(g0 + (s8 < ns ? s8 : 0));
                vst[i] = *(const u32x4*)(VT + (size_t)(eq * 32 + e) * SP + jn * 128 + u * 8); }
            __syncthreads();
#pragma unroll
            for (int i = 0; i < GS; ++i) { const int p = c.tid + 512 * i, e = p / (GS * 16), cc = p % (GS * 16); *(LAS u32x4*)(VS + e * VPITCH + cc * 16) = vst[i]; }
            __syncthreads();
#pragma unroll
            for (int s8 = 0; s8 < GS; ++s8) if (s8 < ns) {
                const int jn = R1_JN(g0 + s8);
#pragma unroll
                for (int eb = 0; eb < 2; ++eb) { u32x2 w; w.x = cvt_pk_bf16(st[eb][0], st[eb][1]); w.y = cvt_pk_bf16(st[eb][2], st[eb][3]);
                    *(u32x2*)(STb + (size_t)jn * 16384 + (eq * 32 + eb * 16 + fr) * 128 + d0 + 4 * fq) = w; }
                f32x4 kv0 = (f32x4){0.f, 0.f, 0.f, 0.f}, kv1 = (f32x4){0.f, 0.f, 0.f, 0.f};
#pragma unroll
                for (int kk = 0; kk < 4; ++kk) { const int off = (s8 * 16 + kk * 4 + fq) * 16;
                    kv0 = MFMA16(kf[s8][kk], *(const LAS bf16x8*)(VS + fr * VPITCH + off), kv0);
                    kv1 = MFMA16(kf[s8][kk], *(const LAS bf16x8*)(VS + (16 + fr) * VPITCH + off), kv1); }
                st[0] = st[0] * decay + kv0; st[1] = st[1] * decay + kv1;
            }
        }
    }
#undef R1_JN
}
__device__ __forceinline__ void ph4_attn(const Args& a, const Ctx& c) {
    const bf16* P = (const bf16*)(a.ws + WS_P); bf16* MIX = (bf16*)(a.ws + WS_MIX);
    for (int task = c.vcu; task < 512 + 32; task += c.G) {
        int b, h, r0, seq;
        if (task < 512) { b = task >> 6; h = (task >> 4) & 3; r0 = b * SP + NCTX + (task & 15) * 256; seq = SP; }
        else { const int t2 = task - 512; b = t2 >> 2; h = t2 & 3; r0 = b * SP; seq = NCTX; }
        const int kvh = h >> 1;
        att::attn_dense_body<128, AB_IN, AB_IN, AB_IN, 1024>(P + (size_t)r0 * AB_IN + h * 128, P + (size_t)b * SP * AB_IN + 512 + kvh * 128, P + (size_t)b * SP * AB_IN + 768 + kvh * 128,
                                                             MIX + (size_t)r0 * 1024 + h * 128, seq, (char*)c.lds);
    }
}

__device__ __forceinline__ bf16x8 scale_frag(bf16x8 f, float s) {
    const u32x4 w = __builtin_bit_cast(u32x4, f); float v[8]; unpack8(w, v);
#pragma unroll
    for (int i = 0; i < 8; ++i) v[i] *= s;
    return __builtin_bit_cast(bf16x8, pack8(v));
}
__device__ __forceinline__ void ph5_r2(const Args& a, const Ctx& c) {
    const bf16* P = (const bf16*)(a.ws + WS_P); bf16* MIX = (bf16*)(a.ws + WS_MIX);
    const bf16* VBT = (const bf16*)(a.ws + WS_VBT); const bf16* ST = (const bf16*)(a.ws + WS_ST);
    const float* ld = a.in[I_ABLD]; const float* gn = a.in[I_ABGN];
    const int fr = c.lane & 15, fq = c.lane >> 4;
    LAS unsigned char* KC = c.lds; LAS unsigned char* VT = c.lds + 32768; LAS unsigned char* SF = c.lds + 65536; LAS unsigned char* SB = c.lds + 98304;
    LAS unsigned char* pl = KC + c.wave * 4096;
    constexpr float L2E = 1.4426950408889634f;
    constexpr int NTASK = NB * 4 * NCHUNK;
    u32x4 stg[16];
#define R2_GLOAD(task_) do { const int _jn = (task_) % NCHUNK, _bh = (task_) / NCHUNK, _b = _bh >> 2, _h = _bh & 3; const int _rb = _b * SP + _jn * 128; \
        _Pragma("unroll") for (int i = 0; i < 16; ++i) { const int q = (c.tid + 512 * i) & 2047, row = q >> 4, c16 = q & 15; const char* src; \
            if (i < 4) src = (const char*)(P + (size_t)(_rb + row) * AB_IN + 1536 + _h * 128) + c16 * 16; \
            else if (i < 8) src = (const char*)(VBT + ((size_t)(_bh * 128 + row)) * SP + _jn * 128) + c16 * 16; \
            else src = (const char*)(ST + ((size_t)(_bh * 2 + (i < 12 ? 0 : 1)) * NCHUNK + _jn) * 16384) + row * 256 + c16 * 16; \
            stg[i] = *(const u32x4*)src; } } while (0)
    for (int task = c.vcu; task < NTASK; task += c.G) {
        const int jn = task % NCHUNK, bh = task / NCHUNK, b = bh >> 2, h = bh & 3;
        const int rowbase = b * SP + jn * 128, c0 = 16 * c.wave;
        const float l2f = log_gamma_of(ld[h]) * L2E, l2b = log_gamma_of(ld[4 + h]) * L2E;
        R2_GLOAD(task);
        const bf16* qp = P + (size_t)(rowbase + c0 + fr) * AB_IN + 1024 + h * 128 + fq * 8;
        bf16x8 qf[4];
#pragma unroll
        for (int kk = 0; kk < 4; ++kk) qf[kk] = *(const bf16x8*)(qp + kk * 32);
        __syncthreads();
#pragma unroll
        for (int i = 0; i < 16; ++i) { const int q = (c.tid + 512 * i) & 2047, row = q >> 4, c16 = q & 15;
            *(LAS u32x4*)(c.lds + (i >> 2) * 32768 + row * 256 + ((c16 ^ (row & 15)) << 4)) = stg[i]; }
        __syncthreads();
#define R2_FRAG(base_, row_, kk_) (*(const LAS bf16x8*)((base_) + (row_) * 256 + ((((kk_) * 4 + fq) ^ ((row_) & 15)) << 4)))
        f32x4 sc[8];
#pragma unroll
        for (int nb = 0; nb < 8; ++nb) { sc[nb] = (f32x4){0.f, 0.f, 0.f, 0.f};
#pragma unroll
            for (int kk = 0; kk < 4; ++kk) sc[nb] = MFMA16(qf[kk], R2_FRAG(KC, nb * 16 + fr, kk), sc[nb]); }
        __syncthreads();
        bf16 gt[4][8];
#pragma unroll
        for (int i = 0; i < 4; ++i)
#pragma unroll
            for (int eb = 0; eb < 8; ++eb) gt[i][eb] = P[(size_t)(rowbase + c0 + fq * 4 + i) * AB_IN + 2560 + h * 128 + eb * 16 + fr];
#pragma unroll
        for (int nb = 0; nb < 8; ++nb)
#pragma unroll
            for (int i = 0; i < 4; ++i) { const int r = fq * 4 + i, cc = c0 + r, ss = nb * 16 + fr, diff = cc - ss;
                const float f = diff >= 0 ? __builtin_amdgcn_exp2f(l2f * (float)diff) : __builtin_amdgcn_exp2f(l2b * (float)(-diff));
                *(LAS bf16*)(pl + r * 256 + (((ss >> 3) ^ r) << 4) + (ss & 7) * 2) = f2bf(sc[nb][i] * f); }
        LDS_WAIT();
        bf16x8 pf[4];
#pragma unroll
        for (int kk = 0; kk < 4; ++kk) pf[kk] = R2_FRAG(pl, fr, kk);
        f32x4 o[8];
#pragma unroll
        for (int eb = 0; eb < 8; ++eb) { o[eb] = (f32x4){0.f, 0.f, 0.f, 0.f};
#pragma unroll
            for (int kk = 0; kk < 4; ++kk) o[eb] = MFMA16(pf[kk], R2_FRAG(VT, eb * 16 + fr, kk), o[eb]); }
        const float xf = __builtin_amdgcn_exp2f(l2f * (float)(c0 + fr + 1)), xb = __builtin_amdgcn_exp2f(l2b * (float)(128 - (c0 + fr)));
        {   bf16x8 qF[4];
#pragma unroll
            for (int kk = 0; kk < 4; ++kk) qF[kk] = scale_frag(qf[kk], xf);
#pragma unroll
            for (int eb = 0; eb < 8; ++eb)
#pragma unroll
                for (int kk = 0; kk < 4; ++kk) o[eb] = MFMA16(qF[kk], R2_FRAG(SF, eb * 16 + fr, kk), o[eb]); }
        {   bf16x8 qB[4];
#pragma unroll
            for (int kk = 0; kk < 4; ++kk) qB[kk] = scale_frag(qf[kk], xb);
#pragma unroll
            for (int eb = 0; eb < 8; ++eb)
#pragma unroll
                for (int kk = 0; kk < 4; ++kk) o[eb] = MFMA16(qB[kk], R2_FRAG(SB, eb * 16 + fr, kk), o[eb]); }
#pragma unroll
        for (int i = 0; i < 4; ++i) {
            float s1 = 0.f;
#pragma unroll
            for (int eb = 0; eb < 8; ++eb) s1 += o[eb][i];
            s1 += __shfl_xor(s1, 1); s1 += __shfl_xor(s1, 2); s1 += __shfl_xor(s1, 4); s1 += __shfl_xor(s1, 8);
            const float mean = s1 * (1.f / 128.f); float s2 = 0.f;
#pragma unroll
            for (int eb = 0; eb < 8; ++eb) { const float dlt = o[eb][i] - mean; s2 += dlt * dlt; }
            s2 += __shfl_xor(s2, 1); s2 += __shfl_xor(s2, 2); s2 += __shfl_xor(s2, 4); s2 += __shfl_xor(s2, 8);
            const float rstd = rsqrtf(s2 * (1.f / 128.f) + 1e-5f);
            const int row = rowbase + c0 + fq * 4 + i;
#pragma unroll
            for (int eb = 0; eb < 8; ++eb) { const int e = eb * 16 + fr; const float g = bf2f(gt[i][eb]);
                const float y = (o[eb][i] - mean) * rstd * gn[h * 128 + e] * (g / (1.f + __expf(-g)));
                MIX[(size_t)row * 1024 + 512 + h * 128 + e] = f2bf(y); }
        }
    }
#undef R2_GLOAD
#undef R2_FRAG
}
__device__ __forceinline__ void moe_setup_tiles(const Args& a, const Ctx& c, int L) {
    LAS int* misc = (LAS int*)(c.lds + MISC_OFF);
    const unsigned* cur = (const unsigned*)(a.ws + WS_CTL) + CW_CNT + 64 * L;
    __syncthreads();
    if (c.tid < 32) misc[64 + c.tid] = (int)__hip_atomic_load(cur + c.tid, __ATOMIC_RELAXED, __HIP_MEMORY_SCOPE_AGENT);
    __syncthreads();
    if (c.tid == 0) { int acc = 0; for (int e = 0; e < NE; ++e) { misc[e] = acc; acc += (misc[64 + e] + 255) >> 8; } misc[NE] = acc; }
    __syncthreads();
    {   LAS unsigned char* tmap = (LAS unsigned char*)(c.lds + TMAP_OFF);
        for (int t = c.tid; t < misc[NE]; t += 512) { int e = 0; while (misc[e + 1] <= t) ++e; tmap[t] = (unsigned char)e; } }
    __syncthreads();
}
template <bool GATHER_> struct MoeOrder {
    static constexpr bool GATHER = GATHER_;
    const LAS int* misc; const int* ltok; int nN, G, c, total;
    __device__ void init(const LAS int* misc_, const int* ltok_, int nN_, int G_, int c_) { misc = misc_; ltok = ltok_; nN = nN_; G = G_; c = c_; total = misc_[NE] * nN_; }
    __device__ bool next(int i, pg8::Unit& u) const {
        const int L0 = i * G + c; if (L0 >= total) return false;
        int L = L0;
#ifndef NO_MOE_XCD
        if ((G & 7) == 0) { const int q = total >> 3, r = total & 7, xcd = L0 & 7, off = L0 >> 3; L = (xcd < r ? xcd * (q + 1) : r * (q + 1) + (xcd - r) * q) + off; }
#endif
        const int mt = L / nN, nt = L % nN; const int e = ((const LAS unsigned char*)misc)[TMAP_OFF - MISC_OFF + mt];
        u.pm = mt; u.pn = nt; u.pb = e * nN + nt; u.e = e; return true;
    }
    __device__ __forceinline__ unsigned arow(const pg8::Unit& u, int r) const {
        int local = (u.pm - misc[u.e]) * 256 + r; if (local >= misc[64 + u.e]) local = 0;
        return (unsigned)ltok[(size_t)u.e * CAP + local];
    }
};
__device__ __forceinline__ float swiglu(float g, float l) {
    g = fminf(g, 7.0f); l = fminf(fmaxf(l, -7.0f), 7.0f);
    return g * __builtin_amdgcn_rcpf(1.f + __builtin_amdgcn_exp2f(-1.702f * 1.4426950408889634f * g)) * (l + 1.0f);
}
template <int XV = 0> struct EpiMoeUpT {
    static constexpr bool PERM = true;
    bf16* ACT; const float* bup  ;
    __device__ __forceinline__ void operator()(const f32x4 (&acc)[2][2][4][2], const pg8::Unit& u, int wr, int wc, int fr, int fq) const {
        const int col0 = u.pn * 128 + wc * 32 + 8 * fq; const float* bb = bup + (size_t)u.e * 2048 + col0;
        f32x4 bg[2], bl[2];
#pragma unroll
        for (int n = 0; n < 2; ++n) { bg[n] = *(const f32x4*)(bb + 4 * n); bl[n] = *(const f32x4*)(bb + 1024 + 4 * n); }
        const unsigned rb = ((unsigned)(u.pm * 256 + wr * 64 + fr) * 1024u + (unsigned)col0) * 2u;
#pragma unroll
        for (int ai = 0; ai < 2; ++ai)
#pragma unroll
            for (int m = 0; m < 4; ++m) { float v[8];
#pragma unroll
                for (int n = 0; n < 2; ++n)
#pragma unroll
                    for (int k = 0; k < 4; ++k) v[4 * n + k] = (XV == 2) ? acc[ai][0][m][n][k] + acc[ai][1][m][n][k] + bg[n][k] : swiglu(acc[ai][0][m][n][k] + bg[n][k], acc[ai][1][m][n][k] + bl[n][k]);
                if (XV == 3) __builtin_nontemporal_store(pack8(v), (u32x4*)((char*)ACT + (rb + (unsigned)((ai * 128 + m * 16) * 1024) * 2u)));
                else if (XV == 0 || v[0] == 12345.678f) st16(ACT, rb + (unsigned)((ai * 128 + m * 16) * 1024) * 2u, pack8(v)); }
    }
};
typedef EpiMoeUpT<0> EpiMoeUp;
template <int XV = 0> struct EpiMoeDownT {
    static constexpr bool PERM = true;
    bf16* YK; const float* bdn  ; const float* lgate; const LAS int* misc;
    __device__ __forceinline__ void operator()(const f32x4 (&acc)[2][2][4][2], const pg8::Unit& u, int wr, int wc, int fr, int fq) const {
        const int col0 = u.pn * 256 + wc * 32 + 8 * fq; const float* bb = bdn + (size_t)u.e * 1024 + col0;
        f32x4 bv[2][2];
#pragma unroll
        for (int bj = 0; bj < 2; ++bj)
#pragma unroll
            for (int n = 0; n < 2; ++n) bv[bj][n] = *(const f32x4*)(bb + bj * 128 + 4 * n);
        const int lbase = (u.pm - misc[u.e]) * 256 + wr * 64 + fr, cnt = misc[64 + u.e];
        const float* gp = lgate + (size_t)u.e * CAP;
        const unsigned rb = ((unsigned)(u.pm * 256 + wr * 64 + fr) * 1024u + (unsigned)col0) * 2u;
#pragma unroll
        for (int ai = 0; ai < 2; ++ai)
#pragma unroll
            for (int m = 0; m < 4; ++m) { const int local = lbase + ai * 128 + m * 16;
                const float g = (XV == 1 || XV == 3) ? 1.0f : (local < cnt ? *(const float*)((const char*)gp + (unsigned)local * 4u) : 0.f);
                const unsigned ro = rb + (unsigned)((ai * 128 + m * 16) * 1024) * 2u;
#pragma unroll
                for (int bj = 0; bj < 2; ++bj) { const u32x4 pk = pack2x4((acc[ai][bj][m][0] + bv[bj][0]) * g, (acc[ai][bj][m][1] + bv[bj][1]) * g); if (XV == 4) st16((char*)YK - (WS_YK - WS_P), (ro + bj * 256) & 0xFFFFFu, pk); else if (XV == 5) st16((char*)YK - (WS_YK - WS_P), ro + bj * 256, pk); else if (XV == 0 || pk.x == 0x12345678u) st16(YK, ro + bj * 256, pk); } }
    }
};
typedef EpiMoeDownT<0> EpiMoeDown;

template <int L> __device__ __forceinline__ void ph_ln1_router(const Args& a, const Ctx& c) {
    constexpr int NROWS = (L == 0) ? R : NB * SEQ;
    constexpr int HTS = 2064;
    const bf16* ACC = (const bf16*)(a.ws + WS_ACC); bf16* H = (bf16*)(a.ws + WS_H); bf16* X1 = (bf16*)(a.ws + WS_MIX);
    const float* mods = (const float*)(a.ws + WS_MODS) + (size_t)L * 9 * 6144;
    const float* g1 = a.in[I_LN1G] + L * D; const float* b1 = a.in[I_LN1B] + L * D;
    const float* Wr = a.in[I_RW] + (size_t)L * D * NE; const float* rb = a.in[I_RB] + L * NE;
    int* LTOK = (int*)(a.ws + WS_LTOK); float* LGATE = (float*)(a.ws + WS_LGATE); int* TOKSLOT = (int*)(a.ws + WS_TOKSLOT);
    unsigned* cur = (unsigned*)(a.ws + WS_CTL) + CW_CNT + 64 * L;
    LAS unsigned char* HT = c.lds;
    LAS float* PART = (LAS float*)(c.lds + 66560);
    LAS float* LOG = (LAS float*)(c.lds + 82944);
    LAS int* rec = (LAS int*)(c.lds + 86016);
    LAS float* recg = (LAS float*)(c.lds + 86016 + 6144);
    LAS int* recrow = (LAS int*)(c.lds + 86016 + 12288);
    LAS int* misc = (LAS int*)(c.lds + MISC_OFF);
    const int fr = c.lane & 15, fq = c.lane >> 4;
    bf16x8 whi[2][4], wlo[2][4];
#pragma unroll
    for (int nb = 0; nb < 2; ++nb)
#pragma unroll
        for (int ks = 0; ks < 4; ++ks) { float wv[8], wl[8];
#pragma unroll
            for (int j = 0; j < 8; ++j) wv[j] = Wr[(size_t)(128 * c.wave + 32 * ks + 8 * fq + j) * NE + nb * 16 + fr];
            const u32x4 hi = pack8(wv); float hf[8]; unpack8(hi, hf);
#pragma unroll
            for (int j = 0; j < 8; ++j) wl[j] = wv[j] - hf[j];
            whi[nb][ks] = __builtin_bit_cast(bf16x8, hi); wlo[nb][ks] = __builtin_bit_cast(bf16x8, pack8(wl)); }
    if (c.tid < 32) misc[128 + c.tid] = 0;
    __syncthreads();
    const int nqb = (NROWS - (int)blockIdx.x + c.G - 1) / c.G;
#define LN1_ROW(q_, row_, b_, isc_) do { const int _rl = blockIdx.x + c.G * (q_); if constexpr (L == 0) { row_ = _rl; b_ = row_ / SP; isc_ = (row_ % SP) < NCTX; } \
        else { b_ = _rl / SEQ; row_ = b_ * SP + NCTX + (_rl % SEQ); isc_ = 0; } } while (0)
    u32x2 vn[2][4];
#pragma unroll
    for (int rr = 0; rr < 2; ++rr) { const int q = 2 * c.wave + rr; if (q < nqb) { int row, b, isc; LN1_ROW(q, row, b, isc); (void)b; (void)isc;
#pragma unroll
        for (int j = 0; j < 4; ++j) vn[rr][j] = *(const u32x2*)(ACC + (size_t)row * D + 4 * c.lane + 256 * j); } }
    for (int s0 = 0; s0 < nqb; s0 += 16) {
#pragma unroll
        for (int rr = 0; rr < 2; ++rr) {
            const int slot = 2 * c.wave + rr, q = s0 + slot;
            if (q < nqb) {
                int row, b, isc; LN1_ROW(q, row, b, isc);
                const float* m = mods + (size_t)(isc ? 8 : b) * 6144;
                f32x4 v[4]; float s = 0.f;
#pragma unroll
                for (int j = 0; j < 4; ++j) { const u32x2 w = vn[rr][j]; v[j] = (f32x4){bflo(w.x), bfhi(w.x), bflo(w.y), bfhi(w.y)}; s += (v[j][0] + v[j][1]) + (v[j][2] + v[j][3]); }
                const float mean = wave_sum(s) * (1.f / D); float s2 = 0.f;
#pragma unroll
                for (int j = 0; j < 4; ++j) { v[j] = v[j] - mean; s2 += (v[j][0] * v[j][0] + v[j][1] * v[j][1]) + (v[j][2] * v[j][2] + v[j][3] * v[j][3]); }
                const float rstd = rsqrtf(wave_sum(s2) * (1.f / D) + 1e-5f);
#pragma unroll
                for (int j = 0; j < 4; ++j) { const int col = 4 * c.lane + 256 * j;
                    const f32x4 x1 = v[j] * rstd * *(const f32x4*)(g1 + col) + *(const f32x4*)(b1 + col);
                    { u32x2 xo; xo.x = cvt_pk_bf16(x1[0], x1[1]); xo.y = cvt_pk_bf16(x1[2], x1[3]); *(u32x2*)(X1 + (size_t)row * D + col) = xo; }
                    const f32x4 hv = x1 * (*(const f32x4*)(m + 4 * 1024 + col) + 1.0f) + *(const f32x4*)(m + 3 * 1024 + col);
                    u32x2 o; o.x = cvt_pk_bf16(hv[0], hv[1]); o.y = cvt_pk_bf16(hv[2], hv[3]); *(u32x2*)(H + (size_t)row * D + col) = o;
                    u32x2 lo; lo.x = cvt_pk_bf16(hv[0] - bflo(o.x), hv[1] - bfhi(o.x)); lo.y = cvt_pk_bf16(hv[2] - bflo(o.y), hv[3] - bfhi(o.y));
                    *(LAS u32x2*)(HT + slot * HTS + col * 2) = o; *(LAS u32x2*)(HT + 16 * HTS + slot * HTS + col * 2) = lo; }
                if (c.lane == 0) recrow[q] = row;
            }
        }
        __syncthreads();
#pragma unroll
        for (int rr = 0; rr < 2; ++rr) { const int q = s0 + 16 + 2 * c.wave + rr; if (q < nqb) { int row, b, isc; LN1_ROW(q, row, b, isc); (void)b; (void)isc;
#pragma unroll
            for (int j = 0; j < 4; ++j) vn[rr][j] = *(const u32x2*)(ACC + (size_t)row * D + 4 * c.lane + 256 * j); } }
        {   f32x4 acc[2] = {(f32x4){0.f, 0.f, 0.f, 0.f}, (f32x4){0.f, 0.f, 0.f, 0.f}};
#pragma unroll
            for (int ks = 0; ks < 4; ++ks) { const int off = fr * HTS + (128 * c.wave + 32 * ks + 8 * fq) * 2;
                const bf16x8 ah = *(const LAS bf16x8*)(HT + off), al = *(const LAS bf16x8*)(HT + 16 * HTS + off);
#pragma unroll
                for (int nb = 0; nb < 2; ++nb) { acc[nb] = MFMA16(ah, whi[nb][ks], acc[nb]); acc[nb] = MFMA16(ah, wlo[nb][ks], acc[nb]); acc[nb] = MFMA16(al, whi[nb][ks], acc[nb]); } }
#pragma unroll
            for (int nb = 0; nb < 2; ++nb)
#pragma unroll
                for (int i = 0; i < 4; ++i) PART[(c.wave * 16 + 4 * fq + i) * 32 + nb * 16 + fr] = acc[nb][i]; }
        __syncthreads();
        {   const int slot = c.tid >> 5, e = c.tid & 31; float sum = rb[e];
#pragma unroll
            for (int w8 = 0; w8 < 8; ++w8) sum += PART[(w8 * 16 + slot) * 32 + e];
            LOG[slot * 33 + e] = sum; }
        __syncthreads();
        if (c.tid < 16 && s0 + c.tid < nqb) {
            const int q = s0 + c.tid; float lg[NE];
#pragma unroll
            for (int e = 0; e < NE; ++e) lg[e] = LOG[c.tid * 33 + e];
            int te[4]; float tv[4];
#pragma unroll
            for (int k = 0; k < 4; ++k) { float best = -3.0e38f; int bi = 0;
#pragma unroll
                for (int e = 0; e < NE; ++e) { const bool better = lg[e] > best; best = better ? lg[e] : best; bi = better ? e : bi; }
                te[k] = bi; tv[k] = best;
#pragma unroll
                for (int e = 0; e < NE; ++e) lg[e] = (e == bi) ? -3.0e38f : lg[e]; }
            float ex[4], es = 0.f;
#pragma unroll
            for (int k = 0; k < 4; ++k) { ex[k] = expf(tv[k] - tv[0]); es += ex[k]; }
#pragma unroll
            for (int k = 0; k < 4; ++k) { const int lpos = atomicAdd((int*)&misc[128 + te[k]], 1); rec[q * 4 + k] = (te[k] << 20) | lpos; recg[q * 4 + k] = ex[k] / es; }
        }
    }
    __syncthreads();
    if (c.tid < 32) { const int n = misc[128 + c.tid]; misc[160 + c.tid] = n ? (int)__hip_atomic_fetch_add(cur + c.tid, (unsigned)n, __ATOMIC_RELAXED, __HIP_MEMORY_SCOPE_AGENT) : 0; }
    __syncthreads();
    for (int i = c.tid; i < nqb * 4; i += 512) { const int q = i >> 2, rc = rec[i], e = rc >> 20, pos = misc[160 + e] + (rc & 0xfffff); const int row = recrow[q];
        LTOK[(size_t)e * CAP + pos] = row; LGATE[(size_t)e * CAP + pos] = recg[i]; TOKSLOT[row * 4 + (i & 3)] = (e << 24) | pos; }
#undef LN1_ROW
}

template <int L> __device__ __forceinline__ void ph_ln2(const Args& a, const Ctx& c) {
    constexpr int NROWS = (L == 0) ? R : NB * SEQ;
    const bf16* X1 = (const bf16*)(a.ws + WS_MIX); const bf16* YK = (const bf16*)(a.ws + WS_YK); const int* TOKSLOT = (const int*)(a.ws + WS_TOKSLOT);
    const float* mods = (const float*)(a.ws + WS_MODS) + (size_t)L * 9 * 6144;
    const float* g2 = a.in[I_LN2G] + L * D; const float* b2 = a.in[I_LN2B] + L * D;
    LAS int* misc = (LAS int*)(c.lds + MISC_OFF);
    moe_setup_tiles(a, c, L);
#define LN2_ROW(rl_, row_, b_, isc_, t_) do { if constexpr (L == 0) { row_ = (rl_); b_ = row_ / SP; isc_ = (row_ % SP) < NCTX; t_ = 0; } else { b_ = (rl_) / SEQ; t_ = (rl_) % SEQ; row_ = b_ * SP + NCTX + t_; isc_ = 0; } } while (0)
    int tsn[4] = {0, 0, 0, 0}; u32x2 an[4]; u32x2 yn[4][4];
#define LN2_TS(rl_) do { int _row, _b, _isc, _t; LN2_ROW(rl_, _row, _b, _isc, _t); (void)_b; (void)_isc; (void)_t; _Pragma("unroll") for (int k = 0; k < 4; ++k) tsn[k] = TOKSLOT[_row * 4 + k]; } while (0)
#define LN2_DATA(rl_) do { int _row, _b, _isc, _t; LN2_ROW(rl_, _row, _b, _isc, _t); (void)_b; (void)_isc; (void)_t; \
        _Pragma("unroll") for (int k = 0; k < 4; ++k) { const int e = tsn[k] >> 24, pos = tsn[k] & 0xffffff; const bf16* yk = YK + ((size_t)misc[e] * 256 + pos) * 1024; \
            _Pragma("unroll") for (int j = 0; j < 4; ++j) yn[k][j] = *(const u32x2*)(yk + 4 * c.lane + 256 * j); } \
        _Pragma("unroll") for (int j = 0; j < 4; ++j) an[j] = *(const u32x2*)(X1 + (size_t)_row * D + 4 * c.lane + 256 * j); } while (0)
    if (c.gw < NROWS) { LN2_TS(c.gw); LN2_DATA(c.gw); if (c.gw + c.NGW < NROWS) LN2_TS(c.gw + c.NGW); }
    for (int rl = c.gw; rl < NROWS; rl += c.NGW) {
        int row, b, isc, t; LN2_ROW(rl, row, b, isc, t);
        const float* m = mods + (size_t)(isc ? 8 : b) * 6144;
        f32x4 v[4]; float s = 0.f;
#pragma unroll
        for (int j = 0; j < 4; ++j) { const int col = 4 * c.lane + 256 * j; f32x4 fl = (f32x4){0.f, 0.f, 0.f, 0.f};
#pragma unroll
            for (int k = 0; k < 4; ++k) { const u32x2 w = yn[k][j]; fl[0] += bflo(w.x); fl[1] += bfhi(w.x); fl[2] += bflo(w.y); fl[3] += bfhi(w.y); }
            const f32x4 x1v = (f32x4){bflo(an[j].x), bfhi(an[j].x), bflo(an[j].y), bfhi(an[j].y)};
            v[j] = x1v * DN_ALPHA + *(const f32x4*)(m + 5 * 1024 + col) * fl;
            s += (v[j][0] + v[j][1]) + (v[j][2] + v[j][3]); }
        if (rl + c.NGW < NROWS) { LN2_DATA(rl + c.NGW); if (rl + 2 * c.NGW < NROWS) LN2_TS(rl + 2 * c.NGW); }
        const float mean = wave_sum(s) * (1.f / D); float s2 = 0.f;
#pragma unroll
        for (int j = 0; j < 4; ++j) { v[j] = v[j] - mean; s2 += (v[j][0] * v[j][0] + v[j][1] * v[j][1]) + (v[j][2] * v[j][2] + v[j][3] * v[j][3]); }
        const float rstd = rsqrtf(wave_sum(s2) * (1.f / D) + 1e-5f);
#pragma unroll
        for (int j = 0; j < 4; ++j) { const int col = 4 * c.lane + 256 * j;
            const f32x4 x2 = v[j] * rstd * *(const f32x4*)(g2 + col) + *(const f32x4*)(b2 + col);
            if constexpr (L == 0) {
                { u32x2 xo; xo.x = cvt_pk_bf16(x2[0], x2[1]); xo.y = cvt_pk_bf16(x2[2], x2[3]); *(u32x2*)((bf16*)(a.ws + WS_X) + (size_t)row * D + col) = xo; }
                const float* mn = m + 9 * 6144;
                const f32x4 h = x2 * (*(const f32x4*)(mn + 1024 + col) + 1.0f) + *(const f32x4*)(mn + col);
                u32x2 o; o.x = cvt_pk_bf16(h[0], h[1]); o.y = cvt_pk_bf16(h[2], h[3]); *(u32x2*)((bf16*)(a.ws + WS_H) + (size_t)row * D + col) = o;
            } else {
#ifdef PROBE_K
                { const unsigned long long* TS = (const unsigned long long*)(a.ws + WS_CTL + 524288); const unsigned long long dt = (TS[PROBE_END] - TS[PROBE_K]) & ~1023ull;
                  const float fac = 1.f + sqrtf((float)dt * 1e-9f); *(f32x4*)(a.out + ((size_t)b * SEQ + t) * D + col) = x2 * fac; }
#else
                *(f32x4*)(a.out + ((size_t)b * SEQ + t) * D + col) = x2;
#endif
            } }
    }
#undef LN2_ROW
#undef LN2_TS
#undef LN2_DATA
}
__device__ __forceinline__ void ph12_mla_post(const Args& a, const Ctx& c) {
    const bf16* PM = (const bf16*)(a.ws + WS_PM); bf16* CQ = (bf16*)(a.ws + WS_CQ); bf16* CKV = (bf16*)(a.ws + WS_CKV); bf16* KM = (bf16*)(a.ws + WS_KM);
    const float* qn = a.in[I_MLAQN]; const float* kvn = a.in[I_MLAKVN];
    const float2* A64 = (const float2*)(a.ws + WS_TAB_A64);
    const int lane = c.lane;
    u32x4 n0 = (u32x4){0u, 0u, 0u, 0u}, n1 = (u32x4){0u, 0u, 0u, 0u};
    if (c.gw < R) { const bf16* pr = PM + (size_t)c.gw * MLA_IN_P; n0 = *(const u32x4*)(pr + lane * 8); if (lane < 32) n1 = *(const u32x4*)(pr + 512 + lane * 8); }
    for (int row = c.gw; row < R; row += c.NGW) {
        const int s = row % SP; const bool lat = s >= NCTX;
        const u32x4 w0 = n0, w1 = n1;
        if (row + c.NGW < R) { const bf16* pr = PM + (size_t)(row + c.NGW) * MLA_IN_P; n0 = *(const u32x4*)(pr + lane * 8); if (lane < 32) n1 = *(const u32x4*)(pr + 512 + lane * 8); }
        float v0[8], v1[8];
        unpack8(w0, v0);
        if (lane < 32) unpack8(w1, v1);
        else {
#pragma unroll
            for (int i = 0; i < 8; ++i) v1[i] = 0.f; }
        float sq = 0.f, sk = 0.f, t0 = 0.f, t1 = 0.f;
#pragma unroll
        for (int i = 0; i < 8; ++i) { t0 += v0[i] * v0[i]; t1 += v1[i] * v1[i]; }
        if (lane < 48) sq = t0; else sk = t0;
        if (lane < 16) sk += t1;
        sq = wave_sum(sq); sk = wave_sum(sk);
        const float rq = rsqrtf(sq * (1.f / MLA_QL) + 1e-6f), rk = rsqrtf(sk * (1.f / MLA_KVL) + 1e-6f);
        float o[8];
        if (lane < 48) {
#pragma unroll
            for (int i = 0; i < 8; ++i) o[i] = v0[i] * rq * qn[lane * 8 + i];
            *(u32x4*)(CQ + (size_t)row * MLA_QL + lane * 8) = pack8(o);
        } else {
#pragma unroll
            for (int i = 0; i < 8; ++i) o[i] = v0[i] * rk * kvn[(lane - 48) * 8 + i];
            *(u32x4*)(CKV + (size_t)row * MLA_KVL + (lane - 48) * 8) = pack8(o);
        }
        if (lane < 16) {
#pragma unroll
            for (int i = 0; i < 8; ++i) o[i] = v1[i] * rk * kvn[128 + lane * 8 + i];
            *(u32x4*)(CKV + (size_t)row * MLA_KVL + 128 + lane * 8) = pack8(o);
        }
        float pr8[8];
#pragma unroll
        for (int i = 0; i < 8; ++i) pr8[i] = __shfl_xor(v1[i], 2);
        if (lane >= 16 && lane < 24) {
            if (lat) { const int t = s - NCTX, pos = lane < 20 ? t / GRID_W : t % GRID_W; const float2* cs = A64 + pos * 16 + (lane & 1) * 8; const bool second = (lane & 2) != 0;
#pragma unroll
                for (int i = 0; i < 8; ++i) { const float2 q = cs[i]; o[i] = second ? (pr8[i] * q.y + v1[i] * q.x) : (v1[i] * q.x - pr8[i] * q.y); } }
            else {
#pragma unroll
                for (int i = 0; i < 8; ++i) o[i] = v1[i]; }
            const u32x4 w = pack8(o);
#pragma unroll
            for (int h = 0; h < 8; ++h) *(u32x4*)(KM + (size_t)row * UQ_N + h * 192 + 128 + (lane - 16) * 8) = w;
        }
    }
}
struct EpiMlaIn {
    static constexpr bool PERM = true;
    bf16* PM; float* SS; bf16* KM; const float2* A64;
    __device__ __forceinline__ void operator()(const f32x4 (&acc)[2][2][4][2], const pg8::Unit& u, int wr, int wc, int fr, int fq) const {
        const int row0 = u.pm * 256 + wr * 64 + fr;
        const unsigned rb = ((unsigned)row0 * MLA_IN_P + (unsigned)(u.pn * 256 + wc * 32 + 8 * fq)) * 2u;
#pragma unroll
        for (int ai = 0; ai < 2; ++ai)
#pragma unroll
            for (int m = 0; m < 4; ++m) { const unsigned ro = rb + (unsigned)((ai * 128 + m * 16) * MLA_IN_P) * 2u; const int row = row0 + ai * 128 + m * 16;
#pragma unroll
                for (int bj = 0; bj < 2; ++bj) { st16(PM, ro + bj * 256, pack2x4(acc[ai][bj][m][0], acc[ai][bj][m][1]));
                    if (u.pn != 1 || bj == 0) {
                        const f32x4 x0 = acc[ai][bj][m][0], x1 = acc[ai][bj][m][1];
                        float sq = (x0[0] * x0[0] + x0[1] * x0[1]) + (x0[2] * x0[2] + x0[3] * x0[3]) + (x1[0] * x1[0] + x1[1] * x1[1]) + (x1[2] * x1[2] + x1[3] * x1[3]);
                        sq += __shfl_xor(sq, 16); sq += __shfl_xor(sq, 32);
                        const int slot = (u.pn == 0 ? 0 : (u.pn == 1 ? 8 : 12)) + bj * 4 + wc;
                        if (fq == 0) SS[(size_t)row * 20 + slot] = sq; } }
                if (u.pn == 1 && wc < 2) {
                    const int s = row % SP; const f32x4 x1 = acc[ai][1][m][0], x2 = acc[ai][1][m][1]; f32x4 o1 = x1, o2 = x2;
                    if (s >= NCTX) { const int t = s - NCTX, pos = wc == 0 ? t / GRID_W : t % GRID_W; const float* cs = (const float*)(A64 + pos * 16 + 4 * fq);
                        const f32x4 ca = *(const f32x4*)cs, cb = *(const f32x4*)(cs + 4);
                        o1 = (f32x4){x1[0] * ca[0] - x2[0] * ca[1], x1[1] * ca[2] - x2[1] * ca[3], x1[2] * cb[0] - x2[2] * cb[1], x1[3] * cb[2] - x2[3] * cb[3]};
                        o2 = (f32x4){x1[0] * ca[1] + x2[0] * ca[0], x1[1] * ca[3] + x2[1] * ca[2], x1[2] * cb[1] + x2[2] * cb[0], x1[3] * cb[3] + x2[3] * cb[2]}; }
                    u32x2 w1, w2; w1.x = cvt_pk_bf16(o1[0], o1[1]); w1.y = cvt_pk_bf16(o1[2], o1[3]); w2.x = cvt_pk_bf16(o2[0], o2[1]); w2.y = cvt_pk_bf16(o2[2], o2[3]);
                    const unsigned kb = ((unsigned)row * UQ_N + (unsigned)(128 + 32 * wc + 4 * fq)) * 2u;
#pragma unroll
                    for (int h = 0; h < 8; ++h) { st8(KM, kb + h * 384, w1); st8(KM, kb + h * 384 + 32, w2); } }
            }
    }
};
struct LatOrder {
    pg8::StaticOrder S; static constexpr bool GATHER = false;
    __device__ void init(int nN, int G, int c) { S.init(NB * 16, nN, G, c); }
    __device__ bool next(int i, pg8::Unit& u) const { if (!S.next(i, u)) return false; u.pm = (u.pm >> 4) * 17 + 1 + (u.pm & 15); return true; }
    __device__ __forceinline__ unsigned arow(const pg8::Unit&, int) const { return 0u; }
};
struct EpiUq {
    static constexpr bool PERM = true;
    bf16* QM; const float2* A64; const float* SS;
    __device__ __forceinline__ void operator()(const f32x4 (&acc)[2][2][4][2], const pg8::Unit& u, int wr, int wc, int fr, int fq) const {
        constexpr float SC0 = 0.07216878364870322f;
        const int row0 = u.pm * 256 + wr * 64 + fr;
        float rs[2][4];
#pragma unroll
        for (int ai = 0; ai < 2; ++ai)
#pragma unroll
            for (int m = 0; m < 4; ++m) { const float* sp = SS + (size_t)(row0 + ai * 128 + m * 16) * 20; const f32x4 a0 = *(const f32x4*)sp, a1 = *(const f32x4*)(sp + 4), a2 = *(const f32x4*)(sp + 8);
                const float ssq = ((a0[0] + a0[1]) + (a0[2] + a0[3])) + ((a1[0] + a1[1]) + (a1[2] + a1[3])) + ((a2[0] + a2[1]) + (a2[2] + a2[3]));
                rs[ai][m] = SC0 * rsqrtf(ssq * (1.f / MLA_QL) + 1e-6f); }
        if (u.pn < 4) {
            const unsigned rb = ((unsigned)row0 * UQ_N + (unsigned)(2 * u.pn * 192 + wc * 32 + 8 * fq)) * 2u;
#pragma unroll
            for (int ai = 0; ai < 2; ++ai)
#pragma unroll
                for (int m = 0; m < 4; ++m) { const unsigned ro = rb + (unsigned)((ai * 128 + m * 16) * UQ_N) * 2u;
#pragma unroll
                    for (int bj = 0; bj < 2; ++bj) st16(QM, ro + bj * 384, pack2x4(acc[ai][bj][m][0] * rs[ai][m], acc[ai][bj][m][1] * rs[ai][m])); }
        } else {
            const int head = 4 * (u.pn - 4) + wc, j0 = 8 * fq;
            const int d1 = j0 < 16 ? j0 : 16 + j0;
            const unsigned rb = ((unsigned)row0 * UQ_N + (unsigned)(head * 192 + 128 + d1)) * 2u;
            const int t0 = row0 % SP - NCTX;
#pragma unroll
            for (int ai = 0; ai < 2; ++ai)
#pragma unroll
                for (int m = 0; m < 4; ++m) { const int t = t0 + ai * 128 + m * 16;
                    const int pos = j0 < 16 ? t / GRID_W : t % GRID_W; const unsigned co = (unsigned)(pos * 16 + (j0 & 15)) * 8u;
                    const unsigned ro = rb + (unsigned)((ai * 128 + m * 16) * UQ_N) * 2u; const float SC = rs[ai][m];
#pragma unroll
                    for (int n = 0; n < 2; ++n) { const f32x4 ca = *(const f32x4*)((const char*)A64 + co + 32 * n), cb = *(const f32x4*)((const char*)A64 + co + 32 * n + 16);
                        const f32x4 x1 = acc[ai][0][m][n], x2 = acc[ai][1][m][n];
                        u32x2 w1, w2;
                        w1.x = cvt_pk_bf16((x1[0] * ca[0] - x2[0] * ca[1]) * SC, (x1[1] * ca[2] - x2[1] * ca[3]) * SC);
                        w1.y = cvt_pk_bf16((x1[2] * cb[0] - x2[2] * cb[1]) * SC, (x1[3] * cb[2] - x2[3] * cb[3]) * SC);
                        w2.x = cvt_pk_bf16((x1[0] * ca[1] + x2[0] * ca[0]) * SC, (x1[1] * ca[3] + x2[1] * ca[2]) * SC);
                        w2.y = cvt_pk_bf16((x1[2] * cb[1] + x2[2] * cb[0]) * SC, (x1[3] * cb[3] + x2[3] * cb[2]) * SC);
                        st8(QM, ro + 8 * n, w1); st8(QM, ro + 32 + 8 * n, w2); } }
        }
    }
};
struct EpiUkv {
    static constexpr bool PERM = true;
    bf16* KM; bf16* VM; const float* SS;
    __device__ __forceinline__ void operator()(const f32x4 (&acc)[2][2][4][2], const pg8::Unit& u, int wr, int wc, int fr, int fq) const {
        const unsigned row0 = (unsigned)(u.pm * 256 + wr * 64 + fr), cw = (unsigned)(wc * 32 + 8 * fq);
        const unsigned kb = (row0 * UQ_N + (unsigned)u.pn * 192 + cw) * 2u, vb = (row0 * 1024u + (unsigned)u.pn * 128 + cw) * 2u;
#pragma unroll
        for (int ai = 0; ai < 2; ++ai)
#pragma unroll
            for (int m = 0; m < 4; ++m) { const float* sp = SS + (size_t)(row0 + ai * 128 + m * 16) * 20 + 12; const f32x4 a0 = *(const f32x4*)sp, a1 = *(const f32x4*)(sp + 4);
                const float rk = rsqrtf((((a0[0] + a0[1]) + (a0[2] + a0[3])) + ((a1[0] + a1[1]) + (a1[2] + a1[3]))) * (1.f / MLA_KVL) + 1e-6f);
                st16(KM, kb + (unsigned)((ai * 128 + m * 16) * UQ_N) * 2u, pack2x4(acc[ai][0][m][0] * rk, acc[ai][0][m][1] * rk));
                st16(VM, vb + (unsigned)((ai * 128 + m * 16) * 1024) * 2u, pack2x4(acc[ai][1][m][0] * rk, acc[ai][1][m][1] * rk)); }
    }
};
__device__ __forceinline__ void ph14_mla_attn(const Args& a, const Ctx& c) {
    const bf16* QM = (const bf16*)(a.ws + WS_QM); const bf16* KM = (const bf16*)(a.ws + WS_KM); const bf16* VM = (const bf16*)(a.ws + WS_VM); bf16* MIX = (bf16*)(a.ws + WS_MIX);
    for (int task = c.vcu; task < 1024; task += c.G) {
        const int b = task >> 7, h = (task >> 4) & 7, r0 = b * SP + NCTX + (task & 15) * 256;
        att::attn_dense_body<192, UQ_N, UQ_N, 1024, 1024>(QM + (size_t)r0 * UQ_N + h * 192, KM + (size_t)b * SP * UQ_N + h * 192, VM + (size_t)b * SP * 1024 + h * 128,
                                                          MIX + (size_t)r0 * 1024 + h * 128, SP, (char*)c.lds);
    }
}

#ifdef EXP_VAR
__device__ __forceinline__ void ph14_exp(const Args& a, const Ctx& c) {
    const bf16* QM = (const bf16*)(a.ws + WS_QM); const bf16* KM = (const bf16*)(a.ws + WS_KM); const bf16* VM = (const bf16*)(a.ws + WS_VM); bf16* OX = (bf16*)(a.ws + WS_ACT);
    for (int task = c.vcu; task < 1024; task += c.G) {
        const int b = task >> 7, h = (task >> 4) & 7, r0 = b * SP + NCTX + (task & 15) * 256;
#if EXP_D == 192
        att::attn_dense_body<192, UQ_N, UQ_N, 1024, 1024, EXP_VAR>(QM + (size_t)r0 * UQ_N + h * 192, KM + (size_t)b * SP * UQ_N + h * 192, VM + (size_t)b * SP * 1024 + h * 128,
                                                                   OX + (size_t)r0 * 1024 + h * 128, SP, (char*)c.lds);
#else
        att::attn_dense_body<128, UQ_N, UQ_N, 1024, 1024, EXP_VAR>(QM + (size_t)r0 * UQ_N + h * 192, KM + (size_t)b * SP * UQ_N + h * 192, VM + (size_t)b * SP * 1024 + h * 128,
                                                                   OX + (size_t)r0 * 1024 + h * 128, SP, (char*)c.lds);
#endif
    }
}
#endif
constexpr int NPH = 20;
#ifndef ONE_LAUNCH
#define ONE_LAUNCH 1
#endif
__global__ void __launch_bounds__(512, 2) fwd(Args a) {
    extern __shared__ __attribute__((aligned(16))) unsigned char lds_raw[];
    Ctx c; c.lds = (LAS unsigned char*)lds_raw; c.tid = threadIdx.x; c.lane = c.tid & 63; c.wave = __builtin_amdgcn_readfirstlane(c.tid >> 6);
    c.G = gridDim.x; { const int bx = blockIdx.x; c.vcu = (c.G % 8 == 0) ? (bx % 8) * (c.G / 8) + bx / 8 : bx; }
    c.gw = c.vcu * 8 + c.wave; c.NGW = c.G * 8;
    volatile LAS unsigned* MISC = (volatile LAS unsigned*)(c.lds + MISC_OFF);
    if (c.tid < 256) MISC[c.tid] = 0u;
    __syncthreads();
    unsigned* ctl = (unsigned*)(a.ws + WS_CTL);
    XcdBarrier bar; bar.bar = ctl + CW_BAR; bar.x = 0; bar.st = nullptr;
    const int lo = a.ph_lo, hi = a.ph_hi;
    if (hi - lo > 1) bar = xcd_barrier_post(ctl + CW_BAR, MISC + 248);
#ifndef PHMASK
#define PHMASK 0xFFFFFu
#endif
#define IN(k) ((((PHMASK) >> (k)) & 1u) && lo <= (k) && (k) < hi)
#ifndef DUPMASK
#define DUPMASK 0u
#endif
#define NREP(k) ((((DUPMASK) >> (k)) & 1u) ? 2 : 1)
#ifdef PROBE_K
#define STAMP(k) do { if (blockIdx.x == 0 && c.tid == 0) ((unsigned long long*)(a.ws + WS_CTL + 524288))[(k)] = __builtin_amdgcn_s_memrealtime(); } while (0)
#else
#define STAMP(k) do { } while (0)
#endif
#ifndef EXTRA_BAR
#define EXTRA_BAR 0
#endif
#ifndef EXP_MOE
#define EXP_MOE 0
#endif
#define SEAM(k) do { if (IN(k) && IN((k) + 1)) { xcd_barrier(bar); if ((k) == 10) for (int _e = 0; _e < EXTRA_BAR; ++_e) xcd_barrier(bar); } STAMP((k) + 1); } while (0)
    STAMP(0);
#ifdef STAGGER_US
#define STAGGER(total_units) do { const int _rem = (total_units) % c.G; if (_rem != 0 && (int)blockIdx.x >= _rem) { \
        const unsigned long long _t0 = __builtin_amdgcn_s_memrealtime(); const unsigned long long _d = (unsigned long long)((int)blockIdx.x - _rem) * (STAGGER_US * 100) / (unsigned)(c.G - _rem); \
        while (__builtin_amdgcn_s_memrealtime() - _t0 < _d) __builtin_amdgcn_s_sleep(8); } } while (0)
#else
#define STAGGER(total_units) do { } while (0)
#endif
    unsigned char* ws = a.ws;
    const float* mods = (const float*)(ws + WS_MODS);
    LAS int* misc = (LAS int*)(c.lds + MISC_OFF);

    if (IN(0)) { ph0_prologue(a, c);
    }
#if (DUPMASK >> 0) & 1
    if (IN(0)) { __syncthreads(); ph0_prologue(a, c);
    }
#endif
    SEAM(0);
    if (IN(1)) { ph1_mod0(a, c);
    }
#if (DUPMASK >> 1) & 1
    if (IN(1)) { __syncthreads(); ph1_mod0(a, c);
    }
#endif
    SEAM(1);
    if (IN(2)) {
        STAGGER((R / 256) * (AB_IN / 256));
        pg8::Gemm g{(const bf16*)(ws + WS_H), (const bf16*)(ws + WS_WABIN), 1024, 1024}; pg8::StaticOrder S; S.init(R / 256, AB_IN / 256, c.G, (int)blockIdx.x);
        EpiStoreBf16 E{(bf16*)(ws + WS_P), AB_IN};
        pg8::gemm_phase(c.lds, g, S, E);
    }
#if (DUPMASK >> 2) & 1
    if (IN(2)) { __syncthreads();
        pg8::Gemm g{(const bf16*)(ws + WS_H), (const bf16*)(ws + WS_WABIN), 1024, 1024}; pg8::StaticOrder S; S.init(R / 256, AB_IN / 256, c.G, (int)blockIdx.x);
        EpiStoreBf16 E{(bf16*)(ws + WS_P), AB_IN};
        pg8::gemm_phase(c.lds, g, S, E);
    }
#endif
    SEAM(2);
    if (IN(3)) { ph3_post(a, c);
    }
#if (DUPMASK >> 3) & 1
    if (IN(3)) { __syncthreads(); ph3_post(a, c);
    }
#endif
    SEAM(3);
    if (IN(4)) { ph4_r1(a, c); __syncthreads(); ph4_attn(a, c);
    }
#if (DUPMASK >> 4) & 1
    if (IN(4)) { __syncthreads(); ph4_r1(a, c); __syncthreads(); ph4_attn(a, c);
    }
#endif
    SEAM(4);
    if (IN(5)) { ph5_r2(a, c);
    }
#if (DUPMASK >> 5) & 1
    if (IN(5)) { __syncthreads(); ph5_r2(a, c);
    }
#endif
    SEAM(5);
    if (IN(6)) {
        pg8::Gemm g{(const bf16*)(ws + WS_MIX), (const bf16*)(ws + WS_WABOUT), 1024, 1024}; pg8::StaticOrder S; S.init(R / 256, 4, c.G, (int)blockIdx.x);
        EpiResid<0> E{a.in[I_X], a.in[I_CTX], nullptr, mods, (bf16*)(ws + WS_ACC)};
        pg8::gemm_phase(c.lds, g, S, E);
    }
#if (DUPMASK >> 6) & 1
    if (IN(6)) { __syncthreads();
        pg8::Gemm g{(const bf16*)(ws + WS_MIX), (const bf16*)(ws + WS_WABOUT), 1024, 1024}; pg8::StaticOrder S; S.init(R / 256, 4, c.G, (int)blockIdx.x);
        EpiResid<0> E{a.in[I_X], a.in[I_CTX], nullptr, mods, (bf16*)(ws + WS_ACC)};
        pg8::gemm_phase(c.lds, g, S, E);
    }
#endif
    SEAM(6);
    if (IN(7)) { ph_ln1_router<0>(a, c);
    }
#if (DUPMASK >> 7) & 1
    if (IN(7)) { __syncthreads(); ph_ln1_router<0>(a, c);
    }
#endif
    SEAM(7);
    if (IN(8)) {
        moe_setup_tiles(a, c, 0); STAGGER(misc[NE] * 8);
        pg8::Gemm g{(const bf16*)(ws + WS_H), (const bf16*)(ws + WS_WUP), 1024, 1024}; MoeOrder<true> S; S.init(misc, (const int*)(ws + WS_LTOK), 8, c.G, (int)blockIdx.x);
        EpiMoeUp E{(bf16*)(ws + WS_ACT), a.in[I_BUP]};
        pg8::gemm_phase(c.lds, g, S, E);
    }
#if (DUPMASK >> 8) & 1
    if (IN(8)) { __syncthreads(); STAMP(30);
        moe_setup_tiles(a, c, 0);
        pg8::Gemm g{(const bf16*)(ws + WS_H), (const bf16*)(ws + WS_WUP), 1024, 1024}; MoeOrder<true> S; S.init(misc, (const int*)(ws + WS_LTOK), 8, c.G, (int)blockIdx.x);
        EpiMoeUpT<EXP_MOE> E{(bf16*)(ws + WS_ACT), a.in[I_BUP]};
        pg8::gemm_phase(c.lds, g, S, E);
    }
#endif
    SEAM(8);
    if (IN(9)) {
        moe_setup_tiles(a, c, 0); STAGGER(misc[NE] * 4);
        pg8::Gemm g{(const bf16*)(ws + WS_ACT), (const bf16*)(ws + WS_WDOWN), 1024, 1024}; MoeOrder<false> S; S.init(misc, nullptr, 4, c.G, (int)blockIdx.x);
        EpiMoeDown E{(bf16*)(ws + WS_YK), a.in[I_BDOWN], (const float*)(ws + WS_LGATE), misc};
        pg8::gemm_phase(c.lds, g, S, E);
    }
#if (DUPMASK >> 9) & 1
    if (IN(9)) { __syncthreads(); STAMP(30);
        moe_setup_tiles(a, c, 0);
        pg8::Gemm g{(const bf16*)(ws + WS_ACT), (const bf16*)(ws + WS_WDOWN), 1024, 1024}; MoeOrder<false> S; S.init(misc, nullptr, 4, c.G, (int)blockIdx.x);
        EpiMoeDownT<EXP_MOE> E{(bf16*)(ws + WS_YK), a.in[I_BDOWN], (const float*)(ws + WS_LGATE), misc};
        pg8::gemm_phase(c.lds, g, S, E);
    }
#endif
    SEAM(9);
    if (IN(10)) { ph_ln2<0>(a, c);
    }
#if (DUPMASK >> 10) & 1
    if (IN(10)) { __syncthreads(); ph_ln2<0>(a, c);
    }
#endif
    SEAM(10);
    if (IN(11)) {
        pg8::Gemm g{(const bf16*)(ws + WS_H), (const bf16*)(ws + WS_WMLAIN), 1024, 1024}; pg8::StaticOrder S; S.init(R / 256, 3, c.G, (int)blockIdx.x);
        EpiMlaIn E{(bf16*)(ws + WS_PM), (float*)(ws + WS_SS), (bf16*)(ws + WS_KM), (const float2*)(ws + WS_TAB_A64)};
        pg8::gemm_phase(c.lds, g, S, E);
    }
#if (DUPMASK >> 11) & 1
    if (IN(11)) { __syncthreads();
        pg8::Gemm g{(const bf16*)(ws + WS_H), (const bf16*)(ws + WS_WMLAIN), 1024, 1024}; pg8::StaticOrder S; S.init(R / 256, 3, c.G, (int)blockIdx.x);
        EpiMlaIn E{(bf16*)(ws + WS_PM), (float*)(ws + WS_SS), (bf16*)(ws + WS_KM), (const float2*)(ws + WS_TAB_A64)};
        pg8::gemm_phase(c.lds, g, S, E);
    }
#endif
    SEAM(11);
    if (IN(12)) {
    }
#if (DUPMASK >> 12) & 1
    if (IN(12)) { }
#endif
#ifdef PROBE_K
    STAMP(13);
#endif
    if (IN(13)) {
#ifndef NO_UQ
        {   pg8::Gemm g{(const bf16*)(ws + WS_PM), (const bf16*)(ws + WS_WUQ), MLA_QL, MLA_IN_P}; LatOrder S; S.init(6, c.G, (int)blockIdx.x);
            EpiUq E{(bf16*)(ws + WS_QM), (const float2*)(ws + WS_TAB_A64), (const float*)(ws + WS_SS)};
            pg8::gemm_phase(c.lds, g, S, E); }
#endif
#ifndef NO_UKV
        {   pg8::Gemm g{(const bf16*)(ws + WS_PM) + 512, (const bf16*)(ws + WS_WUKV), MLA_KVL, MLA_IN_P}; pg8::StaticOrder S; S.init(R / 256, 8, c.G, (int)blockIdx.x);
            EpiUkv E{(bf16*)(ws + WS_KM), (bf16*)(ws + WS_VM), (const float*)(ws + WS_SS)};
            pg8::gemm_phase(c.lds, g, S, E); }
#endif
    }
#if (DUPMASK >> 13) & 1
    if (IN(13)) { __syncthreads();
#ifndef NO_UQ
        {   pg8::Gemm g{(const bf16*)(ws + WS_PM), (const bf16*)(ws + WS_WUQ), MLA_QL, MLA_IN_P}; LatOrder S; S.init(6, c.G, (int)blockIdx.x);
            EpiUq E{(bf16*)(ws + WS_QM), (const float2*)(ws + WS_TAB_A64), (const float*)(ws + WS_SS)};
            pg8::gemm_phase(c.lds, g, S, E); }
#endif
#ifndef NO_UKV
        {   pg8::Gemm g{(const bf16*)(ws + WS_PM) + 512, (const bf16*)(ws + WS_WUKV), MLA_KVL, MLA_IN_P}; pg8::StaticOrder S; S.init(R / 256, 8, c.G, (int)blockIdx.x);
            EpiUkv E{(bf16*)(ws + WS_KM), (bf16*)(ws + WS_VM), (const float*)(ws + WS_SS)};
            pg8::gemm_phase(c.lds, g, S, E); }
#endif
    }
#endif
    SEAM(13);
    if (IN(14)) { ph14_mla_attn(a, c);
    }
#if (DUPMASK >> 14) & 1
    if (IN(14)) { __syncthreads(); ph14_mla_attn(a, c);
    }
#endif
    SEAM(14);
#ifdef EXP_VAR
    if (IN(14)) { STAMP(30); ph14_exp(a, c); xcd_barrier(bar); STAMP(31); }
#endif
    if (IN(15)) {
        pg8::Gemm g{(const bf16*)(ws + WS_MIX), (const bf16*)(ws + WS_WMLAOUT), 1024, 1024}; LatOrder S; S.init(4, c.G, (int)blockIdx.x);
        EpiResid<1> E{nullptr, nullptr, (const bf16*)(ws + WS_X), mods + 9 * 6144, (bf16*)(ws + WS_ACC)};
        pg8::gemm_phase(c.lds, g, S, E);
    }
#if (DUPMASK >> 15) & 1
    if (IN(15)) { __syncthreads();
        pg8::Gemm g{(const bf16*)(ws + WS_MIX), (const bf16*)(ws + WS_WMLAOUT), 1024, 1024}; LatOrder S; S.init(4, c.G, (int)blockIdx.x);
        EpiResid<1> E{nullptr, nullptr, (const bf16*)(ws + WS_X), mods + 9 * 6144, (bf16*)(ws + WS_ACC)};
        pg8::gemm_phase(c.lds, g, S, E);
    }
#endif
    SEAM(15);
    if (IN(16)) { ph_ln1_router<1>(a, c);
    }
#if (DUPMASK >> 16) & 1
    if (IN(16)) { __syncthreads(); ph_ln1_router<1>(a, c);
    }
#endif
    SEAM(16);
    if (IN(17)) {
        moe_setup_tiles(a, c, 1); STAGGER(misc[NE] * 8);
        pg8::Gemm g{(const bf16*)(ws + WS_H), (const bf16*)(ws + WS_WUP) + (size_t)32 * 2048 * 1024, 1024, 1024}; MoeOrder<true> S; S.init(misc, (const int*)(ws + WS_LTOK), 8, c.G, (int)blockIdx.x);
        EpiMoeUp E{(bf16*)(ws + WS_ACT), a.in[I_BUP] + 32 * 2048};
        pg8::gemm_phase(c.lds, g, S, E);
    }
#if (DUPMASK >> 17) & 1
    if (IN(17)) { __syncthreads();
        moe_setup_tiles(a, c, 1);
        pg8::Gemm g{(const bf16*)(ws + WS_H), (const bf16*)(ws + WS_WUP) + (size_t)32 * 2048 * 1024, 1024, 1024}; MoeOrder<true> S; S.init(misc, (const int*)(ws + WS_LTOK), 8, c.G, (int)blockIdx.x);
        EpiMoeUp E{(bf16*)(ws + WS_ACT), a.in[I_BUP] + 32 * 2048};
        pg8::gemm_phase(c.lds, g, S, E);
    }
#endif
    SEAM(17);
    if (IN(18)) {
        moe_setup_tiles(a, c, 1); STAGGER(misc[NE] * 4);
        pg8::Gemm g{(const bf16*)(ws + WS_ACT), (const bf16*)(ws + WS_WDOWN) + (size_t)32 * 1024 * 1024, 1024, 1024}; MoeOrder<false> S; S.init(misc, nullptr, 4, c.G, (int)blockIdx.x);
        EpiMoeDown E{(bf16*)(ws + WS_YK), a.in[I_BDOWN] + 32 * 1024, (const float*)(ws + WS_LGATE), misc};
        pg8::gemm_phase(c.lds, g, S, E);
    }
#if (DUPMASK >> 18) & 1
    if (IN(18)) { __syncthreads();
        moe_setup_tiles(a, c, 1);
        pg8::Gemm g{(const bf16*)(ws + WS_ACT), (const bf16*)(ws + WS_WDOWN) + (size_t)32 * 1024 * 1024, 1024, 1024}; MoeOrder<false> S; S.init(misc, nullptr, 4, c.G, (int)blockIdx.x);
        EpiMoeDown E{(bf16*)(ws + WS_YK), a.in[I_BDOWN] + 32 * 1024, (const float*)(ws + WS_LGATE), misc};
        pg8::gemm_phase(c.lds, g, S, E);
    }
#endif
    SEAM(18);
    if (IN(19)) { ph_ln2<1>(a, c);
    }
#if (DUPMASK >> 19) & 1
    if (IN(19)) { __syncthreads(); ph_ln2<1>(a, c);
    }
#endif
#undef IN
#undef SEAM
}

extern "C" void kernel_launch(void* const* d_in, const int* in_sizes, int n_in, void* d_out, int out_size, void* d_ws, size_t ws_size, hipStream_t stream) {
    static int grid = 0;
    if (grid == 0) {
        if (n_in != 28 || in_sizes[0] != NB * SEQ * D || out_size != NB * SEQ * D || ws_size < WS_END) {
            fprintf(stderr, "kernel_launch: shape mismatch: n_in %d in0 %d out %d ws %zu (need >= %zu)\n", n_in, n_in > 0 ? in_sizes[0] : -1, out_size, ws_size, (size_t)WS_END); grid = -1; return; }
        int dev = 0, cus = 0, per_cu = 0;
        if (hipGetDevice(&dev) != hipSuccess || hipDeviceGetAttribute(&cus, hipDeviceAttributeMultiprocessorCount, dev) != hipSuccess) { fprintf(stderr, "kernel_launch: device query failed\n"); grid = -1; return; }
        if (hipFuncSetAttribute((const void*)fwd, hipFuncAttributeMaxDynamicSharedMemorySize, LDS_BYTES) != hipSuccess) { fprintf(stderr, "kernel_launch: hipFuncSetAttribute failed\n"); grid = -1; return; }
        if (hipOccupancyMaxActiveBlocksPerMultiprocessor(&per_cu, (const void*)fwd, 512, LDS_BYTES) != hipSuccess || per_cu < 1) fprintf(stderr, "kernel_launch: occupancy query reports %d blocks per CU\n", per_cu);
        (void)hipGetLastError();
        grid = cus;
    }
    if (grid < 0) return;
    if (hipMemsetAsync((char*)d_ws + WS_CTL, 0, CTL_ZERO_BYTES, stream) != hipSuccess) { fprintf(stderr, "kernel_launch: memset failed\n"); return; }
    Args a{};
    for (int i = 0; i < 28; ++i) a.in[i] = (const float*)d_in[i];
    a.out = (float*)d_out; a.ws = (unsigned char*)d_ws;
#if ONE_LAUNCH
    a.ph_lo = 0; a.ph_hi = NPH;
    hipLaunchKernelGGL(fwd, dim3(grid), dim3(512), LDS_BYTES, stream, a);
#else
    for (int p = 0; p < NPH; ++p) { a.ph_lo = p; a.ph_hi = p + 1; hipLaunchKernelGGL(fwd, dim3(grid), dim3(512), LDS_BYTES, stream, a); }
#endif
    const hipError_t le = hipPeekAtLastError();
    if (le != hipSuccess) fprintf(stderr, "kernel_launch: launch failed: %s\n", hipGetErrorName(le));
}
```

```cpp
#include <hip/hip_runtime.h>
#include <cstdio>
#include <cstdint>

#define LAS __attribute__((address_space(3)))
#define GAS __attribute__((address_space(1)))
typedef unsigned short bf16;
typedef short bf16x8 __attribute__((ext_vector_type(8)));
typedef short s16x4 __attribute__((ext_vector_type(4)));
typedef float f32x4 __attribute__((ext_vector_type(4)));
typedef float f32x2 __attribute__((ext_vector_type(2)));
typedef float f32x8 __attribute__((ext_vector_type(8)));
typedef float f32x16 __attribute__((ext_vector_type(16)));
typedef unsigned u32x4 __attribute__((ext_vector_type(4)));
typedef unsigned u32x2 __attribute__((ext_vector_type(2)));
typedef GAS unsigned gu32;

constexpr int D = 1024, NB = 8, SEQ = 4096, NCTX = 256, SP = SEQ + NCTX  , R = NB * SP  ;
constexpr int GRID_W = 64;
constexpr int AB_IN = 3072, MLA_IN = 704, MLA_IN_P = 768, MLA_QL = 384, MLA_KVL = 256, UQ_N = 1536, UKV_N = 2048;
constexpr int NE = 32, TOPK = 4, DFF = 1024;
constexpr int NCHUNK = SP / 128;
constexpr float DN_ALPHA = 1.4142135623730951f;
constexpr int CAP = R * TOPK;
constexpr int NSLOT_MAX = R * TOPK + NE * 256;

#if defined(PROBE_K) && !defined(PROBE_END)
#define PROBE_END (PROBE_K + 1)
#endif
__device__ __forceinline__ unsigned cvt_pk_bf16(float lo, float hi) { unsigned r; asm volatile("v_cvt_pk_bf16_f32 %0, %1, %2" : "=v"(r) : "v"(lo), "v"(hi)); return r; }
__device__ __forceinline__ unsigned cvt_pk_nv(float lo, float hi) { unsigned r; asm("v_cvt_pk_bf16_f32 %0, %1, %2" : "=v"(r) : "v"(lo), "v"(hi)); return r; }
__device__ __forceinline__ float bflo(unsigned w) { return __uint_as_float(w << 16); }
__device__ __forceinline__ float bfhi(unsigned w) { return __uint_as_float(w & 0xffff0000u); }
__device__ __forceinline__ float bf2f(bf16 b) { return __uint_as_float((unsigned)b << 16); }
__device__ __forceinline__ bf16 f2bf(float f) { return (bf16)(cvt_pk_bf16(f, 0.f) & 0xffffu); }
__device__ __forceinline__ float wave_sum(float v) {
#pragma unroll
    for (int o = 1; o < 64; o <<= 1) v += __shfl_xor(v, o);
    return v;
}
#define LDS_WAIT() asm volatile("s_waitcnt lgkmcnt(0)" ::: "memory")
#define VM_WAIT() asm volatile("s_waitcnt vmcnt(0)" ::: "memory")
#ifndef PG8_WGM
#define PG8_WGM 8
#endif
namespace pg8 {
typedef unsigned short bf16_t;
constexpr int BM = 256, BK = 64, HALF = 128, HTB = HALF * BK * 2  , STAGE_BYTES = 8 * HTB, NXCD = 8, WGM = PG8_WGM;

__host__ __device__ __forceinline__ int lds_byte(int r, int c) { const int st = (r >> 4) * 2 + (c >> 5), rr = r & 15, cc = c & 31, ob = rr * 64 + cc * 2; return st * 1024 + (ob ^ (((ob >> 9) & 1) << 5)); }
__host__ __device__ __forceinline__ void stage_rc(int b, int& R_, int& C_) { const int st = b / 1024, sb = b % 1024, swz = sb ^ (((sb >> 9) & 1) << 5); R_ = (st >> 1) * 16 + swz / 64; C_ = (st & 1) * 32 + (swz % 64) / 2; }
__host__ __device__ __forceinline__ int perm32(int rho) { const int n = rho >> 4, i = rho & 15; return 8 * (i >> 2) + 4 * n + (i & 3); }

struct Unit { int pm, pn, pb, e; };
struct Gemm { const bf16_t* A; const bf16_t* Bt; int K; int lda; };

struct StaticOrder {
    int nM, nN, nwg, G, c;
    static constexpr bool GATHER = false;
    __device__ void init(int nM_, int nN_, int G_, int c_) { nM = nM_; nN = nN_; nwg = nM * nN; G = G_; c = c_; }
    __device__ bool next(int i, Unit& u) const {
        const long L = (long)i * G + c; if (L >= nwg) return false;
        int wgid = (int)L; { const int q = nwg / NXCD, r = nwg % NXCD, xcd = wgid % NXCD, off = wgid / NXCD; wgid = (xcd < r ? xcd * (q + 1) : r * (q + 1) + (xcd - r) * q) + off; }
        const int nig = WGM * nN, gid = wgid / nig, fm = gid * WGM, gsz = (nM - fm) < WGM ? (nM - fm) : WGM;
        u.pm = fm + ((wgid % nig) % gsz); u.pn = (wgid % nig) / gsz; u.pb = u.pn; u.e = 0; return true;
    }
    __device__ __forceinline__ unsigned arow(const Unit&, int) const { return 0u; }
};

template <class Epi, class Sched>
__device__ __forceinline__ void gemm_phase(LAS unsigned char* lds, const Gemm g, const Sched& S, const Epi& E) {
    constexpr bool GATHER = Sched::GATHER;
    const int tid = threadIdx.x, wid = __builtin_amdgcn_readfirstlane(tid >> 6), lane = tid & 63, wr = wid >> 2, wc = wid & 3, fr = lane & 15, fq = lane >> 4;
    const int K = g.K, nt = K / BK, LDA = g.lda;
    unsigned voffB[2]; int RA[2], CA[2];
#pragma unroll
    for (int i = 0; i < 2; ++i) { int R_, C_; stage_rc(tid * 16 + i * 8192, R_, C_); const int Rb = Epi::PERM ? ((R_ & ~31) + perm32(R_ & 31)) : R_;
        RA[i] = R_; CA[i] = C_; voffB[i] = (unsigned)(Rb * K + C_) * 2u; }
    const size_t kstep = (size_t)(BK * 2);
    const size_t hstep = (size_t)HALF * K * 2;
    const size_t tstep = 2 * hstep;
    const size_t tstepA = (size_t)2 * HALF * LDA * 2;
    const unsigned ldsw = (unsigned)wid * 1024u;
    const int aoff = lds_byte(wr * 64 + fr, fq * 8), boff = lds_byte(wc * 32 + fr, fq * 8);
#define PG8_SA(b, h) (((b) * 2 + (h)) * HTB)
#define PG8_SB(b, h) ((4 + (b) * 2 + (h)) * HTB)
#define PG8_STAGE(bufoff, gbase, voff) do { _Pragma("unroll") for (int _i = 0; _i < 2; ++_i) \
        __builtin_amdgcn_global_load_lds((const unsigned*)((const char*)(gbase) + (voff)[_i]), (LAS unsigned*)(lds + (bufoff) + ldsw + _i * 8192), 16, 0, 0); } while (0)
#define PG8_LDA(dst, b, h) do { _Pragma("unroll") for (int m = 0; m < 4; ++m) _Pragma("unroll") for (int k = 0; k < 2; ++k) dst[m][k] = *(const LAS bf16x8*)(lds + PG8_SA(b, h) + aoff + m * 2048 + k * 1024); } while (0)
#define PG8_LDB(dst, b, h) do { _Pragma("unroll") for (int n = 0; n < 2; ++n) _Pragma("unroll") for (int k = 0; k < 2; ++k) dst[n][k] = *(const LAS bf16x8*)(lds + PG8_SB(b, h) + boff + n * 2048 + k * 1024); } while (0)
#ifdef NO_SETPRIO
#define PG8_PRIO(x)
#else
#define PG8_PRIO(x) __builtin_amdgcn_s_setprio(x)
#endif
#define PG8_MMA(ai, bj, At, Bt) do { PG8_PRIO(1); _Pragma("unroll") for (int m = 0; m < 4; ++m) _Pragma("unroll") for (int n = 0; n < 2; ++n) _Pragma("unroll") for (int k = 0; k < 2; ++k) \
        acc[ai][bj][m][n] = __builtin_amdgcn_mfma_f32_16x16x32_bf16(Bt[n][k], At[m][k], acc[ai][bj][m][n], 0, 0, 0); PG8_PRIO(0); } while (0)
#define PG8_WAIT_V(n) asm volatile("s_waitcnt vmcnt(" #n ")" ::: "memory")
#define PG8_WAIT_L(n) asm volatile("s_waitcnt lgkmcnt(" #n ")" ::: "memory")
#define PG8_BAR __builtin_amdgcn_s_barrier()
#define PG8_SCHED __builtin_amdgcn_sched_barrier(0)
#define PG8_AOFFS(dst, u) do { _Pragma("unroll") for (int _h = 0; _h < 2; ++_h) _Pragma("unroll") for (int _i = 0; _i < 2; ++_i) { \
        if constexpr (GATHER) dst[_h][_i] = (S.arow(u, _h * HALF + RA[_i]) * (unsigned)LDA + (unsigned)CA[_i]) * 2u; \
        else dst[_h][_i] = ((unsigned)((_h * HALF + RA[_i]) * LDA + CA[_i])) * 2u; } } while (0)
    Unit cur, nxt; int ui = 0;
    if (!S.next(0, cur)) return;
    f32x4 acc[2][2][4][2];
#pragma unroll
    for (int a = 0; a < 2; ++a)
#pragma unroll
        for (int b = 0; b < 2; ++b)
#pragma unroll
            for (int m = 0; m < 4; ++m)
#pragma unroll
                for (int n = 0; n < 2; ++n) acc[a][b][m][n] = (f32x4){0.f, 0.f, 0.f, 0.f};
    bf16x8 At[4][2], B0[2][2], B1[2][2];
    unsigned vAc[2][2], vAn[2][2];
    PG8_AOFFS(vAc, cur);
    const char* cA = GATHER ? (const char*)g.A : (const char*)g.A + (size_t)cur.pm * tstepA; const char* cB = (const char*)g.Bt + (size_t)cur.pb * tstep;
    PG8_STAGE(PG8_SB(0, 0), cB, voffB); PG8_STAGE(PG8_SB(0, 1), cB + hstep, voffB); PG8_STAGE(PG8_SA(0, 0), cA, vAc[0]); PG8_STAGE(PG8_SA(0, 1), cA, vAc[1]);
    if (wr == 1) PG8_BAR;
    PG8_WAIT_V(2); PG8_BAR;
    PG8_STAGE(PG8_SB(1, 0), cB + kstep, voffB); PG8_STAGE(PG8_SA(1, 0), cA + kstep, vAc[0]); PG8_STAGE(PG8_SB(1, 1), cB + hstep + kstep, voffB);
    PG8_WAIT_V(6); PG8_BAR;
    for (;;) {
        const bool has_next = S.next(ui + 1, nxt);
        if (has_next) { PG8_AOFFS(vAn, nxt); } else {
#pragma unroll
            for (int _h = 0; _h < 2; ++_h)
#pragma unroll
                for (int _i = 0; _i < 2; ++_i) vAn[_h][_i] = vAc[_h][_i]; }
        const char* nA = has_next ? (GATHER ? (const char*)g.A : (const char*)g.A + (size_t)nxt.pm * tstepA) : cA; const char* nB = has_next ? (const char*)g.Bt + (size_t)nxt.pb * tstep : cB;
#pragma unroll 1
        for (int t = 0; t < nt; t += 2) {
            const bool last = (t == nt - 2);
            const char* a1 = cA + (size_t)(t + 1) * kstep;
            const char* a2 = last ? nA : cA + (size_t)(t + 2) * kstep; const char* b2 = last ? nB : cB + (size_t)(t + 2) * kstep;
            const char* a3 = a2 + kstep; const char* b3 = b2 + kstep;
            unsigned v2[2][2];
#pragma unroll
            for (int _h = 0; _h < 2; ++_h)
#pragma unroll
                for (int _i = 0; _i < 2; ++_i) v2[_h][_i] = last ? vAn[_h][_i] : vAc[_h][_i];
#ifdef GV1
            PG8_STAGE(PG8_SA(1, 1), a1, vAc[1]); PG8_SCHED; PG8_LDB(B0, 0, 0); PG8_LDB(B1, 0, 1); PG8_SCHED; PG8_LDA(At, 0, 0);
            PG8_WAIT_V(8); PG8_WAIT_L(0); PG8_BAR; PG8_MMA(0, 0, At, B0); PG8_MMA(0, 1, At, B1); PG8_BAR; PG8_SCHED;
            PG8_STAGE(PG8_SB(0, 0), b2, voffB); PG8_STAGE(PG8_SB(0, 1), b2 + hstep, voffB); PG8_STAGE(PG8_SA(0, 0), a2, v2[0]); PG8_SCHED; PG8_LDA(At, 0, 1);
            PG8_WAIT_V(8); PG8_WAIT_L(0); PG8_BAR; PG8_MMA(1, 0, At, B0); PG8_MMA(1, 1, At, B1); PG8_BAR; PG8_SCHED;
            PG8_STAGE(PG8_SA(0, 1), a2, v2[1]); PG8_SCHED; PG8_LDB(B0, 1, 0); PG8_LDB(B1, 1, 1); PG8_SCHED; PG8_LDA(At, 1, 0);
            PG8_WAIT_V(8); PG8_WAIT_L(0); PG8_BAR; PG8_MMA(0, 0, At, B0); PG8_MMA(0, 1, At, B1); PG8_BAR; PG8_SCHED;
            PG8_STAGE(PG8_SB(1, 0), b3, voffB); PG8_STAGE(PG8_SB(1, 1), b3 + hstep, voffB); PG8_STAGE(PG8_SA(1, 0), a3, v2[0]); PG8_SCHED; PG8_LDA(At, 1, 1);
            PG8_WAIT_V(8); PG8_WAIT_L(0); PG8_BAR; PG8_MMA(1, 0, At, B0); PG8_MMA(1, 1, At, B1); PG8_BAR; PG8_SCHED;
#else
            PG8_LDB(B0, 0, 0); PG8_LDB(B1, 0, 1); PG8_SCHED; PG8_LDA(At, 0, 0); PG8_STAGE(PG8_SA(1, 1), a1, vAc[1]);
            PG8_WAIT_V(8); PG8_WAIT_L(0); PG8_BAR; PG8_MMA(0, 0, At, B0); PG8_MMA(0, 1, At, B1); PG8_BAR; PG8_SCHED;
            PG8_LDA(At, 0, 1); PG8_STAGE(PG8_SB(0, 0), b2, voffB); PG8_STAGE(PG8_SB(0, 1), b2 + hstep, voffB); PG8_STAGE(PG8_SA(0, 0), a2, v2[0]);
            PG8_WAIT_V(8); PG8_WAIT_L(0); PG8_BAR; PG8_MMA(1, 0, At, B0); PG8_MMA(1, 1, At, B1); PG8_BAR; PG8_SCHED;
            PG8_LDB(B0, 1, 0); PG8_LDB(B1, 1, 1); PG8_SCHED; PG8_LDA(At, 1, 0); PG8_STAGE(PG8_SA(0, 1), a2, v2[1]);
            PG8_WAIT_V(8); PG8_WAIT_L(0); PG8_BAR; PG8_MMA(0, 0, At, B0); PG8_MMA(0, 1, At, B1); PG8_BAR; PG8_SCHED;
            PG8_LDA(At, 1, 1); PG8_STAGE(PG8_SB(1, 0), b3, voffB); PG8_STAGE(PG8_SB(1, 1), b3 + hstep, voffB); PG8_STAGE(PG8_SA(1, 0), a3, v2[0]);
            PG8_WAIT_V(8); PG8_WAIT_L(0); PG8_BAR; PG8_MMA(1, 0, At, B0); PG8_MMA(1, 1, At, B1); PG8_BAR; PG8_SCHED;
#endif
        }
#ifndef NO_ALIGN_EPI
        if (wr == 0) PG8_BAR;
#endif
        E(acc, cur, wr, wc, fr, fq);
        if (!has_next) break;
#pragma unroll
        for (int a = 0; a < 2; ++a)
#pragma unroll
            for (int b = 0; b < 2; ++b)
#pragma unroll
                for (int m = 0; m < 4; ++m)
#pragma unroll
                    for (int n = 0; n < 2; ++n) acc[a][b][m][n] = (f32x4){0.f, 0.f, 0.f, 0.f};
        cur = nxt; cA = nA; cB = nB; ++ui;
#pragma unroll
        for (int _h = 0; _h < 2; ++_h)
#pragma unroll
            for (int _i = 0; _i < 2; ++_i) vAc[_h][_i] = vAn[_h][_i];
#ifndef NO_ALIGN_EPI
        if (wr == 1) PG8_BAR;
#endif
    }
    PG8_WAIT_V(0);
#ifdef NO_ALIGN_EPI
    if (wr == 0) PG8_BAR;
#endif
    PG8_BAR;
#undef PG8_SA
#undef PG8_SB
#undef PG8_STAGE
#undef PG8_LDA
#undef PG8_LDB
#undef PG8_MMA
#undef PG8_WAIT_V
#undef PG8_WAIT_L
#undef PG8_BAR
#undef PG8_SCHED
#undef PG8_AOFFS
}
}
namespace att {
constexpr int NW = 8, QBLK = 32, KVBLK = 64, DV = 128;
template <int DQK> __device__ __forceinline__ int kswz_f(int row) { if constexpr (DQK == 128) return (row & 3) | (((row >> 3) & 3) << 2); else return ((row >> 1) & 1) | (((row >> 3) & 3) << 1); }
#define KSWZ(row, colB, RS) ((row) * (RS) + ((colB) ^ (kswz_f<(RS) / 2>(row) << 4)))
#define SBAR() __builtin_amdgcn_sched_barrier(0)
#ifdef ATT_SETPRIO
#define ATT_PRIO(x) __builtin_amdgcn_s_setprio(x)
#else
#define ATT_PRIO(x)
#endif
__device__ __forceinline__ int crow(int r, int hi) { return (r & 3) + 8 * (r >> 2) + 4 * hi; }
constexpr float THR = 8.f;
constexpr float LOG2E = 1.4426950408889634f;

__device__ __forceinline__ void partialSM(f32x16& p0, f32x16& p1, float& m_reg, float& mn, float& alpha) {
  constexpr float C = LOG2E;
  float pmax = p0[0];
#pragma unroll
  for (int r = 1; r < 16; ++r) pmax = fmaxf(pmax, p0[r]);
#pragma unroll
  for (int r = 0; r < 16; ++r) pmax = fmaxf(pmax, p1[r]);
  { auto rr = __builtin_amdgcn_permlane32_swap(__float_as_uint(pmax), __float_as_uint(pmax), false, false);
    pmax = fmaxf(__uint_as_float(rr[0]), __uint_as_float(rr[1])); }
  if (__builtin_expect(__all(pmax - m_reg <= THR), 1)) { mn = m_reg; alpha = 1.f; }
  else { mn = fmaxf(m_reg, pmax); alpha = __builtin_amdgcn_exp2f((m_reg - mn) * C); m_reg = mn; }
  float mnC = -mn * C;
#pragma unroll
  for (int r = 0; r < 16; ++r) p0[r] = fmaf(p0[r], C, mnC);
#pragma unroll
  for (int r = 0; r < 16; ++r) p1[r] = fmaf(p1[r], C, mnC);
#pragma unroll
  for (int r = 0; r < 16; ++r) p0[r] = __builtin_amdgcn_exp2f(p0[r]);
}
__device__ __forceinline__ void finishSM(f32x16& p0, f32x16& p1, float alpha, float& l_reg, bf16x8& pa0, bf16x8& pa1, bf16x8& pa2, bf16x8& pa3) {
#pragma unroll
  for (int r = 0; r < 16; ++r) p1[r] = __builtin_amdgcn_exp2f(p1[r]);
  float ps = 0;
#pragma unroll
  for (int r = 0; r < 16; ++r) ps += p0[r];
#pragma unroll
  for (int r = 0; r < 16; ++r) ps += p1[r];
  { auto rr = __builtin_amdgcn_permlane32_swap(__float_as_uint(ps), __float_as_uint(ps), false, false);
    ps = __uint_as_float(rr[0]) + __uint_as_float(rr[1]); }
  l_reg = l_reg * alpha + ps;
#define PK4(P, BASE, OUT) do { unsigned a0 = cvt_pk_bf16(P[BASE + 0], P[BASE + 1]), a1 = cvt_pk_bf16(P[BASE + 2], P[BASE + 3]);   \
    unsigned b0 = cvt_pk_bf16(P[BASE + 4], P[BASE + 5]), b1 = cvt_pk_bf16(P[BASE + 6], P[BASE + 7]);                              \
    auto r0 = __builtin_amdgcn_permlane32_swap(a0, b0, false, false); auto r1 = __builtin_amdgcn_permlane32_swap(a1, b1, false, false); \
    u32x4 w = {r0[0], r1[0], r0[1], r1[1]}; OUT = *reinterpret_cast<bf16x8*>(&w); } while (0)
  PK4(p0, 0, pa0); PK4(p0, 8, pa1); PK4(p1, 0, pa2); PK4(p1, 8, pa3);
#undef PK4
}
__device__ __forceinline__ void finishSM_min(f32x16& p0, f32x16& p1, bf16x8& pa0, bf16x8& pa1, bf16x8& pa2, bf16x8& pa3) {
#define PK4(P, BASE, OUT) do { unsigned a0 = cvt_pk_bf16(P[BASE + 0], P[BASE + 1]), a1 = cvt_pk_bf16(P[BASE + 2], P[BASE + 3]);   \
    unsigned b0 = cvt_pk_bf16(P[BASE + 4], P[BASE + 5]), b1 = cvt_pk_bf16(P[BASE + 6], P[BASE + 7]);                              \
    auto r0 = __builtin_amdgcn_permlane32_swap(a0, b0, false, false); auto r1 = __builtin_amdgcn_permlane32_swap(a1, b1, false, false); \
    u32x4 w = {r0[0], r1[0], r0[1], r1[1]}; OUT = *reinterpret_cast<bf16x8*>(&w); } while (0)
  PK4(p0, 0, pa0); PK4(p0, 8, pa1); PK4(p1, 0, pa2); PK4(p1, 8, pa3);
#undef PK4
}
template <int DQK, int QL, int VAR = 0>
__device__ __forceinline__ void qkt(f32x16& p0, f32x16& p1, const char* Ks, const bf16x8* qr, const char* qlds, int r32, int hi) {
  p0 = f32x16{}; p1 = f32x16{};
  constexpr int NQ = DQK / 16, NR = NQ - QL, NG = NQ / 2;
  bf16x8 kb[2][4], qv[2];
#define QK_LD(buf_, g_) do { _Pragma("unroll") for (int dd = 0; dd < 2; ++dd) { const int d0 = 2 * (g_) + dd, cb = (d0 * 16 + hi * 8) * 2; \
      if constexpr (VAR == 9) { kb[buf_][2 * dd] = *reinterpret_cast<const bf16x8*>(Ks + cb); kb[buf_][2 * dd + 1] = *reinterpret_cast<const bf16x8*>(Ks + 32 * DQK * 2 + cb); } \
      else if constexpr (VAR == 8) { kb[buf_][2 * dd] = *reinterpret_cast<const bf16x8*>(Ks + r32 * (DQK * 2) + cb); kb[buf_][2 * dd + 1] = *reinterpret_cast<const bf16x8*>(Ks + (32 + r32) * (DQK * 2) + cb); } \
      else { kb[buf_][2 * dd] = *reinterpret_cast<const bf16x8*>(Ks + KSWZ(r32, cb, DQK * 2)); kb[buf_][2 * dd + 1] = *reinterpret_cast<const bf16x8*>(Ks + KSWZ(32 + r32, cb, DQK * 2)); } } } while (0)
#define QV_LD(g_) do { _Pragma("unroll") for (int dd = 0; dd < 2; ++dd) { const int d0 = 2 * (g_) + dd; if (d0 >= NR) qv[dd] = *reinterpret_cast<const bf16x8*>(qlds + (d0 - NR) * 1024); } } while (0)
  if constexpr (VAR == 6) { _Pragma("unroll") for (int i = 0; i < 2; ++i) _Pragma("unroll") for (int j = 0; j < 4; ++j) kb[i][j] = qr[0]; qv[0] = qr[0]; qv[1] = qr[0]; }
  if constexpr (VAR != 6) { QK_LD(0, 0); QV_LD(0); }
#pragma unroll
  for (int g = 0; g < NG; ++g) {
    if constexpr (VAR != 6) { if (g + 1 < NG) QK_LD((g + 1) & 1, g + 1); }
    SBAR();
    ATT_PRIO(1);
#pragma unroll
    for (int dd = 0; dd < 2; ++dd) { const int d0 = 2 * g + dd; const bf16x8 q = d0 < NR ? qr[d0 < NR ? d0 : 0] : qv[dd];
      p0 = __builtin_amdgcn_mfma_f32_32x32x16_bf16(kb[g & 1][2 * dd], q, p0, 0, 0, 0);
      p1 = __builtin_amdgcn_mfma_f32_32x32x16_bf16(kb[g & 1][2 * dd + 1], q, p1, 0, 0, 0); }
    ATT_PRIO(0);
    if constexpr (VAR != 6) if (g + 1 < NG) QV_LD(g + 1);
    SBAR();
  }
#undef QV_LD
#undef QK_LD
}
__device__ __forceinline__ int v_st(int k, int c) { const int kk = (k & ~0xC) | ((k & 4) << 1) | ((k & 8) >> 1); return ((kk >> 3) * 4 + (c >> 5)) * 512 + ((kk & 7) * 32 + (c & 31)) * 2; }
__device__ __forceinline__ int v_rd_base(int lane) { return ((lane & 3) << 3) | (((lane >> 2) & 3) << 6) | (((lane >> 4) & 1) << 5) | (((lane >> 5) & 1) << 8); }
constexpr int v_rd_off(int d0, int ks, int half) { return d0 * 512 + ks * 4096 + half * 2048; }
typedef short v4i16_t __attribute__((ext_vector_type(4)));
__device__ __forceinline__ s16x4 vtr(int addr) { return __builtin_bit_cast(s16x4, __builtin_amdgcn_ds_read_tr16_b64_v4i16(reinterpret_cast<LAS v4i16_t*>(addr))); }
template <int VAR = 0>
__device__ __forceinline__ void pv_d0(f32x16* o, int vb, bf16x8 pa0, bf16x8 pa1, bf16x8 pa2, bf16x8 pa3) {
  s16x4 vf[2][8];
  if constexpr (VAR == 7) { _Pragma("unroll") for (int i = 0; i < 2; ++i) _Pragma("unroll") for (int j = 0; j < 8; ++j) vf[i][j] = (s16x4){(short)pa0[0], (short)pa0[1], (short)pa1[0], (short)pa1[1]}; }
#define PV_LD(buf_, d0_) do { _Pragma("unroll") for (int ks = 0; ks < 4; ++ks) { vf[buf_][2 * ks] = vtr(vb + v_rd_off(d0_, ks, 0)); vf[buf_][2 * ks + 1] = vtr(vb + v_rd_off(d0_, ks, 1)); } } while (0)
#define PK(L, H) (bf16x8){L[0], L[1], L[2], L[3], H[0], H[1], H[2], H[3]}
  if constexpr (VAR != 7) PV_LD(0, 0);
#pragma unroll
  for (int d0 = 0; d0 < 4; ++d0) {
    if constexpr (VAR != 7) { if (d0 + 1 < 4) PV_LD((d0 + 1) & 1, d0 + 1); }
    SBAR();
    ATT_PRIO(1);
    o[d0] = __builtin_amdgcn_mfma_f32_32x32x16_bf16(pa0, PK(vf[d0 & 1][0], vf[d0 & 1][1]), o[d0], 0, 0, 0);
    o[d0] = __builtin_amdgcn_mfma_f32_32x32x16_bf16(pa1, PK(vf[d0 & 1][2], vf[d0 & 1][3]), o[d0], 0, 0, 0);
    o[d0] = __builtin_amdgcn_mfma_f32_32x32x16_bf16(pa2, PK(vf[d0 & 1][4], vf[d0 & 1][5]), o[d0], 0, 0, 0);
    o[d0] = __builtin_amdgcn_mfma_f32_32x32x16_bf16(pa3, PK(vf[d0 & 1][6], vf[d0 & 1][7]), o[d0], 0, 0, 0);
    ATT_PRIO(0);
    SBAR();
  }
#undef PK
#undef PV_LD
}
template <int DQK> struct Shm { static constexpr int V = KVBLK * DV * 2, K = KVBLK * DQK * 2, QL = (DQK > 128 ? (DQK - 128) / 16 : 0), TOTAL = 3 * V + 3 * K + NW * 64 * 4 + QL * NW * 1024; };

template <int DQK, int LDQ, int LDK, int LDV, int LDO, int VAR = 0>
__device__ __forceinline__ void attn_dense_body(const bf16* __restrict__ Qb, const bf16* __restrict__ Kh, const bf16* __restrict__ Vh, bf16* __restrict__ Ob, int seq, char* lds) {
  constexpr int SHM_V = Shm<DQK>::V, SHM_K = Shm<DQK>::K, NQ = DQK / 16, QL = Shm<DQK>::QL, NR = NQ - QL, KP = DQK / 64  , KROWB = DQK * 2;
  const int tid = threadIdx.x, wid = __builtin_amdgcn_readfirstlane(tid >> 6), lane = tid & 63, r32 = lane & 31, hi = lane >> 5;
  char* K_lds = lds; char* V_lds = lds + 3 * SHM_K;
  float* ws = (float*)(lds + 3 * SHM_V + 3 * SHM_K) + wid * 64; float* li_l = ws; float* al_l = ws + 32;
  float m_reg = -1e30f, l_reg = 0; f32x16 o[4] = {}; bf16x8 qr[NR];
  char* qlds = lds + 3 * SHM_V + 3 * SHM_K + NW * 64 * 4 + wid * (QL * 1024) + lane * 16;
  const bf16* Qw = Qb + (long)(wid * QBLK + r32) * LDQ + hi * 8;
#pragma unroll
  for (int d0 = 0; d0 < NQ; ++d0) { const bf16x8 qv = *reinterpret_cast<const bf16x8*>(Qw + d0 * 16); if (d0 < NR) qr[d0 < NR ? d0 : 0] = qv; else *reinterpret_cast<bf16x8*>(qlds + (d0 - NR) * 1024) = qv; }
  unsigned koff[KP], voff[2];
#pragma unroll
  for (int i = 0; i < KP; ++i) { const int ob = 16 * (tid + 512 * i), row = ob / KROWB, cbs = ob % KROWB, cb = cbs ^ (kswz_f<DQK>(row) << 4); koff[i] = (unsigned)(row * LDK * 2 + cb); }
#pragma unroll
  for (int i = 0; i < 2; ++i) { const int ob = 16 * (tid + 512 * i), sub = ob >> 9, rem = ob & 511, kk = (sub >> 2) * 8 + (rem >> 6), cc = (sub & 3) * 32 + ((rem & 63) >> 1);
    const int k = (kk & ~0xC) | ((kk & 4) << 1) | ((kk & 8) >> 1); voff[i] = (unsigned)(k * LDV * 2 + cc * 2); }
  const int vb0 = (int)(uintptr_t)V_lds + v_rd_base(lane);
  const int NT = seq / KVBLK;
#define KDMA(t_, slot_) do { if constexpr (VAR == 2 || VAR == 3) break; const int _tt = (t_) < NT ? (t_) : NT - 1; const char* _b = (const char*)Kh + (size_t)_tt * (KVBLK * LDK * 2); \
    _Pragma("unroll") for (int _q = 0; _q < KP; ++_q) { unsigned _o = koff[_q]; asm volatile("" : "+v"(_o)); __builtin_amdgcn_global_load_lds((const unsigned*)(_b + _o), (LAS unsigned*)(K_lds + (slot_) * SHM_K + _q * 8192 + wid * 1024), 16, 0, 0); } } while (0)
#define VDMA(t_, slot_) do { if constexpr (VAR == 2 || VAR == 3) break; const int _tt = (t_) < NT ? (t_) : NT - 1; const char* _b = (const char*)Vh + (size_t)_tt * (KVBLK * LDV * 2); \
    _Pragma("unroll") for (int _q = 0; _q < 2; ++_q) { unsigned _o = voff[_q]; asm volatile("" : "+v"(_o)); __builtin_amdgcn_global_load_lds((const unsigned*)(_b + _o), (LAS unsigned*)(V_lds + (slot_) * SHM_V + _q * 8192 + wid * 1024), 16, 0, 0); } } while (0)
#define WAITB() do { asm volatile("s_waitcnt vmcnt(%0)" :: "n"(KP + 2) : "memory"); __builtin_amdgcn_s_barrier(); asm volatile("" ::: "memory"); SBAR(); } while (0)
#define RESC(a) do { if (__any((a) < 1.f)) { if (hi == 0) al_l[r32] = (a); asm volatile("s_waitcnt lgkmcnt(0)" ::: "memory"); \
    _Pragma("unroll") for (int d = 0; d < 4; ++d) _Pragma("unroll") for (int r = 0; r < 16; ++r) o[d][r] *= al_l[crow(r, hi)]; } } while (0)
  f32x16 pA0 = {}, pA1 = {}, pB0 = {}, pB1 = {}; float mnA, mnB, alA = 1.f, alB = 1.f; bf16x8 pa0 = {}, pa1 = {}, pa2 = {}, pa3 = {};
#define WAITN(n_) do { if constexpr (VAR != 2 && VAR != 3) asm volatile("s_waitcnt vmcnt(%0)" :: "n"(n_) : "memory"); } while (0)
#define BARX() do { if constexpr (VAR != 3) __builtin_amdgcn_s_barrier(); asm volatile("" ::: "memory"); SBAR(); } while (0)
#define H1(X0, X1, Y0, Y1, alY, HASPREV) do { if (HASPREV) { if constexpr (VAR == 1) finishSM_min(Y0, Y1, pa0, pa1, pa2, pa3); else finishSM(Y0, Y1, alY, l_reg, pa0, pa1, pa2, pa3); } \
    SBAR(); if constexpr (VAR != 4) qkt<DQK, QL, VAR>(X0, X1, K_lds + s0 * SHM_K, qr, qlds, r32, hi); SBAR(); } while (0)
#define H2(X0, X1, mnX, alX, HASPREV) do { if (HASPREV) { if constexpr (VAR != 5) pv_d0<VAR>(o, vb0 + s2 * SHM_V, pa0, pa1, pa2, pa3); } \
    if constexpr (VAR != 1) { partialSM(X0, X1, m_reg, mnX, alX); RESC(alX); } else { alX = 1.f; mnX = 0.f; } } while (0)
#define ROT() do { const int _r = s0; s0 = s1; s1 = s2; s2 = _r; } while (0)
#ifdef ATT_SETPRIO2
  if (wid >= 4) __builtin_amdgcn_s_setprio(1);
#endif
  KDMA(0, 0); KDMA(1, 1); VDMA(0, 0); KDMA(2, 2);
  WAITN(2 * KP + 2); BARX();
  int s0 = 0, s1 = 1, s2 = 2;
  if (wid < 4) {
#define STEP_A(t_, X0, X1, mnX, alX, Y0, Y1, alY, HASPREV) do { \
    H1(X0, X1, Y0, Y1, alY, HASPREV); WAITN(2 * KP + 2); BARX(); VDMA((t_) + 1, s1); \
    H2(X0, X1, mnX, alX, HASPREV);    WAITN(KP + 4);     BARX(); KDMA((t_) + 3, s0); ROT(); } while (0)
    for (int t = 0; t < NT; t += 2) {
      STEP_A(t, pA0, pA1, mnA, alA, pB0, pB1, alB, t > 0);
      STEP_A(t + 1, pB0, pB1, mnB, alB, pA0, pA1, alA, true);
    }
    if constexpr (VAR == 1) finishSM_min(pB0, pB1, pa0, pa1, pa2, pa3); else finishSM(pB0, pB1, alB, l_reg, pa0, pa1, pa2, pa3);
    WAITN(2 * KP + 2); BARX(); VDMA(NT + 1, s1);
    SBAR(); pv_d0<VAR>(o, vb0 + s2 * SHM_V, pa0, pa1, pa2, pa3);
    BARX();
#undef STEP_A
  } else {
    WAITN(2 * KP + 2); BARX(); VDMA(1, 1);
#define STEP_B(t_, X0, X1, mnX, alX, Y0, Y1, alY, HASPREV) do { \
    H1(X0, X1, Y0, Y1, alY, HASPREV); WAITN(KP + 4);     BARX(); KDMA((t_) + 3, s0); \
    H2(X0, X1, mnX, alX, HASPREV);    WAITN(2 * KP + 2); BARX(); VDMA((t_) + 2, s2); ROT(); } while (0)
    for (int t = 0; t < NT; t += 2) {
      STEP_B(t, pA0, pA1, mnA, alA, pB0, pB1, alB, t > 0);
      STEP_B(t + 1, pB0, pB1, mnB, alB, pA0, pA1, alA, true);
    }
    if constexpr (VAR == 1) finishSM_min(pB0, pB1, pa0, pa1, pa2, pa3); else finishSM(pB0, pB1, alB, l_reg, pa0, pa1, pa2, pa3);
    BARX();
    SBAR(); pv_d0<VAR>(o, vb0 + s2 * SHM_V, pa0, pa1, pa2, pa3);
#undef STEP_B
  }
#ifdef ATT_SETPRIO2
  __builtin_amdgcn_s_setprio(0);
#endif
  if (hi == 0) li_l[r32] = l_reg; asm volatile("s_waitcnt lgkmcnt(0)" ::: "memory");
  float rli[16];
#pragma unroll
  for (int r = 0; r < 16; ++r) rli[r] = __builtin_amdgcn_rcpf(li_l[crow(r, hi)]);
  int lane_e = lane; asm volatile("" : "+v"(lane_e));
  char* Ow = (char*)(Ob + (long)(wid * QBLK) * LDO);
  const unsigned ob0 = (unsigned)((4 * (lane_e >> 5)) * LDO + (lane_e & 31)) * 2u;
#pragma unroll
  for (int r = 0; r < 16; ++r) { const unsigned orow = (unsigned)(((r & 3) + 8 * (r >> 2)) * LDO) * 2u;
#pragma unroll
    for (int d0 = 0; d0 < 4; ++d0) *(bf16*)(Ow + (ob0 + orow + d0 * 64)) = f2bf(o[d0][r] * rli[r]); }
  asm volatile("s_waitcnt vmcnt(0)" ::: "memory"); __builtin_amdgcn_s_barrier(); asm volatile("" ::: "memory");
  (void)mnA; (void)mnB;
#undef KDMA
#undef VDMA
#undef WAITB
#undef RESC
#undef WAITN
#undef BARX
#undef H1
#undef H2
#undef ROT
}
}
constexpr size_t MiB = 1u << 20;
constexpr size_t WS_CTL = 0, CTL_ZERO_BYTES = 1 * MiB;
constexpr size_t WS_MODS = 1 * MiB;
constexpr size_t WS_TAB_RET = 2 * MiB;
constexpr size_t WS_TAB_A128 = 4 * MiB + 512 * 1024;
constexpr size_t WS_TAB_A64 = WS_TAB_A128 + 16384;
constexpr size_t WS_WABIN = 6 * MiB, WS_WABOUT = 12 * MiB, WS_WMLAIN = 14 * MiB, WS_WUQ = 16 * MiB, WS_WUKV = 18 * MiB, WS_WMLAOUT = 19 * MiB;
constexpr size_t WS_WUP = 22 * MiB, WS_WDOWN = 278 * MiB;
constexpr size_t WS_X = 406 * MiB, WS_ACC = 542 * MiB, WS_H = 678 * MiB, WS_P = 746 * MiB, WS_MIX = 950 * MiB;
constexpr size_t WS_KZTF = 1018 * MiB, WS_KZTB = 1052 * MiB, WS_VBT = 1086 * MiB, WS_ST = 1120 * MiB;
constexpr size_t WS_LTOK = 1188 * MiB, WS_LGATE = 1205 * MiB, WS_TOKSLOT = 1222 * MiB, WS_ACT = 1223 * MiB, WS_YK = 1511 * MiB, WS_END = 1799 * MiB;
constexpr size_t WS_PM = WS_P, WS_CQ = WS_P + 51 * MiB, WS_CKV = WS_CQ + 25 * MiB + 512 * 1024, WS_QM = WS_CKV + 17 * MiB;
constexpr size_t WS_KM = WS_KZTF, WS_VM = WS_ST;
constexpr size_t WS_SS = WS_CQ;
static_assert(WS_QM + (size_t)R * UQ_N * 2 <= WS_MIX, "MLA overlay fits in P");
static_assert(WS_KM + (size_t)R * UQ_N * 2 <= WS_ST && WS_VM + (size_t)R * 1024 * 2 <= WS_LTOK, "MLA K/V overlay");
static_assert(WS_ACT + (size_t)NSLOT_MAX * 1024 * 2 <= WS_YK && WS_YK + (size_t)NSLOT_MAX * 1024 * 2 <= WS_END, "MoE buffers");
constexpr int CW_TMO = 0, CW_BAR = 4096, CW_CNT = 16384;

constexpr int RING_BYTES = 131072;
constexpr int ATT_BYTES = 157696;
constexpr int XTRA_OFF = RING_BYTES;
constexpr int MISC_OFF = ATT_BYTES;
constexpr int TMAP_OFF = ATT_BYTES + 1024;
constexpr int LDS_BYTES = ATT_BYTES + 2048;
static_assert(att::Shm<192>::TOTAL <= ATT_BYTES && att::Shm<128>::TOTAL <= ATT_BYTES && LDS_BYTES <= 163840, "LDS map");

#define XB_TMO      128
#define XB_XCNT(j)  (256  + 64 * (j))
#define XB_XSUB(j)  (1280 + 64 * (j))
#define XB_XGEN(j)  (2304 + 64 * (j))
#define XB_TOP      3328
#define XB_TOPGEN   3392
#define XCD_BAR_WORDS 3456
#define XB_SPIN_CAP (1u << 22)
__device__ __forceinline__ unsigned xb_ld(unsigned* p)              { return __hip_atomic_load(p, __ATOMIC_RELAXED, __HIP_MEMORY_SCOPE_AGENT); }
__device__ __forceinline__ unsigned xb_add(unsigned* p, unsigned v) { return __hip_atomic_fetch_add(p, v, __ATOMIC_RELAXED, __HIP_MEMORY_SCOPE_AGENT); }
__device__ __forceinline__ unsigned xb_xcc_id() { return (unsigned)__builtin_amdgcn_s_getreg((3 << 11) | 20) & 0xFu; }
#define XB_SPIN(cond, bar) do { unsigned _sp = 0; while (cond) { __builtin_amdgcn_s_sleep(1); \
    if ((++_sp & 255u) == 0u) { if (xb_ld(&(bar)[XB_TMO])) break; if (_sp > XB_SPIN_CAP) { atomicAdd(&(bar)[XB_TMO], 1u); break; } } } } while (0)
struct XcdBarrier { unsigned* bar; unsigned x; volatile LAS unsigned* st; };
__device__ __forceinline__ XcdBarrier xcd_barrier_post(unsigned* bar, volatile LAS unsigned* st) {
    XcdBarrier b; b.bar = bar; b.x = xb_xcc_id(); b.st = st;
    if (threadIdx.x == 0) (void)xb_add(&bar[XB_XCNT(b.x)], 1u);
    return b;
}
__device__ __forceinline__ void xcd_barrier_complete(unsigned* bar, unsigned x, unsigned& nloc, unsigned& nx) {
    const unsigned G = gridDim.x * gridDim.y * gridDim.z;
    unsigned sum, cnt, mine, sp = 0u;
    for (;;) {
        sum = 0u; cnt = 0u; mine = 0u;
#pragma unroll
        for (unsigned j = 0; j < 16; ++j) { const unsigned c = xb_ld(&bar[XB_XCNT(j)]); sum += c; cnt += (c > 0u) ? 1u : 0u; mine = (j == x) ? c : mine; }
        if (sum == G) break;
        __builtin_amdgcn_s_sleep(1);
        if ((++sp & 255u) == 0u) { if (xb_ld(&bar[XB_TMO])) break; if (sp > XB_SPIN_CAP) { atomicAdd(&bar[XB_TMO], 1u); break; } }
    }
    nloc = mine > 0u ? mine : 1u; nx = cnt > 0u ? cnt : 1u;
}
__device__ __forceinline__ void xcd_barrier(const XcdBarrier& b) {
    asm volatile("s_waitcnt vmcnt(0)" ::: "memory");
    __syncthreads();
    if (threadIdx.x == 0) {
        unsigned* bar = b.bar;
        __builtin_amdgcn_s_waitcnt(0);
        unsigned nloc = b.st[0], nx = b.st[1];
        if (nloc == 0u) { xcd_barrier_complete(bar, b.x, nloc, nx); b.st[0] = nloc; b.st[1] = nx; }
        const unsigned old = xb_add(&bar[XB_XSUB(b.x)], 1u);
        const unsigned gen = old / nloc;
        if (old + 1u == (gen + 1u) * nloc) {
            __builtin_amdgcn_fence(__ATOMIC_RELEASE, "agent");
            asm volatile("s_waitcnt vmcnt(0)" ::: "memory");
            const unsigned og = xb_add(&bar[XB_TOP], 1u);
            const unsigned tg = og / nx;
            if (og + 1u == (tg + 1u) * nx) xb_add(&bar[XB_TOPGEN], 1u);
            else XB_SPIN(xb_ld(&bar[XB_TOPGEN]) == tg, bar);
            __builtin_amdgcn_fence(__ATOMIC_ACQUIRE, "agent");
            xb_add(&bar[XB_XGEN(b.x)], 1u);
            asm volatile("s_waitcnt vmcnt(0)" ::: "memory");
        } else {
            XB_SPIN(xb_ld(&bar[XB_XGEN(b.x)]) == gen, bar);
            __builtin_amdgcn_fence(__ATOMIC_ACQUIRE, "agent");
            asm volatile("s_waitcnt vmcnt(0)" ::: "memory");
        }
    }
    __syncthreads();
}

struct Args { const float* in[28]; float* out; unsigned char* ws; int ph_lo, ph_hi; };
struct Ctx { LAS unsigned char* lds; int tid, lane, wave, vcu, G, gw, NGW; };
enum { I_X = 0, I_C, I_CTX, I_CCTX, I_ADAW, I_ADAB, I_LN1G, I_LN1B, I_LN2G, I_LN2B, I_ABWIN, I_ABQN, I_ABKN, I_ABLD, I_ABGN, I_ABWOUT,
       I_MLAWIN, I_MLAQN, I_MLAKVN, I_MLAWUQ, I_MLAWUKV, I_MLAWOUT, I_RW, I_RB, I_WUP, I_BUP, I_WDOWN, I_BDOWN };
template <int MAP> __device__ __forceinline__ int colmap(int r) {
    if constexpr (MAP == 0) return r;
    else if constexpr (MAP == 1) { const int t = r >> 8, cc = r & 255; return cc < 128 ? t * 128 + cc : 1024 + t * 128 + (cc - 128); }
    else if constexpr (MAP == 2) {
        if (r < 384) return r;
        if (r < 448) { const int t = r - 384, wc = t >> 5, fq = (t >> 3) & 3, n = (t >> 2) & 1, k = t & 3; return 640 + 32 * wc + 16 * n + 4 * fq + k; }
        if (r < 512) return -1;
        return 384 + (r - 512);
    }
    else {
        if (r < 1024) { const int h = r >> 7, i = r & 127; return h * 192 + i; }
        const int rr = r - 1024, t = rr >> 8, cc = rr & 255, bj = cc >> 7, c2 = cc & 127, head = 4 * t + (c2 >> 5), j = c2 & 31;
        return head * 192 + 128 + (j < 16 ? j : 16 + j) + (bj ? 16 : 0);
    }
}
template <int MAP> __device__ __forceinline__ void tr_item(const float* __restrict__ W, int K, int N, bf16* __restrict__ WT, LAS float* scr, int item, int nblk, int lane, const float* __restrict__ gk = nullptr) {
    const int kb = item / nblk, nb = item % nblk, k0 = 64 * kb, n0 = 32 * nb;
    const int col = colmap<MAP>(n0 + (lane & 31));
    const float* src = W + (size_t)(k0 + (lane >> 5)) * N + (col >= 0 ? col : 0);
    float v[32];
#pragma unroll
    for (int i = 0; i < 32; ++i) v[i] = src[(size_t)(2 * i) * N];
#pragma unroll
    for (int i = 0; i < 32; ++i) { const int kk = 2 * i + (lane >> 5); float x = col >= 0 ? v[i] : 0.f; if (gk) x *= gk[k0 + kk]; scr[kk * 33 + (lane & 31)] = x; }
    LDS_WAIT(); asm volatile("" ::: "memory");
    const int c8 = lane & 7;
#pragma unroll
    for (int j = 0; j < 4; ++j) { const int n = (lane >> 3) + 8 * j; const LAS float* s = scr + (8 * c8) * 33 + n;
        u32x4 o; o.x = cvt_pk_nv(s[0 * 33], s[1 * 33]); o.y = cvt_pk_nv(s[2 * 33], s[3 * 33]); o.z = cvt_pk_nv(s[4 * 33], s[5 * 33]); o.w = cvt_pk_nv(s[6 * 33], s[7 * 33]);
        *(u32x4*)(WT + (size_t)(n0 + n) * K + k0 + 8 * c8) = o; }
    LDS_WAIT(); asm volatile("" ::: "memory");
}
#ifndef CV_DEFER
#define CV_DEFER 1
#endif
constexpr int CV_IUP = 16 * 64, CV_IDN = 16 * 32, CV_TOTAL = 32 * CV_IUP + 32 * CV_IDN;
__device__ __forceinline__ void conv_l1(const Args& a, const Ctx& c, int first, int count) {
    LAS float* scr = (LAS float*)(c.lds + c.wave * 16384);
    int end = first + count; if (end > CV_TOTAL) end = CV_TOTAL;
    for (int it = first + c.wave; it < end; it += 8) {
        if (it < 32 * CV_IUP) { const int m = 32 + it / CV_IUP; tr_item<1>(a.in[I_WUP] + (size_t)m * 1024 * 2048, 1024, 2048, (bf16*)(a.ws + WS_WUP) + (size_t)m * 2048 * 1024, scr, it % CV_IUP, 64, c.lane); }
        else { const int r = it - 32 * CV_IUP, m = 32 + r / CV_IDN; tr_item<0>(a.in[I_WDOWN] + (size_t)m * 1024 * 1024, 1024, 1024, (bf16*)(a.ws + WS_WDOWN) + (size_t)m * 1024 * 1024, scr, r % CV_IDN, 32, c.lane); }
    }
}
__device__ __forceinline__ void conv_tail(const Args& a, const Ctx& c, int& done, int rank, int rem, int n) {
#if CV_DEFER
    if (rem <= 0 || rem >= c.G || n <= 0) return;
    if (rank >= rem) { __syncthreads(); conv_l1(a, c, done + (rank - rem) * n, n); }
    done += (c.G - rem) * n; if (done > CV_TOTAL) done = CV_TOTAL;
#endif
}
__device__ __forceinline__ void conv_rest(const Args& a, const Ctx& c, int& done) {
#if CV_DEFER
    const int left = CV_TOTAL - done; if (left <= 0) return;
    const int per = (left + c.G - 1) / c.G;
    __syncthreads(); conv_l1(a, c, done + c.vcu * per, per); __syncthreads();
    done = CV_TOTAL;
#endif
}
__device__ __forceinline__ void ph0_prologue(const Args& a, const Ctx& c) {
    unsigned char* ws = a.ws;
    float* mods = (float*)(ws + WS_MODS);
    {
        LAS float* sc = (LAS float*)c.lds;
        LAS float* part = (LAS float*)(c.lds + 40960);
        for (int i = c.tid; i < 9 * 1024; i += 512) { const float v = (i < 8192) ? a.in[I_C][i] : a.in[I_CCTX][i - 8192]; sc[i] = v / (1.f + expf(-v)); }
        __syncthreads();
        for (int task = blockIdx.x; task < 192; task += c.G) {
            const int l = task / 96, j = (task % 96) * 64 + c.lane;
            const float* W = a.in[I_ADAW] + (size_t)l * 1024 * 6144 + (size_t)(128 * c.wave) * 6144 + j;
            float acc[9];
#pragma unroll
            for (int b = 0; b < 9; ++b) acc[b] = 0.f;
#pragma unroll 1
            for (int d0 = 0; d0 < 128; d0 += 32) { float w[32];
#pragma unroll
                for (int i = 0; i < 32; ++i) w[i] = W[(size_t)(d0 + i) * 6144];
#pragma unroll
                for (int i = 0; i < 32; ++i)
#pragma unroll
                    for (int b = 0; b < 9; ++b) acc[b] = fmaf(sc[b * 1024 + 128 * c.wave + d0 + i], w[i], acc[b]); }
#pragma unroll
            for (int b = 0; b < 9; ++b) part[(c.wave * 9 + b) * 64 + c.lane] = acc[b];
            __syncthreads();
            for (int i = c.tid; i < 9 * 64; i += 512) { float sum = 0.f;
#pragma unroll
                for (int w8 = 0; w8 < 8; ++w8) sum += part[w8 * 576 + i];
                const int b = i >> 6, jj = (task % 96) * 64 + (i & 63);
                mods[(size_t)(l * 9 + b) * 6144 + jj] = sum + a.in[I_ADAB][l * 6144 + jj]; }
            __syncthreads();
        }
    }
    {
        float2* ret = (float2*)(ws + WS_TAB_RET); float2* a128 = (float2*)(ws + WS_TAB_A128); float2* a64 = (float2*)(ws + WS_TAB_A64);
        const int gt = c.gw * 64 + c.lane, NT = c.NGW * 64;
        for (int i = gt; i < SP * 64; i += NT) { const int pos = i >> 6, f = i & 63; const double ang = (double)pos * pow(10000.0, -(double)f / 64.0); ret[i] = make_float2((float)cos(ang), (float)sin(ang)); }
        for (int i = gt; i < 64 * 32; i += NT) { const int pos = i >> 5, f = i & 31; const double ang = (double)pos * pow(10000.0, -(double)f / 32.0); a128[i] = make_float2((float)cos(ang), (float)sin(ang)); }
        for (int i = gt; i < 64 * 16; i += NT) { const int pos = i >> 4, f = i & 15; const double ang = (double)pos * pow(10000.0, -(double)f / 16.0); a64[i] = make_float2((float)cos(ang), (float)sin(ang)); }
    }
    {
        LAS float* scr = (LAS float*)(c.lds + c.wave * 16384);
        constexpr int I0 = 16 * 96, I1 = 16 * 32, I2 = 16 * 24, I3 = 6 * 48, I4 = 4 * 64, I5 = 16 * 32, IUP = 16 * 64, IDN = 16 * 32;
#if CV_DEFER
        constexpr int NMAT = 32;
#else
        constexpr int NMAT = 64;
#endif
        constexpr int NITEMS = I0 + I1 + I2 + I3 + I4 + I5 + NMAT * IUP + NMAT * IDN;
        for (int it = c.gw; it < NITEMS; it += c.NGW) {
            int r = it;
            if (r < I0) { tr_item<0>(a.in[I_ABWIN], 1024, AB_IN, (bf16*)(ws + WS_WABIN), scr, r, 96, c.lane); continue; } r -= I0;
            if (r < I1) { tr_item<0>(a.in[I_ABWOUT], 1024, 1024, (bf16*)(ws + WS_WABOUT), scr, r, 32, c.lane); continue; } r -= I1;
            if (r < I2) { tr_item<2>(a.in[I_MLAWIN], 1024, MLA_IN, (bf16*)(ws + WS_WMLAIN), scr, r, 24, c.lane); continue; } r -= I2;
            if (r < I3) { tr_item<3>(a.in[I_MLAWUQ], MLA_QL, UQ_N, (bf16*)(ws + WS_WUQ), scr, r, 48, c.lane, a.in[I_MLAQN]); continue; } r -= I3;
            if (r < I4) { tr_item<0>(a.in[I_MLAWUKV], MLA_KVL, UKV_N, (bf16*)(ws + WS_WUKV), scr, r, 64, c.lane, a.in[I_MLAKVN]); continue; } r -= I4;
            if (r < I5) { tr_item<0>(a.in[I_MLAWOUT], 1024, 1024, (bf16*)(ws + WS_WMLAOUT), scr, r, 32, c.lane); continue; } r -= I5;
            if (r < NMAT * IUP) { const int m = r / IUP; tr_item<1>(a.in[I_WUP] + (size_t)m * 1024 * 2048, 1024, 2048, (bf16*)(ws + WS_WUP) + (size_t)m * 2048 * 1024, scr, r % IUP, 64, c.lane); continue; } r -= NMAT * IUP;
            { const int m = r / IDN; tr_item<0>(a.in[I_WDOWN] + (size_t)m * 1024 * 1024, 1024, 1024, (bf16*)(ws + WS_WDOWN) + (size_t)m * 1024 * 1024, scr, r % IDN, 32, c.lane); }
        }
    }
}

__device__ __forceinline__ void ph1_mod0(const Args& a, const Ctx& c) {
    const float* mods = (const float*)(a.ws + WS_MODS); bf16* H = (bf16*)(a.ws + WS_H);
#define P1_SRC(row_) (((row_) % SP) < NCTX ? a.in[I_CTX] + ((size_t)((row_) / SP) * NCTX + ((row_) % SP)) * D : a.in[I_X] + ((size_t)((row_) / SP) * SEQ + (((row_) % SP) - NCTX)) * D)
    f32x4 xn[4];
    if (c.gw < R) { const float* src = P1_SRC(c.gw);
#pragma unroll
        for (int j = 0; j < 4; ++j) xn[j] = *(const f32x4*)(src + 4 * c.lane + 256 * j); }
    for (int row = c.gw; row < R; row += c.NGW) {
        f32x4 x[4];
#pragma unroll
        for (int j = 0; j < 4; ++j) x[j] = xn[j];
        if (row + c.NGW < R) { const float* src = P1_SRC(row + c.NGW);
#pragma unroll
            for (int j = 0; j < 4; ++j) xn[j] = *(const f32x4*)(src + 4 * c.lane + 256 * j); }
        const int b = row / SP, s = row % SP;
        const float* m = mods + (size_t)(s < NCTX ? 8 : b) * 6144;
        bf16* dst = H + (size_t)row * D;
#pragma unroll
        for (int j = 0; j < 4; ++j) { const int col = 4 * c.lane + 256 * j;
            const f32x4 sh = *(const f32x4*)(m + col), sl = *(const f32x4*)(m + 1024 + col);
            const f32x4 h = x[j] * (sl + 1.0f) + sh;
            u32x2 o; o.x = cvt_pk_bf16(h[0], h[1]); o.y = cvt_pk_bf16(h[2], h[3]); *(u32x2*)(dst + col) = o; }
    }
#undef P1_SRC
}

#ifdef NT_EPI
__device__ __forceinline__ void st16(void* base, unsigned off, u32x4 v) { __builtin_nontemporal_store(v, (u32x4*)((char*)base + off)); }
#else
__device__ __forceinline__ void st16(void* base, unsigned off, u32x4 v) { *(u32x4*)((char*)base + off) = v; }
#endif
__device__ __forceinline__ void st8(void* base, unsigned off, u32x2 v) { *(u32x2*)((char*)base + off) = v; }
__device__ __forceinline__ u32x4 pack2x4(const f32x4 v0, const f32x4 v1) { u32x4 w; w.x = cvt_pk_bf16(v0[0], v0[1]); w.y = cvt_pk_bf16(v0[2], v0[3]); w.z = cvt_pk_bf16(v1[0], v1[1]); w.w = cvt_pk_bf16(v1[2], v1[3]); return w; }
struct EpiStoreBf16 {
    static constexpr bool PERM = true; static constexpr int NST = 16;
    bf16* O; int ldc;
    __device__ __forceinline__ void operator()(const f32x4 (&acc)[2][2][4][2], const pg8::Unit& u, int wr, int wc, int fr, int fq) const {
        const unsigned rb = ((unsigned)(u.pm * 256 + wr * 64 + fr) * (unsigned)ldc + (unsigned)(u.pn * 256 + wc * 32 + 8 * fq)) * 2u;
#pragma unroll
        for (int ai = 0; ai < 2; ++ai)
#pragma unroll
            for (int m = 0; m < 4; ++m) { const unsigned ro = rb + (unsigned)((ai * 128 + m * 16) * ldc) * 2u;
#pragma unroll
                for (int bj = 0; bj < 2; ++bj) st16(O, ro + bj * 256, pack2x4(acc[ai][bj][m][0], acc[ai][bj][m][1])); }
    }
};
template <int L> struct EpiResid {
    static constexpr bool PERM = true;
    const float* xlat; const float* xctx; const bf16* X; const float* mods  ; bf16* ACC;
    __device__ __forceinline__ void operator()(const f32x4 (&acc)[2][2][4][2], const pg8::Unit& u, int wr, int wc, int fr, int fq) const {
        const int b = u.pm / 17, tt = u.pm % 17; const bool isc = (tt == 0);
        const float* src = nullptr; const bf16* srcb = nullptr; if constexpr (L == 0) src = isc ? xctx + (size_t)b * NCTX * D : xlat + ((size_t)b * SEQ + (size_t)(tt - 1) * 256) * D; else srcb = X + (size_t)u.pm * 256 * D;
        const float* m2 = mods + (size_t)(isc ? 8 : b) * 6144 + 2 * 1024;
        bf16* dst = ACC + (size_t)u.pm * 256 * D;
        const int col0 = u.pn * 256 + wc * 32 + 8 * fq;
        const unsigned rb = ((unsigned)(wr * 64 + fr) * D + (unsigned)col0);
        f32x4 mv[2][2];
#pragma unroll
        for (int bj = 0; bj < 2; ++bj)
#pragma unroll
            for (int n = 0; n < 2; ++n) mv[bj][n] = *(const f32x4*)(m2 + col0 + bj * 128 + n * 4);
#pragma unroll
        for (int ai = 0; ai < 2; ++ai)
#pragma unroll
            for (int m = 0; m < 4; ++m) { const unsigned ro = rb + (unsigned)((ai * 128 + m * 16) * D);
#pragma unroll
                for (int bj = 0; bj < 2; ++bj) { const unsigned o = ro + bj * 128; f32x4 x0, x1;
                    if constexpr (L == 0) { x0 = *(const f32x4*)(src + o); x1 = *(const f32x4*)(src + o + 4); }
                    else { const u32x4 w = *(const u32x4*)(srcb + o); x0 = (f32x4){bflo(w.x), bfhi(w.x), bflo(w.y), bfhi(w.y)}; x1 = (f32x4){bflo(w.z), bfhi(w.z), bflo(w.w), bfhi(w.w)}; }
                    st16(dst, o * 2u, pack2x4(x0 * DN_ALPHA + mv[bj][0] * acc[ai][bj][m][0], x1 * DN_ALPHA + mv[bj][1] * acc[ai][bj][m][1])); } }
    }
};
__device__ __forceinline__ void unpack8(const u32x4 w, float* v) { v[0] = bflo(w.x); v[1] = bfhi(w.x); v[2] = bflo(w.y); v[3] = bfhi(w.y); v[4] = bflo(w.z); v[5] = bfhi(w.z); v[6] = bflo(w.w); v[7] = bfhi(w.w); }
__device__ __forceinline__ u32x4 pack8(const float* v) { u32x4 w; w.x = cvt_pk_bf16(v[0], v[1]); w.y = cvt_pk_bf16(v[2], v[3]); w.z = cvt_pk_bf16(v[4], v[5]); w.w = cvt_pk_bf16(v[6], v[7]); return w; }
__device__ __forceinline__ float log_gamma_of(float log_decay) { return (float)log1p(-exp((double)log_decay)); }

__device__ __forceinline__ void ph3_post(const Args& a, const Ctx& c) {
    bf16* P = (bf16*)(a.ws + WS_P);
    const float2* RET = (const float2*)(a.ws + WS_TAB_RET); const float2* A128 = (const float2*)(a.ws + WS_TAB_A128);
    const float* qn = a.in[I_ABQN]; const float* kn = a.in[I_ABKN]; const float* ld = a.in[I_ABLD];
    bf16* KZTF = (bf16*)(a.ws + WS_KZTF); bf16* KZTB = (bf16*)(a.ws + WS_KZTB); bf16* VBT = (bf16*)(a.ws + WS_VBT);
    LAS bf16* T0 = (LAS bf16*)c.lds; LAS bf16* T1 = T0 + 128 * 72;
    const int tok = c.tid >> 3, j = c.tid & 7;
    constexpr float QK_SCALE = 0.08838834764831845f;
#define P3_COLS(kind_, c1_, c2_) do { if ((kind_) < 6) { const int _x = j < 4 ? 8 * j : 64 + 8 * (j - 4); c1_ = (kind_) * 128 + _x; c2_ = c1_ + 32; } \
        else if ((kind_) < 14) { c1_ = 1024 + ((kind_) - 6) * 128 + 8 * j; c2_ = c1_ + 64; } else { c1_ = 2048 + ((kind_) - 14) * 128 + 16 * j; c2_ = c1_ + 8; } } while (0)
    u32x4 nw1 = (u32x4){0u, 0u, 0u, 0u}, nw2 = nw1;
    if (c.vcu < (R / 64) * 18) { const int rb = c.vcu / 18, kind = c.vcu % 18; int c1, c2; P3_COLS(kind, c1, c2); const bf16* pr = P + (size_t)(rb * 64 + tok) * AB_IN; nw1 = *(const u32x4*)(pr + c1); nw2 = *(const u32x4*)(pr + c2); }
    for (int u = c.vcu; u < (R / 64) * 18; u += c.G) {
        const int rb = u / 18, kind = u % 18;
        const int row0 = rb * 64, b0 = row0 / SP, s0 = row0 % SP;
        const int row = row0 + tok, s = s0 + tok; const bool lat = s0 >= NCTX;
        bf16* prow = P + (size_t)row * AB_IN;
        const u32x4 cw1 = nw1, cw2 = nw2;
        if (u + c.G < (R / 64) * 18) { const int rbn = (u + c.G) / 18, kn = (u + c.G) % 18; int c1, c2; P3_COLS(kn, c1, c2); const bf16* pr = P + (size_t)(rbn * 64 + tok) * AB_IN; nw1 = *(const u32x4*)(pr + c1); nw2 = *(const u32x4*)(pr + c2); }
        if (kind < 14) {
            int cb, x1c, x2c;
            if (kind < 6) { cb = kind * 128; x1c = j < 4 ? 8 * j : 64 + 8 * (j - 4); x2c = x1c + 32; }
            else { cb = 1024 + (kind - 6) * 128; x1c = 8 * j; x2c = 64 + 8 * j; }
            float v1[8], v2[8], o1[8], o2[8];
            unpack8(cw1, v1); unpack8(cw2, v2);
            if (kind < 6) {
                float ss = 0.f;
#pragma unroll
                for (int i = 0; i < 8; ++i) ss += v1[i] * v1[i] + v2[i] * v2[i];
                ss += __shfl_xor(ss, 1); ss += __shfl_xor(ss, 2); ss += __shfl_xor(ss, 4);
                const float rinv = rsqrtf(ss * (1.f / 128.f) + 1e-6f);
                const float* g = kind < 4 ? qn : kn;
#pragma unroll
                for (int i = 0; i < 8; ++i) { v1[i] *= rinv * g[x1c + i]; v2[i] *= rinv * g[x2c + i]; }
                if (lat) { const int t = s - NCTX; const int pos = j < 4 ? t / GRID_W : t % GRID_W; const float2* cs = A128 + pos * 32 + (j & 3) * 8;
#pragma unroll
                    for (int i = 0; i < 8; ++i) { const float2 q = cs[i]; o1[i] = v1[i] * q.x - v2[i] * q.y; o2[i] = v1[i] * q.y + v2[i] * q.x; } }
                else {
#pragma unroll
                    for (int i = 0; i < 8; ++i) { o1[i] = v1[i]; o2[i] = v2[i]; } }
                if (kind < 4) {
#pragma unroll
                    for (int i = 0; i < 8; ++i) { o1[i] *= QK_SCALE; o2[i] *= QK_SCALE; } }
            } else {
                const float2* cs = RET + (size_t)s * 64 + 8 * j;
#pragma unroll
                for (int i = 0; i < 8; ++i) { const float2 q = cs[i]; o1[i] = v1[i] * q.x - v2[i] * q.y; o2[i] = v1[i] * q.y + v2[i] * q.x; }
                if (kind < 10) {
#pragma unroll
                    for (int i = 0; i < 8; ++i) { o1[i] *= QK_SCALE; o2[i] *= QK_SCALE; } }
            }
            *(u32x4*)(prow + cb + x1c) = pack8(o1); *(u32x4*)(prow + cb + x2c) = pack8(o2);
            if (kind >= 10) {
                const int h = kind - 10;
                const float lgf = log_gamma_of(ld[h]), lgb = log_gamma_of(ld[4 + h]);
                const int cpos = s & 127;
                const float zf = expf(lgf * (float)(127 - cpos)), zb = expf(lgb * (float)cpos);
#pragma unroll
                for (int i = 0; i < 8; ++i) { T0[(x1c + i) * 72 + tok] = f2bf(o1[i] * zf); T0[(x2c + i) * 72 + tok] = f2bf(o2[i] * zf);
                                              T1[(x1c + i) * 72 + tok] = f2bf(o1[i] * zb); T1[(x2c + i) * 72 + tok] = f2bf(o2[i] * zb); }
                __syncthreads();
#pragma unroll
                for (int q = 0; q < 2; ++q) { const int p = c.tid + 512 * q, d = p >> 3, seg = p & 7;
                    const size_t go = ((size_t)((b0 * 4 + h) * 128 + d)) * SP + s0 + seg * 8;
                    *(u32x4*)(KZTF + go) = *(const LAS u32x4*)(T0 + d * 72 + seg * 8);
                    *(u32x4*)(KZTB + go) = *(const LAS u32x4*)(T1 + d * 72 + seg * 8); }
                __syncthreads();
            }
        } else {
            const int h = kind - 14, cb = 2048 + h * 128;
            const u32x4 w0 = cw1, w1 = cw2; (void)cb;
            const unsigned ww[8] = {w0.x, w0.y, w0.z, w0.w, w1.x, w1.y, w1.z, w1.w};
#pragma unroll
            for (int i = 0; i < 8; ++i) { T0[(16 * j + 2 * i) * 72 + tok] = (bf16)(ww[i] & 0xffffu); T0[(16 * j + 2 * i + 1) * 72 + tok] = (bf16)(ww[i] >> 16); }
            __syncthreads();
#pragma unroll
            for (int q = 0; q < 2; ++q) { const int p = c.tid + 512 * q, d = p >> 3, seg = p & 7;
                *(u32x4*)(VBT + ((size_t)((b0 * 4 + h) * 128 + d)) * SP + s0 + seg * 8) = *(const LAS u32x4*)(T0 + d * 72 + seg * 8); }
            __syncthreads();
        }
    }
#undef P3_COLS
}

#define MFMA16(a_, b_, c_) __builtin_amdgcn_mfma_f32_16x16x32_bf16((a_), (b_), (c_), 0, 0, 0)
__device__ __forceinline__ void ph4_r1(const Args& a, const Ctx& c) {
    const float* ld = a.in[I_ABLD];
    bf16* ST = (bf16*)(a.ws + WS_ST);
    const int fr = c.lane & 15, fq = c.lane >> 4;
    constexpr int GS = 6, VPITCH = GS * 256 + 16;
    LAS unsigned char* VS = c.lds;
#define R1_JN(n_) (dir == 0 ? (n_) : ((n_) < 2 ? 1 - (n_) : 35 - (n_)))
    for (int task = blockIdx.x; task < 256; task += c.G) {
        const int eq = task & 3, dir = (task >> 2) & 1, h = (task >> 3) & 3, b = task >> 5;
        const bf16* KZ = (const bf16*)(a.ws + (dir ? WS_KZTB : WS_KZTF)) + (size_t)(b * 4 + h) * 128 * SP;
        const bf16* VT = (const bf16*)(a.ws + WS_VBT) + (size_t)(b * 4 + h) * 128 * SP;
        const float decay = expf(log_gamma_of(ld[dir * 4 + h]) * 128.f);
        const int d0 = 16 * c.wave;
        f32x4 st[2] = {(f32x4){0.f, 0.f, 0.f, 0.f}, (f32x4){0.f, 0.f, 0.f, 0.f}};
        bf16* STb = ST + ((size_t)((b * 4 + h) * 2 + dir) * NCHUNK) * 16384;
        const bf16* kp0 = KZ + (size_t)(d0 + fr) * SP + fq * 8;
#pragma unroll 1
        for (int g0 = 0; g0 < NCHUNK; g0 += GS) {
            const int ns = NCHUNK - g0 < GS ? NCHUNK - g0 : GS;
            bf16x8 kf[GS][4]; u32x4 vst[GS];
#pragma unroll
            for (int s8 = 0; s8 < GS; ++s8) { const int jn = R1_JN(g0 + (s8 < ns ? s8 : 0));
#pragma unroll
                for (int kk = 0; kk < 4; ++kk) kf[s8][kk] = *(const bf16x8*)(kp0 + jn * 128 + kk * 32); }
#pragma unroll
            for (int i = 0; i < GS; ++i) { const int p = c.tid + 512 * i, e = p / (GS * 16), cc = p % (GS * 16), s8 = cc >> 4, u = cc & 15; const int jn = R1_JN(g0 + (s8 < ns ? s8 : 0));
                vst[i] = *(const u32x4*)(VT + (size_t)(eq * 32 + e) * SP + jn * 128 + u * 8); }
            __syncthreads();
#pragma unroll
            for (int i = 0; i < GS; ++i) { const int p = c.tid + 512 * i, e = p / (GS * 16), cc = p % (GS * 16); *(LAS u32x4*)(VS + e * VPITCH + cc * 16) = vst[i]; }
            __syncthreads();
#pragma unroll
            for (int s8 = 0; s8 < GS; ++s8) if (s8 < ns) {
                const int jn = R1_JN(g0 + s8);
#pragma unroll
                for (int eb = 0; eb < 2; ++eb) { u32x2 w; w.x = cvt_pk_bf16(st[eb][0], st[eb][1]); w.y = cvt_pk_bf16(st[eb][2], st[eb][3]);
                    *(u32x2*)(STb + (size_t)jn * 16384 + (eq * 32 + eb * 16 + fr) * 128 + d0 + 4 * fq) = w; }
                f32x4 kv0 = (f32x4){0.f, 0.f, 0.f, 0.f}, kv1 = (f32x4){0.f, 0.f, 0.f, 0.f};
#pragma unroll
                for (int kk = 0; kk < 4; ++kk) { const int off = (s8 * 16 + kk * 4 + fq) * 16;
                    kv0 = MFMA16(kf[s8][kk], *(const LAS bf16x8*)(VS + fr * VPITCH + off), kv0);
                    kv1 = MFMA16(kf[s8][kk], *(const LAS bf16x8*)(VS + (16 + fr) * VPITCH + off), kv1); }
                st[0] = st[0] * decay + kv0; st[1] = st[1] * decay + kv1;
            }
        }
    }
#undef R1_JN
}
__device__ __forceinline__ void ph4_attn(const Args& a, const Ctx& c) {
    const bf16* P = (const bf16*)(a.ws + WS_P); bf16* MIX = (bf16*)(a.ws + WS_MIX);
    for (int task = c.vcu; task < 512 + 32; task += c.G) {
        int b, h, r0, seq;
        if (task < 512) { b = task >> 6; h = (task >> 4) & 3; r0 = b * SP + NCTX + (task & 15) * 256; seq = SP; }
        else { const int t2 = task - 512; b = t2 >> 2; h = t2 & 3; r0 = b * SP; seq = NCTX; }
        const int kvh = h >> 1;
        att::attn_dense_body<128, AB_IN, AB_IN, AB_IN, 1024>(P + (size_t)r0 * AB_IN + h * 128, P + (size_t)b * SP * AB_IN + 512 + kvh * 128, P + (size_t)b * SP * AB_IN + 768 + kvh * 128,
                                                             MIX + (size_t)r0 * 1024 + h * 128, seq, (char*)c.lds);
    }
}

__device__ __forceinline__ bf16x8 scale_frag(bf16x8 f, float s) {
    const u32x4 w = __builtin_bit_cast(u32x4, f); float v[8]; unpack8(w, v);
#pragma unroll
    for (int i = 0; i < 8; ++i) v[i] *= s;
    return __builtin_bit_cast(bf16x8, pack8(v));
}
__device__ __forceinline__ void ph5_r2(const Args& a, const Ctx& c) {
    const bf16* P = (const bf16*)(a.ws + WS_P); bf16* MIX = (bf16*)(a.ws + WS_MIX);
    const bf16* VBT = (const bf16*)(a.ws + WS_VBT); const bf16* ST = (const bf16*)(a.ws + WS_ST);
    const float* ld = a.in[I_ABLD]; const float* gn = a.in[I_ABGN];
    const int fr = c.lane & 15, fq = c.lane >> 4;
    LAS unsigned char* KC = c.lds; LAS unsigned char* VT = c.lds + 32768; LAS unsigned char* SF = c.lds + 65536; LAS unsigned char* SB = c.lds + 98304;
    LAS unsigned char* pl = KC + c.wave * 4096;
    constexpr float L2E = 1.4426950408889634f;
    constexpr int NTASK = NB * 4 * NCHUNK;
    u32x4 stg[16];
#define R2_GLOAD(task_) do { const int _jn = (task_) % NCHUNK, _bh = (task_) / NCHUNK, _b = _bh >> 2, _h = _bh & 3; const int _rb = _b * SP + _jn * 128; \
        _Pragma("unroll") for (int i = 0; i < 16; ++i) { const int q = (c.tid + 512 * i) & 2047, row = q >> 4, c16 = q & 15; const char* src; \
            if (i < 4) src = (const char*)(P + (size_t)(_rb + row) * AB_IN + 1536 + _h * 128) + c16 * 16; \
            else if (i < 8) src = (const char*)(VBT + ((size_t)(_bh * 128 + row)) * SP + _jn * 128) + c16 * 16; \
            else src = (const char*)(ST + ((size_t)(_bh * 2 + (i < 12 ? 0 : 1)) * NCHUNK + _jn) * 16384) + row * 256 + c16 * 16; \
            stg[i] = *(const u32x4*)src; } } while (0)
    for (int task = c.vcu; task < NTASK; task += c.G) {
        const int jn = task % NCHUNK, bh = task / NCHUNK, b = bh >> 2, h = bh & 3;
        const int rowbase = b * SP + jn * 128, c0 = 16 * c.wave;
        const float l2f = log_gamma_of(ld[h]) * L2E, l2b = log_gamma_of(ld[4 + h]) * L2E;
        R2_GLOAD(task);
        const bf16* qp = P + (size_t)(rowbase + c0 + fr) * AB_IN + 1024 + h * 128 + fq * 8;
        bf16x8 qf[4];
#pragma unroll
        for (int kk = 0; kk < 4; ++kk) qf[kk] = *(const bf16x8*)(qp + kk * 32);
        __syncthreads();
#pragma unroll
        for (int i = 0; i < 16; ++i) { const int q = (c.tid + 512 * i) & 2047, row = q >> 4, c16 = q & 15;
            *(LAS u32x4*)(c.lds + (i >> 2) * 32768 + row * 256 + ((c16 ^ (row & 15)) << 4)) = stg[i]; }
        __syncthreads();
#define R2_FRAG(base_, row_, kk_) (*(const LAS bf16x8*)((base_) + (row_) * 256 + ((((kk_) * 4 + fq) ^ ((row_) & 15)) << 4)))
        f32x4 sc[8];
#pragma unroll
        for (int nb = 0; nb < 8; ++nb) { sc[nb] = (f32x4){0.f, 0.f, 0.f, 0.f};
#pragma unroll
            for (int kk = 0; kk < 4; ++kk) sc[nb] = MFMA16(qf[kk], R2_FRAG(KC, nb * 16 + fr, kk), sc[nb]); }
        __syncthreads();
        bf16 gt[4][8];
#pragma unroll
        for (int i = 0; i < 4; ++i)
#pragma unroll
            for (int eb = 0; eb < 8; ++eb) gt[i][eb] = P[(size_t)(rowbase + c0 + fq * 4 + i) * AB_IN + 2560 + h * 128 + eb * 16 + fr];
#pragma unroll
        for (int nb = 0; nb < 8; ++nb)
#pragma unroll
            for (int i = 0; i < 4; ++i) { const int r = fq * 4 + i, cc = c0 + r, ss = nb * 16 + fr, diff = cc - ss;
                const float f = diff >= 0 ? __builtin_amdgcn_exp2f(l2f * (float)diff) : __builtin_amdgcn_exp2f(l2b * (float)(-diff));
                *(LAS bf16*)(pl + r * 256 + (((ss >> 3) ^ r) << 4) + (ss & 7) * 2) = f2bf(sc[nb][i] * f); }
        LDS_WAIT();
        bf16x8 pf[4];
#pragma unroll
        for (int kk = 0; kk < 4; ++kk) pf[kk] = R2_FRAG(pl, fr, kk);
        f32x4 o[8];
#pragma unroll
        for (int eb = 0; eb < 8; ++eb) { o[eb] = (f32x4){0.f, 0.f, 0.f, 0.f};
#pragma unroll
            for (int kk = 0; kk < 4; ++kk) o[eb] = MFMA16(pf[kk], R2_FRAG(VT, eb * 16 + fr, kk), o[eb]); }
        const float xf = __builtin_amdgcn_exp2f(l2f * (float)(c0 + fr + 1)), xb = __builtin_amdgcn_exp2f(l2b * (float)(128 - (c0 + fr)));
        {   bf16x8 qF[4];
#pragma unroll
            for (int kk = 0; kk < 4; ++kk) qF[kk] = scale_frag(qf[kk], xf);
#pragma unroll
            for (int eb = 0; eb < 8; ++eb)
#pragma unroll
                for (int kk = 0; kk < 4; ++kk) o[eb] = MFMA16(qF[kk], R2_FRAG(SF, eb * 16 + fr, kk), o[eb]); }
        {   bf16x8 qB[4];
#pragma unroll
            for (int kk = 0; kk < 4; ++kk) qB[kk] = scale_frag(qf[kk], xb);
#pragma unroll
            for (int eb = 0; eb < 8; ++eb)
#pragma unroll
                for (int kk = 0; kk < 4; ++kk) o[eb] = MFMA16(qB[kk], R2_FRAG(SB, eb * 16 + fr, kk), o[eb]); }
#pragma unroll
        for (int i = 0; i < 4; ++i) {
            float s1 = 0.f;
#pragma unroll
            for (int eb = 0; eb < 8; ++eb) s1 += o[eb][i];
            s1 += __shfl_xor(s1, 1); s1 += __shfl_xor(s1, 2); s1 += __shfl_xor(s1, 4); s1 += __shfl_xor(s1, 8);
            const float mean = s1 * (1.f / 128.f); float s2 = 0.f;
#pragma unroll
            for (int eb = 0; eb < 8; ++eb) { const float dlt = o[eb][i] - mean; s2 += dlt * dlt; }
            s2 += __shfl_xor(s2, 1); s2 += __shfl_xor(s2, 2); s2 += __shfl_xor(s2, 4); s2 += __shfl_xor(s2, 8);
            const float rstd = rsqrtf(s2 * (1.f / 128.f) + 1e-5f);
            const int row = rowbase + c0 + fq * 4 + i;
#pragma unroll
            for (int eb = 0; eb < 8; ++eb) { const int e = eb * 16 + fr; const float g = bf2f(gt[i][eb]);
                const float y = (o[eb][i] - mean) * rstd * gn[h * 128 + e] * (g / (1.f + __expf(-g)));
                MIX[(size_t)row * 1024 + 512 + h * 128 + e] = f2bf(y); }
        }
    }
#undef R2_GLOAD
#undef R2_FRAG
}
__device__ __forceinline__ void moe_setup_tiles(const Args& a, const Ctx& c, int L) {
    LAS int* misc = (LAS int*)(c.lds + MISC_OFF);
    const unsigned* cur = (const unsigned*)(a.ws + WS_CTL) + CW_CNT + 64 * L;
    __syncthreads();
    if (c.tid < 32) misc[64 + c.tid] = (int)__hip_atomic_load(cur + c.tid, __ATOMIC_RELAXED, __HIP_MEMORY_SCOPE_AGENT);
    __syncthreads();
    if (c.tid == 0) { int acc = 0; for (int e = 0; e < NE; ++e) { misc[e] = acc; acc += (misc[64 + e] + 255) >> 8; } misc[NE] = acc; }
    __syncthreads();
    {   LAS unsigned char* tmap = (LAS unsigned char*)(c.lds + TMAP_OFF);
        for (int t = c.tid; t < misc[NE]; t += 512) { int e = 0; while (misc[e + 1] <= t) ++e; tmap[t] = (unsigned char)e; } }
    __syncthreads();
}
template <bool GATHER_> struct MoeOrder {
    static constexpr bool GATHER = GATHER_;
    const LAS int* misc; const int* ltok; int nN, G, c, total;
    __device__ void init(const LAS int* misc_, const int* ltok_, int nN_, int G_, int c_) { misc = misc_; ltok = ltok_; nN = nN_; G = G_; c = c_; total = misc_[NE] * nN_; }
    __device__ bool next(int i, pg8::Unit& u) const {
        const int L0 = i * G + c; if (L0 >= total) return false;
        int L = L0;
#ifndef NO_MOE_XCD
        if ((G & 7) == 0) { const int q = total >> 3, r = total & 7, xcd = L0 & 7, off = L0 >> 3; L = (xcd < r ? xcd * (q + 1) : r * (q + 1) + (xcd - r) * q) + off; }
#endif
        const int mt = L / nN, nt = L % nN; const int e = ((const LAS unsigned char*)misc)[TMAP_OFF - MISC_OFF + mt];
        u.pm = mt; u.pn = nt; u.pb = e * nN + nt; u.e = e; return true;
    }
    __device__ __forceinline__ unsigned arow(const pg8::Unit& u, int r) const {
        int local = (u.pm - misc[u.e]) * 256 + r; if (local >= misc[64 + u.e]) local = 0;
        return (unsigned)ltok[(size_t)u.e * CAP + local];
    }
};
__device__ __forceinline__ float swiglu(float g, float l) {
    g = fminf(g, 7.0f); l = fminf(fmaxf(l, -7.0f), 7.0f);
    return g * __builtin_amdgcn_rcpf(1.f + __builtin_amdgcn_exp2f(-1.702f * 1.4426950408889634f * g)) * (l + 1.0f);
}
template <int XV = 0> struct EpiMoeUpT {
    static constexpr bool PERM = true;
    bf16* ACT; const float* bup  ;
    __device__ __forceinline__ void operator()(const f32x4 (&acc)[2][2][4][2], const pg8::Unit& u, int wr, int wc, int fr, int fq) const {
        const int col0 = u.pn * 128 + wc * 32 + 8 * fq; const float* bb = bup + (size_t)u.e * 2048 + col0;
        f32x4 bg[2], bl[2];
#pragma unroll
        for (int n = 0; n < 2; ++n) { bg[n] = *(const f32x4*)(bb + 4 * n); bl[n] = *(const f32x4*)(bb + 1024 + 4 * n); }
        const unsigned rb = ((unsigned)(u.pm * 256 + wr * 64 + fr) * 1024u + (unsigned)col0) * 2u;
#pragma unroll
        for (int ai = 0; ai < 2; ++ai)
#pragma unroll
            for (int m = 0; m < 4; ++m) { float v[8];
#pragma unroll
                for (int n = 0; n < 2; ++n)
#pragma unroll
                    for (int k = 0; k < 4; ++k) v[4 * n + k] = (XV == 2) ? acc[ai][0][m][n][k] + acc[ai][1][m][n][k] + bg[n][k] : swiglu(acc[ai][0][m][n][k] + bg[n][k], acc[ai][1][m][n][k] + bl[n][k]);
                if (XV == 3) __builtin_nontemporal_store(pack8(v), (u32x4*)((char*)ACT + (rb + (unsigned)((ai * 128 + m * 16) * 1024) * 2u)));
                else if (XV == 0 || v[0] == 12345.678f) st16(ACT, rb + (unsigned)((ai * 128 + m * 16) * 1024) * 2u, pack8(v)); }
    }
};
typedef EpiMoeUpT<0> EpiMoeUp;
template <int XV = 0> struct EpiMoeDownT {
    static constexpr bool PERM = true;
    bf16* YK; const float* bdn  ; const float* lgate; const LAS int* misc;
    __device__ __forceinline__ void operator()(const f32x4 (&acc)[2][2][4][2], const pg8::Unit& u, int wr, int wc, int fr, int fq) const {
        const int col0 = u.pn * 256 + wc * 32 + 8 * fq; const float* bb = bdn + (size_t)u.e * 1024 + col0;
        f32x4 bv[2][2];
#pragma unroll
        for (int bj = 0; bj < 2; ++bj)
#pragma unroll
            for (int n = 0; n < 2; ++n) bv[bj][n] = *(const f32x4*)(bb + bj * 128 + 4 * n);
        const int lbase = (u.pm - misc[u.e]) * 256 + wr * 64 + fr, cnt = misc[64 + u.e];
        const float* gp = lgate + (size_t)u.e * CAP;
        const unsigned rb = ((unsigned)(u.pm * 256 + wr * 64 + fr) * 1024u + (unsigned)col0) * 2u;
#pragma unroll
        for (int ai = 0; ai < 2; ++ai)
#pragma unroll
            for (int m = 0; m < 4; ++m) { const int local = lbase + ai * 128 + m * 16;
                const float g = (XV == 1 || XV == 3) ? 1.0f : (local < cnt ? *(const float*)((const char*)gp + (unsigned)local * 4u) : 0.f);
                const unsigned ro = rb + (unsigned)((ai * 128 + m * 16) * 1024) * 2u;
#pragma unroll
                for (int bj = 0; bj < 2; ++bj) { const u32x4 pk = pack2x4((acc[ai][bj][m][0] + bv[bj][0]) * g, (acc[ai][bj][m][1] + bv[bj][1]) * g); if (XV == 4) st16((char*)YK - (WS_YK - WS_P), (ro + bj * 256) & 0xFFFFFu, pk); else if (XV == 5) st16((char*)YK - (WS_YK - WS_P), (ro + bj * 256) & 0x7FFFFFFu, pk); else if (XV == 6) st16((char*)YK - (WS_YK - WS_P), ((ro & ~127u) + (ro & 63u) + bj * 64) & 0x7FFFFFFu, pk); else if (XV == 0 || pk.x == 0x12345678u) st16(YK, ro + bj * 256, pk); } }
    }
};
typedef EpiMoeDownT<0> EpiMoeDown;

template <int L> __device__ __forceinline__ void ph_ln1_router(const Args& a, const Ctx& c) {
    constexpr int NROWS = (L == 0) ? R : NB * SEQ;
    constexpr int HTS = 2064;
    const bf16* ACC = (const bf16*)(a.ws + WS_ACC); bf16* H = (bf16*)(a.ws + WS_H); bf16* X1 = (bf16*)(a.ws + WS_MIX);
    const float* mods = (const float*)(a.ws + WS_MODS) + (size_t)L * 9 * 6144;
    const float* g1 = a.in[I_LN1G] + L * D; const float* b1 = a.in[I_LN1B] + L * D;
    const float* Wr = a.in[I_RW] + (size_t)L * D * NE; const float* rb = a.in[I_RB] + L * NE;
    int* LTOK = (int*)(a.ws + WS_LTOK); float* LGATE = (float*)(a.ws + WS_LGATE); int* TOKSLOT = (int*)(a.ws + WS_TOKSLOT);
    unsigned* cur = (unsigned*)(a.ws + WS_CTL) + CW_CNT + 64 * L;
    LAS unsigned char* HT = c.lds;
    LAS float* PART = (LAS float*)(c.lds + 66560);
    LAS float* LOG = (LAS float*)(c.lds + 82944);
    LAS int* rec = (LAS int*)(c.lds + 86016);
    LAS float* recg = (LAS float*)(c.lds + 86016 + 6144);
    LAS int* recrow = (LAS int*)(c.lds + 86016 + 12288);
    LAS int* misc = (LAS int*)(c.lds + MISC_OFF);
    const int fr = c.lane & 15, fq = c.lane >> 4;
    bf16x8 whi[2][4], wlo[2][4];
#pragma unroll
    for (int nb = 0; nb < 2; ++nb)
#pragma unroll
        for (int ks = 0; ks < 4; ++ks) { float wv[8], wl[8];
#pragma unroll
            for (int j = 0; j < 8; ++j) wv[j] = Wr[(size_t)(128 * c.wave + 32 * ks + 8 * fq + j) * NE + nb * 16 + fr];
            const u32x4 hi = pack8(wv); float hf[8]; unpack8(hi, hf);
#pragma unroll
            for (int j = 0; j < 8; ++j) wl[j] = wv[j] - hf[j];
            whi[nb][ks] = __builtin_bit_cast(bf16x8, hi); wlo[nb][ks] = __builtin_bit_cast(bf16x8, pack8(wl)); }
    if (c.tid < 32) misc[128 + c.tid] = 0;
    __syncthreads();
    const int nqb = (NROWS - (int)blockIdx.x + c.G - 1) / c.G;
#define LN1_ROW(q_, row_, b_, isc_) do { const int _rl = blockIdx.x + c.G * (q_); if constexpr (L == 0) { row_ = _rl; b_ = row_ / SP; isc_ = (row_ % SP) < NCTX; } \
        else { b_ = _rl / SEQ; row_ = b_ * SP + NCTX + (_rl % SEQ); isc_ = 0; } } while (0)
    u32x2 vn[2][4];
#pragma unroll
    for (int rr = 0; rr < 2; ++rr) { const int q = 2 * c.wave + rr; if (q < nqb) { int row, b, isc; LN1_ROW(q, row, b, isc); (void)b; (void)isc;
#pragma unroll
        for (int j = 0; j < 4; ++j) vn[rr][j] = *(const u32x2*)(ACC + (size_t)row * D + 4 * c.lane + 256 * j); } }
    for (int s0 = 0; s0 < nqb; s0 += 16) {
#pragma unroll
        for (int rr = 0; rr < 2; ++rr) {
            const int slot = 2 * c.wave + rr, q = s0 + slot;
            if (q < nqb) {
                int row, b, isc; LN1_ROW(q, row, b, isc);
                const float* m = mods + (size_t)(isc ? 8 : b) * 6144;
                f32x4 v[4]; float s = 0.f;
#pragma unroll
                for (int j = 0; j < 4; ++j) { const u32x2 w = vn[rr][j]; v[j] = (f32x4){bflo(w.x), bfhi(w.x), bflo(w.y), bfhi(w.y)}; s += (v[j][0] + v[j][1]) + (v[j][2] + v[j][3]); }
                const float mean = wave_sum(s) * (1.f / D); float s2 = 0.f;
#pragma unroll
                for (int j = 0; j < 4; ++j) { v[j] = v[j] - mean; s2 += (v[j][0] * v[j][0] + v[j][1] * v[j][1]) + (v[j][2] * v[j][2] + v[j][3] * v[j][3]); }
                const float rstd = rsqrtf(wave_sum(s2) * (1.f / D) + 1e-5f);
#pragma unroll
                for (int j = 0; j < 4; ++j) { const int col = 4 * c.lane + 256 * j;
                    const f32x4 x1 = v[j] * rstd * *(const f32x4*)(g1 + col) + *(const f32x4*)(b1 + col);
                    { u32x2 xo; xo.x = cvt_pk_bf16(x1[0], x1[1]); xo.y = cvt_pk_bf16(x1[2], x1[3]); *(u32x2*)(X1 + (size_t)row * D + col) = xo; }
                    const f32x4 hv = x1 * (*(const f32x4*)(m + 4 * 1024 + col) + 1.0f) + *(const f32x4*)(m + 3 * 1024 + col);
                    u32x2 o; o.x = cvt_pk_bf16(hv[0], hv[1]); o.y = cvt_pk_bf16(hv[2], hv[3]); *(u32x2*)(H + (size_t)row * D + col) = o;
                    u32x2 lo; lo.x = cvt_pk_bf16(hv[0] - bflo(o.x), hv[1] - bfhi(o.x)); lo.y = cvt_pk_bf16(hv[2] - bflo(o.y), hv[3] - bfhi(o.y));
                    *(LAS u32x2*)(HT + slot * HTS + col * 2) = o; *(LAS u32x2*)(HT + 16 * HTS + slot * HTS + col * 2) = lo; }
                if (c.lane == 0) recrow[q] = row;
            }
        }
        __syncthreads();
#pragma unroll
        for (int rr = 0; rr < 2; ++rr) { const int q = s0 + 16 + 2 * c.wave + rr; if (q < nqb) { int row, b, isc; LN1_ROW(q, row, b, isc); (void)b; (void)isc;
#pragma unroll
            for (int j = 0; j < 4; ++j) vn[rr][j] = *(const u32x2*)(ACC + (size_t)row * D + 4 * c.lane + 256 * j); } }
        {   f32x4 acc[2] = {(f32x4){0.f, 0.f, 0.f, 0.f}, (f32x4){0.f, 0.f, 0.f, 0.f}};
#pragma unroll
            for (int ks = 0; ks < 4; ++ks) { const int off = fr * HTS + (128 * c.wave + 32 * ks + 8 * fq) * 2;
                const bf16x8 ah = *(const LAS bf16x8*)(HT + off), al = *(const LAS bf16x8*)(HT + 16 * HTS + off);
#pragma unroll
                for (int nb = 0; nb < 2; ++nb) { acc[nb] = MFMA16(ah, whi[nb][ks], acc[nb]); acc[nb] = MFMA16(ah, wlo[nb][ks], acc[nb]); acc[nb] = MFMA16(al, whi[nb][ks], acc[nb]); } }
#pragma unroll
            for (int nb = 0; nb < 2; ++nb)
#pragma unroll
                for (int i = 0; i < 4; ++i) PART[(c.wave * 16 + 4 * fq + i) * 32 + nb * 16 + fr] = acc[nb][i]; }
        __syncthreads();
        {   const int slot = c.tid >> 5, e = c.tid & 31; float sum = rb[e];
#pragma unroll
            for (int w8 = 0; w8 < 8; ++w8) sum += PART[(w8 * 16 + slot) * 32 + e];
            LOG[slot * 33 + e] = sum; }
        __syncthreads();
        if (c.tid < 16 && s0 + c.tid < nqb) {
            const int q = s0 + c.tid; float lg[NE];
#pragma unroll
            for (int e = 0; e < NE; ++e) lg[e] = LOG[c.tid * 33 + e];
            int te[4]; float tv[4];
#pragma unroll
            for (int k = 0; k < 4; ++k) { float best = -3.0e38f; int bi = 0;
#pragma unroll
                for (int e = 0; e < NE; ++e) { const bool better = lg[e] > best; best = better ? lg[e] : best; bi = better ? e : bi; }
                te[k] = bi; tv[k] = best;
#pragma unroll
                for (int e = 0; e < NE; ++e) lg[e] = (e == bi) ? -3.0e38f : lg[e]; }
            float ex[4], es = 0.f;
#pragma unroll
            for (int k = 0; k < 4; ++k) { ex[k] = expf(tv[k] - tv[0]); es += ex[k]; }
#pragma unroll
            for (int k = 0; k < 4; ++k) { const int lpos = atomicAdd((int*)&misc[128 + te[k]], 1); rec[q * 4 + k] = (te[k] << 20) | lpos; recg[q * 4 + k] = ex[k] / es; }
        }
    }
    __syncthreads();
    if (c.tid < 32) { const int n = misc[128 + c.tid]; misc[160 + c.tid] = n ? (int)__hip_atomic_fetch_add(cur + c.tid, (unsigned)n, __ATOMIC_RELAXED, __HIP_MEMORY_SCOPE_AGENT) : 0; }
    __syncthreads();
    for (int i = c.tid; i < nqb * 4; i += 512) { const int q = i >> 2, rc = rec[i], e = rc >> 20, pos = misc[160 + e] + (rc & 0xfffff); const int row = recrow[q];
        LTOK[(size_t)e * CAP + pos] = row; LGATE[(size_t)e * CAP + pos] = recg[i]; TOKSLOT[row * 4 + (i & 3)] = (e << 24) | pos; }
#undef LN1_ROW
}

template <int L> __device__ __forceinline__ void ph_ln2(const Args& a, const Ctx& c) {
    constexpr int NROWS = (L == 0) ? R : NB * SEQ;
    const bf16* X1 = (const bf16*)(a.ws + WS_MIX); const bf16* YK = (const bf16*)(a.ws + WS_YK); const int* TOKSLOT = (const int*)(a.ws + WS_TOKSLOT);
    const float* mods = (const float*)(a.ws + WS_MODS) + (size_t)L * 9 * 6144;
    const float* g2 = a.in[I_LN2G] + L * D; const float* b2 = a.in[I_LN2B] + L * D;
    LAS int* misc = (LAS int*)(c.lds + MISC_OFF);
    moe_setup_tiles(a, c, L);
#define LN2_ROW(rl_, row_, b_, isc_, t_) do { if constexpr (L == 0) { row_ = (rl_); b_ = row_ / SP; isc_ = (row_ % SP) < NCTX; t_ = 0; } else { b_ = (rl_) / SEQ; t_ = (rl_) % SEQ; row_ = b_ * SP + NCTX + t_; isc_ = 0; } } while (0)
    int tsn[4] = {0, 0, 0, 0}; u32x2 an[4]; u32x2 yn[4][4];
#define LN2_TS(rl_) do { int _row, _b, _isc, _t; LN2_ROW(rl_, _row, _b, _isc, _t); (void)_b; (void)_isc; (void)_t; _Pragma("unroll") for (int k = 0; k < 4; ++k) tsn[k] = TOKSLOT[_row * 4 + k]; } while (0)
#define LN2_DATA(rl_) do { int _row, _b, _isc, _t; LN2_ROW(rl_, _row, _b, _isc, _t); (void)_b; (void)_isc; (void)_t; \
        _Pragma("unroll") for (int k = 0; k < 4; ++k) { const int e = tsn[k] >> 24, pos = tsn[k] & 0xffffff; const bf16* yk = YK + ((size_t)misc[e] * 256 + pos) * 1024; \
            _Pragma("unroll") for (int j = 0; j < 4; ++j) yn[k][j] = *(const u32x2*)(yk + 4 * c.lane + 256 * j); } \
        _Pragma("unroll") for (int j = 0; j < 4; ++j) an[j] = *(const u32x2*)(X1 + (size_t)_row * D + 4 * c.lane + 256 * j); } while (0)
    if (c.gw < NROWS) { LN2_TS(c.gw); LN2_DATA(c.gw); if (c.gw + c.NGW < NROWS) LN2_TS(c.gw + c.NGW); }
    for (int rl = c.gw; rl < NROWS; rl += c.NGW) {
        int row, b, isc, t; LN2_ROW(rl, row, b, isc, t);
        const float* m = mods + (size_t)(isc ? 8 : b) * 6144;
        f32x4 v[4]; float s = 0.f;
#pragma unroll
        for (int j = 0; j < 4; ++j) { const int col = 4 * c.lane + 256 * j; f32x4 fl = (f32x4){0.f, 0.f, 0.f, 0.f};
#pragma unroll
            for (int k = 0; k < 4; ++k) { const u32x2 w = yn[k][j]; fl[0] += bflo(w.x); fl[1] += bfhi(w.x); fl[2] += bflo(w.y); fl[3] += bfhi(w.y); }
            const f32x4 x1v = (f32x4){bflo(an[j].x), bfhi(an[j].x), bflo(an[j].y), bfhi(an[j].y)};
            v[j] = x1v * DN_ALPHA + *(const f32x4*)(m + 5 * 1024 + col) * fl;
            s += (v[j][0] + v[j][1]) + (v[j][2] + v[j][3]); }
        if (rl + c.NGW < NROWS) { LN2_DATA(rl + c.NGW); if (rl + 2 * c.NGW < NROWS) LN2_TS(rl + 2 * c.NGW); }
        const float mean = wave_sum(s) * (1.f / D); float s2 = 0.f;
#pragma unroll
        for (int j = 0; j < 4; ++j) { v[j] = v[j] - mean; s2 += (v[j][0] * v[j][0] + v[j][1] * v[j][1]) + (v[j][2] * v[j][2] + v[j][3] * v[j][3]); }
        const float rstd = rsqrtf(wave_sum(s2) * (1.f / D) + 1e-5f);
#pragma unroll
        for (int j = 0; j < 4; ++j) { const int col = 4 * c.lane + 256 * j;
            const f32x4 x2 = v[j] * rstd * *(const f32x4*)(g2 + col) + *(const f32x4*)(b2 + col);
            if constexpr (L == 0) {
                { u32x2 xo; xo.x = cvt_pk_bf16(x2[0], x2[1]); xo.y = cvt_pk_bf16(x2[2], x2[3]); *(u32x2*)((bf16*)(a.ws + WS_X) + (size_t)row * D + col) = xo; }
                const float* mn = m + 9 * 6144;
                const f32x4 h = x2 * (*(const f32x4*)(mn + 1024 + col) + 1.0f) + *(const f32x4*)(mn + col);
                u32x2 o; o.x = cvt_pk_bf16(h[0], h[1]); o.y = cvt_pk_bf16(h[2], h[3]); *(u32x2*)((bf16*)(a.ws + WS_H) + (size_t)row * D + col) = o;
            } else {
#ifdef PROBE_K
                { const unsigned long long* TS = (const unsigned long long*)(a.ws + WS_CTL + 524288); const unsigned long long dt = (TS[PROBE_END] - TS[PROBE_K]) & ~1023ull;
                  const float fac = 1.f + sqrtf((float)dt * 1e-9f); *(f32x4*)(a.out + ((size_t)b * SEQ + t) * D + col) = x2 * fac; }
#else
                *(f32x4*)(a.out + ((size_t)b * SEQ + t) * D + col) = x2;
#endif
            } }
    }
#undef LN2_ROW
#undef LN2_TS
#undef LN2_DATA
}
__device__ __forceinline__ void ph12_mla_post(const Args& a, const Ctx& c) {
    const bf16* PM = (const bf16*)(a.ws + WS_PM); bf16* CQ = (bf16*)(a.ws + WS_CQ); bf16* CKV = (bf16*)(a.ws + WS_CKV); bf16* KM = (bf16*)(a.ws + WS_KM);
    const float* qn = a.in[I_MLAQN]; const float* kvn = a.in[I_MLAKVN];
    const float2* A64 = (const float2*)(a.ws + WS_TAB_A64);
    const int lane = c.lane;
    u32x4 n0 = (u32x4){0u, 0u, 0u, 0u}, n1 = (u32x4){0u, 0u, 0u, 0u};
    if (c.gw < R) { const bf16* pr = PM + (size_t)c.gw * MLA_IN_P; n0 = *(const u32x4*)(pr + lane * 8); if (lane < 32) n1 = *(const u32x4*)(pr + 512 + lane * 8); }
    for (int row = c.gw; row < R; row += c.NGW) {
        const int s = row % SP; const bool lat = s >= NCTX;
        const u32x4 w0 = n0, w1 = n1;
        if (row + c.NGW < R) { const bf16* pr = PM + (size_t)(row + c.NGW) * MLA_IN_P; n0 = *(const u32x4*)(pr + lane * 8); if (lane < 32) n1 = *(const u32x4*)(pr + 512 + lane * 8); }
        float v0[8], v1[8];
        unpack8(w0, v0);
        if (lane < 32) unpack8(w1, v1);
        else {
#pragma unroll
            for (int i = 0; i < 8; ++i) v1[i] = 0.f; }
        float sq = 0.f, sk = 0.f, t0 = 0.f, t1 = 0.f;
#pragma unroll
        for (int i = 0; i < 8; ++i) { t0 += v0[i] * v0[i]; t1 += v1[i] * v1[i]; }
        if (lane < 48) sq = t0; else sk = t0;
        if (lane < 16) sk += t1;
        sq = wave_sum(sq); sk = wave_sum(sk);
        const float rq = rsqrtf(sq * (1.f / MLA_QL) + 1e-6f), rk = rsqrtf(sk * (1.f / MLA_KVL) + 1e-6f);
        float o[8];
        if (lane < 48) {
#pragma unroll
            for (int i = 0; i < 8; ++i) o[i] = v0[i] * rq * qn[lane * 8 + i];
            *(u32x4*)(CQ + (size_t)row * MLA_QL + lane * 8) = pack8(o);
        } else {
#pragma unroll
            for (int i = 0; i < 8; ++i) o[i] = v0[i] * rk * kvn[(lane - 48) * 8 + i];
            *(u32x4*)(CKV + (size_t)row * MLA_KVL + (lane - 48) * 8) = pack8(o);
        }
        if (lane < 16) {
#pragma unroll
            for (int i = 0; i < 8; ++i) o[i] = v1[i] * rk * kvn[128 + lane * 8 + i];
            *(u32x4*)(CKV + (size_t)row * MLA_KVL + 128 + lane * 8) = pack8(o);
        }
        float pr8[8];
#pragma unroll
        for (int i = 0; i < 8; ++i) pr8[i] = __shfl_xor(v1[i], 2);
        if (lane >= 16 && lane < 24) {
            if (lat) { const int t = s - NCTX, pos = lane < 20 ? t / GRID_W : t % GRID_W; const float2* cs = A64 + pos * 16 + (lane & 1) * 8; const bool second = (lane & 2) != 0;
#pragma unroll
                for (int i = 0; i < 8; ++i) { const float2 q = cs[i]; o[i] = second ? (pr8[i] * q.y + v1[i] * q.x) : (v1[i] * q.x - pr8[i] * q.y); } }
            else {
#pragma unroll
                for (int i = 0; i < 8; ++i) o[i] = v1[i]; }
            const u32x4 w = pack8(o);
#pragma unroll
            for (int h = 0; h < 8; ++h) *(u32x4*)(KM + (size_t)row * UQ_N + h * 192 + 128 + (lane - 16) * 8) = w;
        }
    }
}
struct EpiMlaIn {
    static constexpr bool PERM = true; static constexpr int NST = 16;
    bf16* PM; float* SS; bf16* KM; const float2* A64;
    __device__ __forceinline__ void operator()(const f32x4 (&acc)[2][2][4][2], const pg8::Unit& u, int wr, int wc, int fr, int fq) const {
        const int row0 = u.pm * 256 + wr * 64 + fr;
        const unsigned rb = ((unsigned)row0 * MLA_IN_P + (unsigned)(u.pn * 256 + wc * 32 + 8 * fq)) * 2u;
#pragma unroll
        for (int ai = 0; ai < 2; ++ai)
#pragma unroll
            for (int m = 0; m < 4; ++m) { const unsigned ro = rb + (unsigned)((ai * 128 + m * 16) * MLA_IN_P) * 2u; const int row = row0 + ai * 128 + m * 16;
#pragma unroll
                for (int bj = 0; bj < 2; ++bj) { st16(PM, ro + bj * 256, pack2x4(acc[ai][bj][m][0], acc[ai][bj][m][1]));
                    if (u.pn != 1 || bj == 0) {
                        const f32x4 x0 = acc[ai][bj][m][0], x1 = acc[ai][bj][m][1];
                        float sq = (x0[0] * x0[0] + x0[1] * x0[1]) + (x0[2] * x0[2] + x0[3] * x0[3]) + (x1[0] * x1[0] + x1[1] * x1[1]) + (x1[2] * x1[2] + x1[3] * x1[3]);
                        sq += __shfl_xor(sq, 16); sq += __shfl_xor(sq, 32);
                        const int slot = (u.pn == 0 ? 0 : (u.pn == 1 ? 8 : 12)) + bj * 4 + wc;
                        if (fq == 0) SS[(size_t)row * 20 + slot] = sq; } }
                if (u.pn == 1 && wc < 2) {
                    const int s = row % SP; const f32x4 x1 = acc[ai][1][m][0], x2 = acc[ai][1][m][1]; f32x4 o1 = x1, o2 = x2;
                    if (s >= NCTX) { const int t = s - NCTX, pos = wc == 0 ? t / GRID_W : t % GRID_W; const float* cs = (const float*)(A64 + pos * 16 + 4 * fq);
                        const f32x4 ca = *(const f32x4*)cs, cb = *(const f32x4*)(cs + 4);
                        o1 = (f32x4){x1[0] * ca[0] - x2[0] * ca[1], x1[1] * ca[2] - x2[1] * ca[3], x1[2] * cb[0] - x2[2] * cb[1], x1[3] * cb[2] - x2[3] * cb[3]};
                        o2 = (f32x4){x1[0] * ca[1] + x2[0] * ca[0], x1[1] * ca[3] + x2[1] * ca[2], x1[2] * cb[1] + x2[2] * cb[0], x1[3] * cb[3] + x2[3] * cb[2]}; }
                    u32x2 w1, w2; w1.x = cvt_pk_bf16(o1[0], o1[1]); w1.y = cvt_pk_bf16(o1[2], o1[3]); w2.x = cvt_pk_bf16(o2[0], o2[1]); w2.y = cvt_pk_bf16(o2[2], o2[3]);
                    const unsigned kb = ((unsigned)row * UQ_N + (unsigned)(128 + 32 * wc + 4 * fq)) * 2u;
#pragma unroll
                    for (int h = 0; h < 8; ++h) { st8(KM, kb + h * 384, w1); st8(KM, kb + h * 384 + 32, w2); } }
            }
    }
};
struct LatOrder {
    pg8::StaticOrder S; static constexpr bool GATHER = false;
    __device__ void init(int nN, int G, int c) { S.init(NB * 16, nN, G, c); }
    __device__ bool next(int i, pg8::Unit& u) const { if (!S.next(i, u)) return false; u.pm = (u.pm >> 4) * 17 + 1 + (u.pm & 15); return true; }
    __device__ __forceinline__ unsigned arow(const pg8::Unit&, int) const { return 0u; }
};
struct EpiUq {
    static constexpr bool PERM = true; static constexpr int NST = 16;
    bf16* QM; const float2* A64; const float* SS;
    __device__ __forceinline__ void operator()(const f32x4 (&acc)[2][2][4][2], const pg8::Unit& u, int wr, int wc, int fr, int fq) const {
        constexpr float SC0 = 0.07216878364870322f;
        const int row0 = u.pm * 256 + wr * 64 + fr;
        float rs[2][4];
#pragma unroll
        for (int ai = 0; ai < 2; ++ai)
#pragma unroll
            for (int m = 0; m < 4; ++m) { const float* sp = SS + (size_t)(row0 + ai * 128 + m * 16) * 20; const f32x4 a0 = *(const f32x4*)sp, a1 = *(const f32x4*)(sp + 4), a2 = *(const f32x4*)(sp + 8);
                const float ssq = ((a0[0] + a0[1]) + (a0[2] + a0[3])) + ((a1[0] + a1[1]) + (a1[2] + a1[3])) + ((a2[0] + a2[1]) + (a2[2] + a2[3]));
                rs[ai][m] = SC0 * rsqrtf(ssq * (1.f / MLA_QL) + 1e-6f); }
        if (u.pn < 4) {
            const unsigned rb = ((unsigned)row0 * UQ_N + (unsigned)(2 * u.pn * 192 + wc * 32 + 8 * fq)) * 2u;
#pragma unroll
            for (int ai = 0; ai < 2; ++ai)
#pragma unroll
                for (int m = 0; m < 4; ++m) { const unsigned ro = rb + (unsigned)((ai * 128 + m * 16) * UQ_N) * 2u;
#pragma unroll
                    for (int bj = 0; bj < 2; ++bj) st16(QM, ro + bj * 384, pack2x4(acc[ai][bj][m][0] * rs[ai][m], acc[ai][bj][m][1] * rs[ai][m])); }
        } else {
            const int head = 4 * (u.pn - 4) + wc, j0 = 8 * fq;
            const int d1 = j0 < 16 ? j0 : 16 + j0;
            const unsigned rb = ((unsigned)row0 * UQ_N + (unsigned)(head * 192 + 128 + d1)) * 2u;
            const int t0 = row0 % SP - NCTX;
#pragma unroll
            for (int ai = 0; ai < 2; ++ai)
#pragma unroll
                for (int m = 0; m < 4; ++m) { const int t = t0 + ai * 128 + m * 16;
                    const int pos = j0 < 16 ? t / GRID_W : t % GRID_W; const unsigned co = (unsigned)(pos * 16 + (j0 & 15)) * 8u;
                    const unsigned ro = rb + (unsigned)((ai * 128 + m * 16) * UQ_N) * 2u; const float SC = rs[ai][m];
#pragma unroll
                    for (int n = 0; n < 2; ++n) { const f32x4 ca = *(const f32x4*)((const char*)A64 + co + 32 * n), cb = *(const f32x4*)((const char*)A64 + co + 32 * n + 16);
                        const f32x4 x1 = acc[ai][0][m][n], x2 = acc[ai][1][m][n];
                        u32x2 w1, w2;
                        w1.x = cvt_pk_bf16((x1[0] * ca[0] - x2[0] * ca[1]) * SC, (x1[1] * ca[2] - x2[1] * ca[3]) * SC);
                        w1.y = cvt_pk_bf16((x1[2] * cb[0] - x2[2] * cb[1]) * SC, (x1[3] * cb[2] - x2[3] * cb[3]) * SC);
                        w2.x = cvt_pk_bf16((x1[0] * ca[1] + x2[0] * ca[0]) * SC, (x1[1] * ca[3] + x2[1] * ca[2]) * SC);
                        w2.y = cvt_pk_bf16((x1[2] * cb[1] + x2[2] * cb[0]) * SC, (x1[3] * cb[3] + x2[3] * cb[2]) * SC);
                        st8(QM, ro + 8 * n, w1); st8(QM, ro + 32 + 8 * n, w2); } }
        }
    }
};
struct EpiUkv {
    static constexpr bool PERM = true; static constexpr int NST = 16;
    bf16* KM; bf16* VM; const float* SS;
    __device__ __forceinline__ void operator()(const f32x4 (&acc)[2][2][4][2], const pg8::Unit& u, int wr, int wc, int fr, int fq) const {
        const unsigned row0 = (unsigned)(u.pm * 256 + wr * 64 + fr), cw = (unsigned)(wc * 32 + 8 * fq);
        const unsigned kb = (row0 * UQ_N + (unsigned)u.pn * 192 + cw) * 2u, vb = (row0 * 1024u + (unsigned)u.pn * 128 + cw) * 2u;
#pragma unroll
        for (int ai = 0; ai < 2; ++ai)
#pragma unroll
            for (int m = 0; m < 4; ++m) { const float* sp = SS + (size_t)(row0 + ai * 128 + m * 16) * 20 + 12; const f32x4 a0 = *(const f32x4*)sp, a1 = *(const f32x4*)(sp + 4);
                const float rk = rsqrtf((((a0[0] + a0[1]) + (a0[2] + a0[3])) + ((a1[0] + a1[1]) + (a1[2] + a1[3]))) * (1.f / MLA_KVL) + 1e-6f);
                st16(KM, kb + (unsigned)((ai * 128 + m * 16) * UQ_N) * 2u, pack2x4(acc[ai][0][m][0] * rk, acc[ai][0][m][1] * rk));
                st16(VM, vb + (unsigned)((ai * 128 + m * 16) * 1024) * 2u, pack2x4(acc[ai][1][m][0] * rk, acc[ai][1][m][1] * rk)); }
    }
};
__device__ __forceinline__ void ph14_mla_attn(const Args& a, const Ctx& c) {
    const bf16* QM = (const bf16*)(a.ws + WS_QM); const bf16* KM = (const bf16*)(a.ws + WS_KM); const bf16* VM = (const bf16*)(a.ws + WS_VM); bf16* MIX = (bf16*)(a.ws + WS_MIX);
    for (int task = c.vcu; task < 1024; task += c.G) {
        const int b = task >> 7, h = (task >> 4) & 7, r0 = b * SP + NCTX + (task & 15) * 256;
        att::attn_dense_body<192, UQ_N, UQ_N, 1024, 1024>(QM + (size_t)r0 * UQ_N + h * 192, KM + (size_t)b * SP * UQ_N + h * 192, VM + (size_t)b * SP * 1024 + h * 128,
                                                          MIX + (size_t)r0 * 1024 + h * 128, SP, (char*)c.lds);
    }
}

#ifdef EXP_VAR
__device__ __forceinline__ void ph14_exp(const Args& a, const Ctx& c) {
    const bf16* QM = (const bf16*)(a.ws + WS_QM); const bf16* KM = (const bf16*)(a.ws + WS_KM); const bf16* VM = (const bf16*)(a.ws + WS_VM); bf16* OX = (bf16*)(a.ws + WS_ACT);
    for (int task = c.vcu; task < 1024; task += c.G) {
        const int b = task >> 7, h = (task >> 4) & 7, r0 = b * SP + NCTX + (task & 15) * 256;
#if EXP_D == 192
        att::attn_dense_body<192, UQ_N, UQ_N, 1024, 1024, EXP_VAR>(QM + (size_t)r0 * UQ_N + h * 192, KM + (size_t)b * SP * UQ_N + h * 192, VM + (size_t)b * SP * 1024 + h * 128,
                                                                   OX + (size_t)r0 * 1024 + h * 128, SP, (char*)c.lds);
#else
        att::attn_dense_body<128, UQ_N, UQ_N, 1024, 1024, EXP_VAR>(QM + (size_t)r0 * UQ_N + h * 192, KM + (size_t)b * SP * UQ_N + h * 192, VM + (size_t)b * SP * 1024 + h * 128,
                                                                   OX + (size_t)r0 * 1024 + h * 128, SP, (char*)c.lds);
#endif
    }
}
#endif
constexpr int NPH = 20;
#ifndef ONE_LAUNCH
#define ONE_LAUNCH 1
#endif
__global__ void __launch_bounds__(512, 2) fwd(Args a) {
    extern __shared__ __attribute__((aligned(16))) unsigned char lds_raw[];
    Ctx c; c.lds = (LAS unsigned char*)lds_raw; c.tid = threadIdx.x; c.lane = c.tid & 63; c.wave = __builtin_amdgcn_readfirstlane(c.tid >> 6);
    c.G = gridDim.x; { const int bx = blockIdx.x; c.vcu = (c.G % 8 == 0) ? (bx % 8) * (c.G / 8) + bx / 8 : bx; }
    c.gw = c.vcu * 8 + c.wave; c.NGW = c.G * 8;
    volatile LAS unsigned* MISC = (volatile LAS unsigned*)(c.lds + MISC_OFF);
    if (c.tid < 256) MISC[c.tid] = 0u;
    __syncthreads();
    unsigned* ctl = (unsigned*)(a.ws + WS_CTL);
    XcdBarrier bar; bar.bar = ctl + CW_BAR; bar.x = 0; bar.st = nullptr;
    const int lo = a.ph_lo, hi = a.ph_hi;
    if (hi - lo > 1) bar = xcd_barrier_post(ctl + CW_BAR, MISC + 248);
#ifndef PHMASK
#define PHMASK 0xFFFFFu
#endif
#define IN(k) ((((PHMASK) >> (k)) & 1u) && lo <= (k) && (k) < hi)
#ifndef DUPMASK
#define DUPMASK 0u
#endif
#define NREP(k) ((((DUPMASK) >> (k)) & 1u) ? 2 : 1)
#ifdef PROBE_K
#define STAMP(k) do { if (blockIdx.x == 0 && c.tid == 0) ((unsigned long long*)(a.ws + WS_CTL + 524288))[(k)] = __builtin_amdgcn_s_memrealtime(); } while (0)
#else
#define STAMP(k) do { } while (0)
#endif
#ifndef EXTRA_BAR
#define EXTRA_BAR 0
#endif
#ifndef EXP_MOE
#define EXP_MOE 0
#endif
#define SEAM(k) do { if (IN(k) && IN((k) + 1)) { xcd_barrier(bar); if ((k) == 10) for (int _e = 0; _e < EXTRA_BAR; ++_e) xcd_barrier(bar); } STAMP((k) + 1); } while (0)
    STAMP(0);
#ifdef STAGGER_US
#define STAGGER(total_units) do { const int _rem = (total_units) % c.G; if (_rem != 0 && (int)blockIdx.x >= _rem) { \
        const unsigned long long _t0 = __builtin_amdgcn_s_memrealtime(); const unsigned long long _d = (unsigned long long)((int)blockIdx.x - _rem) * (STAGGER_US * 100) / (unsigned)(c.G - _rem); \
        while (__builtin_amdgcn_s_memrealtime() - _t0 < _d) __builtin_amdgcn_s_sleep(8); } } while (0)
#else
#define STAGGER(total_units) do { } while (0)
#endif
    unsigned char* ws = a.ws;
    const float* mods = (const float*)(ws + WS_MODS);
    LAS int* misc = (LAS int*)(c.lds + MISC_OFF);
    int cv_done = 0;
#ifndef CV_N2
#define CV_N2 32
#endif
#ifndef CV_N5
#define CV_N5 24
#endif
#ifndef CV_N6
#define CV_N6 48
#endif
#ifndef CV_N8
#define CV_N8 32
#endif
#ifndef CV_N9
#define CV_N9 40
#endif
#ifndef CV_N11
#define CV_N11 32
#endif
#ifndef CV_N13
#define CV_N13 16
#endif

    if (IN(0)) { ph0_prologue(a, c);
    }
#if (DUPMASK >> 0) & 1
    if (IN(0)) { __syncthreads(); ph0_prologue(a, c);
    }
#endif
    SEAM(0);
    if (IN(1)) { ph1_mod0(a, c);
    }
#if (DUPMASK >> 1) & 1
    if (IN(1)) { __syncthreads(); ph1_mod0(a, c);
    }
#endif
    SEAM(1);
    if (IN(2)) {
        STAGGER((R / 256) * (AB_IN / 256));
        pg8::Gemm g{(const bf16*)(ws + WS_H), (const bf16*)(ws + WS_WABIN), 1024, 1024}; pg8::StaticOrder S; S.init(R / 256, AB_IN / 256, c.G, (int)blockIdx.x);
        EpiStoreBf16 E{(bf16*)(ws + WS_P), AB_IN};
        pg8::gemm_phase(c.lds, g, S, E);
        conv_tail(a, c, cv_done, (int)blockIdx.x, ((R / 256) * (AB_IN / 256)) % c.G, CV_N2);
    }
#if (DUPMASK >> 2) & 1
    if (IN(2)) { __syncthreads();
        pg8::Gemm g{(const bf16*)(ws + WS_H), (const bf16*)(ws + WS_WABIN), 1024, 1024}; pg8::StaticOrder S; S.init(R / 256, AB_IN / 256, c.G, (int)blockIdx.x);
        EpiStoreBf16 E{(bf16*)(ws + WS_P), AB_IN};
        pg8::gemm_phase(c.lds, g, S, E);
    }
#endif
    SEAM(2);
    if (IN(3)) { ph3_post(a, c);
    }
#if (DUPMASK >> 3) & 1
    if (IN(3)) { __syncthreads(); ph3_post(a, c);
    }
#endif
    SEAM(3);
    if (IN(4)) { ph4_r1(a, c); __syncthreads(); ph4_attn(a, c);
    }
#if (DUPMASK >> 4) & 1
    if (IN(4)) { __syncthreads(); ph4_r1(a, c); __syncthreads(); ph4_attn(a, c);
    }
#endif
    SEAM(4);
    if (IN(5)) { ph5_r2(a, c);
        conv_tail(a, c, cv_done, c.vcu, (NB * 4 * NCHUNK) % c.G, CV_N5);
    }
#if (DUPMASK >> 5) & 1
    if (IN(5)) { __syncthreads(); ph5_r2(a, c);
    }
#endif
    SEAM(5);
    if (IN(6)) {
        pg8::Gemm g{(const bf16*)(ws + WS_MIX), (const bf16*)(ws + WS_WABOUT), 1024, 1024}; pg8::StaticOrder S; S.init(R / 256, 4, c.G, (int)blockIdx.x);
        EpiResid<0> E{a.in[I_X], a.in[I_CTX], nullptr, mods, (bf16*)(ws + WS_ACC)};
        pg8::gemm_phase(c.lds, g, S, E);
        conv_tail(a, c, cv_done, (int)blockIdx.x, ((R / 256) * 4) % c.G, CV_N6);
    }
#if (DUPMASK >> 6) & 1
    if (IN(6)) { __syncthreads();
        pg8::Gemm g{(const bf16*)(ws + WS_MIX), (const bf16*)(ws + WS_WABOUT), 1024, 1024}; pg8::StaticOrder S; S.init(R / 256, 4, c.G, (int)blockIdx.x);
        EpiResid<0> E{a.in[I_X], a.in[I_CTX], nullptr, mods, (bf16*)(ws + WS_ACC)};
        pg8::gemm_phase(c.lds, g, S, E);
    }
#endif
    SEAM(6);
    if (IN(7)) { ph_ln1_router<0>(a, c);
    }
#if (DUPMASK >> 7) & 1
    if (IN(7)) { __syncthreads(); ph_ln1_router<0>(a, c);
    }
#endif
    SEAM(7);
    if (IN(8)) {
        moe_setup_tiles(a, c, 0); STAGGER(misc[NE] * 8);
        pg8::Gemm g{(const bf16*)(ws + WS_H), (const bf16*)(ws + WS_WUP), 1024, 1024}; MoeOrder<true> S; S.init(misc, (const int*)(ws + WS_LTOK), 8, c.G, (int)blockIdx.x);
        EpiMoeUp E{(bf16*)(ws + WS_ACT), a.in[I_BUP]};
        pg8::gemm_phase(c.lds, g, S, E);
        conv_tail(a, c, cv_done, (int)blockIdx.x, (misc[NE] * 8) % c.G, CV_N8);
    }
#if (DUPMASK >> 8) & 1
    if (IN(8)) { __syncthreads(); STAMP(30);
        moe_setup_tiles(a, c, 0);
        pg8::Gemm g{(const bf16*)(ws + WS_H), (const bf16*)(ws + WS_WUP), 1024, 1024}; MoeOrder<true> S; S.init(misc, (const int*)(ws + WS_LTOK), 8, c.G, (int)blockIdx.x);
        EpiMoeUpT<EXP_MOE> E{(bf16*)(ws + WS_ACT), a.in[I_BUP]};
        pg8::gemm_phase(c.lds, g, S, E);
    }
#endif
    SEAM(8);
    if (IN(9)) {
        moe_setup_tiles(a, c, 0); STAGGER(misc[NE] * 4);
        pg8::Gemm g{(const bf16*)(ws + WS_ACT), (const bf16*)(ws + WS_WDOWN), 1024, 1024}; MoeOrder<false> S; S.init(misc, nullptr, 4, c.G, (int)blockIdx.x);
        EpiMoeDown E{(bf16*)(ws + WS_YK), a.in[I_BDOWN], (const float*)(ws + WS_LGATE), misc};
        pg8::gemm_phase(c.lds, g, S, E);
        conv_tail(a, c, cv_done, (int)blockIdx.x, (misc[NE] * 4) % c.G, CV_N9);
    }
#if (DUPMASK >> 9) & 1
    if (IN(9)) { __syncthreads(); STAMP(30);
        moe_setup_tiles(a, c, 0);
        pg8::Gemm g{(const bf16*)(ws + WS_ACT), (const bf16*)(ws + WS_WDOWN), 1024, 1024}; MoeOrder<false> S; S.init(misc, nullptr, 4, c.G, (int)blockIdx.x);
        EpiMoeDownT<EXP_MOE> E{(bf16*)(ws + WS_YK), a.in[I_BDOWN], (const float*)(ws + WS_LGATE), misc};
        pg8::gemm_phase(c.lds, g, S, E);
    }
#endif
    SEAM(9);
    if (IN(10)) { ph_ln2<0>(a, c);
    }
#if (DUPMASK >> 10) & 1
    if (IN(10)) { __syncthreads(); ph_ln2<0>(a, c);
    }
#endif
    SEAM(10);
    if (IN(11)) {
        pg8::Gemm g{(const bf16*)(ws + WS_H), (const bf16*)(ws + WS_WMLAIN), 1024, 1024}; pg8::StaticOrder S; S.init(R / 256, 3, c.G, (int)blockIdx.x);
        EpiMlaIn E{(bf16*)(ws + WS_PM), (float*)(ws + WS_SS), (bf16*)(ws + WS_KM), (const float2*)(ws + WS_TAB_A64)};
        pg8::gemm_phase(c.lds, g, S, E);
        conv_tail(a, c, cv_done, (int)blockIdx.x, ((R / 256) * 3) % c.G, CV_N11);
    }
#if (DUPMASK >> 11) & 1
    if (IN(11)) { __syncthreads();
        pg8::Gemm g{(const bf16*)(ws + WS_H), (const bf16*)(ws + WS_WMLAIN), 1024, 1024}; pg8::StaticOrder S; S.init(R / 256, 3, c.G, (int)blockIdx.x);
        EpiMlaIn E{(bf16*)(ws + WS_PM), (float*)(ws + WS_SS), (bf16*)(ws + WS_KM), (const float2*)(ws + WS_TAB_A64)};
        pg8::gemm_phase(c.lds, g, S, E);
    }
#endif
    SEAM(11);
    if (IN(12)) {
    }
#if (DUPMASK >> 12) & 1
    if (IN(12)) { }
#endif
#ifdef PROBE_K
    STAMP(13);
#endif
    if (IN(13)) {
#ifndef NO_UQ
        {   pg8::Gemm g{(const bf16*)(ws + WS_PM), (const bf16*)(ws + WS_WUQ), MLA_QL, MLA_IN_P}; LatOrder S; S.init(6, c.G, (int)blockIdx.x);
            EpiUq E{(bf16*)(ws + WS_QM), (const float2*)(ws + WS_TAB_A64), (const float*)(ws + WS_SS)};
            pg8::gemm_phase(c.lds, g, S, E); }
#endif
#ifndef NO_UKV
        {   pg8::Gemm g{(const bf16*)(ws + WS_PM) + 512, (const bf16*)(ws + WS_WUKV), MLA_KVL, MLA_IN_P}; pg8::StaticOrder S; S.init(R / 256, 8, c.G, (int)blockIdx.x);
            EpiUkv E{(bf16*)(ws + WS_KM), (bf16*)(ws + WS_VM), (const float*)(ws + WS_SS)};
            pg8::gemm_phase(c.lds, g, S, E);
            conv_tail(a, c, cv_done, (int)blockIdx.x, ((R / 256) * 8) % c.G, CV_N13); }
#endif
    }
#if (DUPMASK >> 13) & 1
    if (IN(13)) { __syncthreads();
#ifndef NO_UQ
        {   pg8::Gemm g{(const bf16*)(ws + WS_PM), (const bf16*)(ws + WS_WUQ), MLA_QL, MLA_IN_P}; LatOrder S; S.init(6, c.G, (int)blockIdx.x);
            EpiUq E{(bf16*)(ws + WS_QM), (const float2*)(ws + WS_TAB_A64), (const float*)(ws + WS_SS)};
            pg8::gemm_phase(c.lds, g, S, E); }
#endif
#ifndef NO_UKV
        {   pg8::Gemm g{(const bf16*)(ws + WS_PM) + 512, (const bf16*)(ws + WS_WUKV), MLA_KVL, MLA_IN_P}; pg8::StaticOrder S; S.init(R / 256, 8, c.G, (int)blockIdx.x);
            EpiUkv E{(bf16*)(ws + WS_KM), (bf16*)(ws + WS_VM), (const float*)(ws + WS_SS)};
            pg8::gemm_phase(c.lds, g, S, E); }
#endif
    }
#endif
    SEAM(13);
    if (IN(14)) { ph14_mla_attn(a, c);
    }
#if (DUPMASK >> 14) & 1
    if (IN(14)) { __syncthreads(); ph14_mla_attn(a, c);
    }
#endif
    SEAM(14);
#ifdef EXP_VAR
    if (IN(14)) { STAMP(30); ph14_exp(a, c); xcd_barrier(bar); STAMP(31); }
#endif
    if (IN(15)) {
        pg8::Gemm g{(const bf16*)(ws + WS_MIX), (const bf16*)(ws + WS_WMLAOUT), 1024, 1024}; LatOrder S; S.init(4, c.G, (int)blockIdx.x);
        EpiResid<1> E{nullptr, nullptr, (const bf16*)(ws + WS_X), mods + 9 * 6144, (bf16*)(ws + WS_ACC)};
        pg8::gemm_phase(c.lds, g, S, E);
    }
#if (DUPMASK >> 15) & 1
    if (IN(15)) { __syncthreads();
        pg8::Gemm g{(const bf16*)(ws + WS_MIX), (const bf16*)(ws + WS_WMLAOUT), 1024, 1024}; LatOrder S; S.init(4, c.G, (int)blockIdx.x);
        EpiResid<1> E{nullptr, nullptr, (const bf16*)(ws + WS_X), mods + 9 * 6144, (bf16*)(ws + WS_ACC)};
        pg8::gemm_phase(c.lds, g, S, E);
    }
#endif
    SEAM(15);
    if (IN(16)) { conv_rest(a, c, cv_done); ph_ln1_router<1>(a, c);
    }
#if (DUPMASK >> 16) & 1
    if (IN(16)) { __syncthreads(); ph_ln1_router<1>(a, c);
    }
#endif
    SEAM(16);
    if (IN(17)) {
        moe_setup_tiles(a, c, 1); STAGGER(misc[NE] * 8);
        pg8::Gemm g{(const bf16*)(ws + WS_H), (const bf16*)(ws + WS_WUP) + (size_t)32 * 2048 * 1024, 1024, 1024}; MoeOrder<true> S; S.init(misc, (const int*)(ws + WS_LTOK), 8, c.G, (int)blockIdx.x);
        EpiMoeUp E{(bf16*)(ws + WS_ACT), a.in[I_BUP] + 32 * 2048};
        pg8::gemm_phase(c.lds, g, S, E);
    }
#if (DUPMASK >> 17) & 1
    if (IN(17)) { __syncthreads();
        moe_setup_tiles(a, c, 1);
        pg8::Gemm g{(const bf16*)(ws + WS_H), (const bf16*)(ws + WS_WUP) + (size_t)32 * 2048 * 1024, 1024, 1024}; MoeOrder<true> S; S.init(misc, (const int*)(ws + WS_LTOK), 8, c.G, (int)blockIdx.x);
        EpiMoeUp E{(bf16*)(ws + WS_ACT), a.in[I_BUP] + 32 * 2048};
        pg8::gemm_phase(c.lds, g, S, E);
    }
#endif
    SEAM(17);
    if (IN(18)) {
        moe_setup_tiles(a, c, 1); STAGGER(misc[NE] * 4);
        pg8::Gemm g{(const bf16*)(ws + WS_ACT), (const bf16*)(ws + WS_WDOWN) + (size_t)32 * 1024 * 1024, 1024, 1024}; MoeOrder<false> S; S.init(misc, nullptr, 4, c.G, (int)blockIdx.x);
        EpiMoeDown E{(bf16*)(ws + WS_YK), a.in[I_BDOWN] + 32 * 1024, (const float*)(ws + WS_LGATE), misc};
        pg8::gemm_phase(c.lds, g, S, E);
    }
#if (DUPMASK >> 18) & 1
    if (IN(18)) { __syncthreads();
        moe_setup_tiles(a, c, 1);
        pg8::Gemm g{(const bf16*)(ws + WS_ACT), (const bf16*)(ws + WS_WDOWN) + (size_t)32 * 1024 * 1024, 1024, 1024}; MoeOrder<false> S; S.init(misc, nullptr, 4, c.G, (int)blockIdx.x);
        EpiMoeDown E{(bf16*)(ws + WS_YK), a.in[I_BDOWN] + 32 * 1024, (const float*)(ws + WS_LGATE), misc};
        pg8::gemm_phase(c.lds, g, S, E);
    }
#endif
    SEAM(18);
    if (IN(19)) { ph_ln2<1>(a, c);
    }
#if (DUPMASK >> 19) & 1
    if (IN(19)) { __syncthreads(); ph_ln2<1>(a, c);
    }
#endif
#undef IN
#undef SEAM
}

extern "C" void kernel_launch(void* const* d_in, const int* in_sizes, int n_in, void* d_out, int out_size, void* d_ws, size_t ws_size, hipStream_t stream) {
    static int grid = 0;
    if (grid == 0) {
        if (n_in != 28 || in_sizes[0] != NB * SEQ * D || out_size != NB * SEQ * D || ws_size < WS_END) {
            fprintf(stderr, "kernel_launch: shape mismatch: n_in %d in0 %d out %d ws %zu (need >= %zu)\n", n_in, n_in > 0 ? in_sizes[0] : -1, out_size, ws_size, (size_t)WS_END); grid = -1; return; }
        int dev = 0, cus = 0, per_cu = 0;
        if (hipGetDevice(&dev) != hipSuccess || hipDeviceGetAttribute(&cus, hipDeviceAttributeMultiprocessorCount, dev) != hipSuccess) { fprintf(stderr, "kernel_launch: device query failed\n"); grid = -1; return; }
        if (hipFuncSetAttribute((const void*)fwd, hipFuncAttributeMaxDynamicSharedMemorySize, LDS_BYTES) != hipSuccess) { fprintf(stderr, "kernel_launch: hipFuncSetAttribute failed\n"); grid = -1; return; }
        if (hipOccupancyMaxActiveBlocksPerMultiprocessor(&per_cu, (const void*)fwd, 512, LDS_BYTES) != hipSuccess || per_cu < 1) fprintf(stderr, "kernel_launch: occupancy query reports %d blocks per CU\n", per_cu);
        (void)hipGetLastError();
        grid = cus;
    }
    if (grid < 0) return;
    if (hipMemsetAsync((char*)d_ws + WS_CTL, 0, CTL_ZERO_BYTES, stream) != hipSuccess) { fprintf(stderr, "kernel_launch: memset failed\n"); return; }
    Args a{};
    for (int i = 0; i < 28; ++i) a.in[i] = (const float*)d_in[i];
    a.out = (float*)d_out; a.ws = (unsigned char*)d_ws;
#if ONE_LAUNCH
    a.ph_lo = 0; a.ph_hi = NPH;
    hipLaunchKernelGGL(fwd, dim3(grid), dim3(512), LDS_BYTES, stream, a);
#else
    for (int p = 0; p < NPH; ++p) { a.ph_lo = p; a.ph_hi = p + 1; hipLaunchKernelGGL(fwd, dim3(grid), dim3(512), LDS_BYTES, stream, a); }
#endif
    const hipError_t le = hipPeekAtLastError();
    if (le != hipSuccess) fprintf(stderr, "kernel_launch: launch failed: %s\n", hipGetErrorName(le));
}
```
